# Optimizing an MI355X kernel written in HIP

```python
import math
import jax, jax.numpy as jnp
from jax import lax
import numpy as np

D_MODEL = 2048
BATCH = 2
SEQ = 16384
DEPTH = 1

HEAD_DIM_ATTN = 64
N_Q_ATTN = 16
N_KV_ATTN = 2
WINDOW = 128
ATTN_BLOCK = 128
D_ATTN = N_Q_ATTN * HEAD_DIM_ATTN
D_KV = N_KV_ATTN * HEAD_DIM_ATTN
N_RET = 8
HEAD_DIM_RET = 128
RET_CHUNK = 128
D_RET = N_RET * HEAD_DIM_RET
D_MIX = D_ATTN + D_RET
D_IN = D_ATTN + 2 * D_KV + 4 * D_RET
N_MEM = 256
N_MEM_HEADS = 4
HEAD_DIM_MEM = D_MODEL // N_MEM_HEADS
N_EXPERTS = 32
TOP_K = 4
D_EXPERT = D_MODEL
SWIGLU_LIMIT = 7.0
SWIGLU_ALPHA = 1.702
MOE_BLOCK = 256
LN_EPS = 1e-5
DN_ALPHA = (2 * DEPTH) ** 0.25
DN_BETA = (8 * DEPTH) ** -0.25
NEG_INF = -1e30

kernel_name = "hymba_swa_retention_memxattn_moe_deepnorm"


def _layer_norm(x, w, b):
    xf = x.astype(jnp.float32)
    mu = xf.mean(-1, keepdims=True)
    var = jnp.square(xf - mu).mean(-1, keepdims=True)
    y = (xf - mu) * lax.rsqrt(var + LN_EPS)
    return (y * w.astype(jnp.float32) + b.astype(jnp.float32)).astype(x.dtype)


def _rms_norm(x, w):
    xf = x.astype(jnp.float32)
    y = xf * lax.rsqrt(jnp.square(xf).mean(-1, keepdims=True) + LN_EPS)
    return (y * w.astype(jnp.float32)).astype(x.dtype)


def _alibi_slopes(n):
    return jnp.exp2(-8.0 * (jnp.arange(n, dtype=jnp.float32) + 1.0) / n)


def _sliding_window_attention(q, k, v, sinks):
    B, S, _, dh = q.shape
    nb = S // ATTN_BLOCK
    G = N_Q_ATTN // N_KV_ATTN
    qb = q.reshape(B, nb, ATTN_BLOCK, N_KV_ATTN, G, dh)
    kb = k.reshape(B, nb, ATTN_BLOCK, N_KV_ATTN, dh)
    vb = v.reshape(B, nb, ATTN_BLOCK, N_KV_ATTN, dh)
    pad = ((0, 0), (1, 0), (0, 0), (0, 0), (0, 0))
    kw = jnp.concatenate([jnp.pad(kb, pad)[:, :-1], kb], axis=2)
    vw = jnp.concatenate([jnp.pad(vb, pad)[:, :-1], vb], axis=2)
    s = jnp.einsum('bnqhgd,bnkhd->bnhgqk', qb, kw,
                   preferred_element_type=jnp.float32) * (dh ** -0.5)
    qpos = jnp.arange(ATTN_BLOCK)[:, None] + ATTN_BLOCK
    kpos = jnp.arange(2 * ATTN_BLOCK)[None, :]
    dist = qpos - kpos
    blk = jnp.arange(nb)
    valid = ((dist >= 0) & (dist < WINDOW))[None] & \
        ((blk[:, None, None] > 0) | (kpos[None] >= ATTN_BLOCK))
    slopes = _alibi_slopes(N_Q_ATTN).reshape(N_KV_ATTN, G)
    s = s - slopes[:, :, None, None] * dist.astype(jnp.float32)
    s = jnp.where(valid[None, :, None, None], s, NEG_INF)
    sink = sinks.astype(jnp.float32).reshape(N_KV_ATTN, G)[None, None, :, :, None, None]
    m = jnp.maximum(s.max(-1, keepdims=True), sink)
    p = jnp.exp(s - m)
    p = p / (p.sum(-1, keepdims=True) + jnp.exp(sink - m))
    o = jnp.einsum('bnhgqk,bnkhd->bnqhgd', p.astype(v.dtype), vw)
    return o.reshape(B, S, N_Q_ATTN * dh)


def _retention(q, k, v):
    B, S, H, d = q.shape
    C = RET_CHUNK
    nc = S // C
    log_g = jnp.log1p(-jnp.exp2(-5.0 - jnp.arange(H, dtype=jnp.float32)))
    qc = q.reshape(B, nc, C, H, d).astype(jnp.float32)
    kc = k.reshape(B, nc, C, H, d).astype(jnp.float32) * (d ** -0.5)
    vc = v.reshape(B, nc, C, H, d).astype(jnp.float32)
    idx = jnp.arange(C, dtype=jnp.float32)
    diff = idx[:, None] - idx[None, :]
    dmask = jnp.where(diff >= 0, jnp.exp(log_g[:, None, None] * jnp.maximum(diff, 0.0)), 0.0)
    s = jnp.einsum('bnqhd,bnkhd->bnhqk', qc, kc) * dmask[None, None]
    inner = jnp.einsum('bnhqk,bnkhe->bnqhe', s, vc)
    w_key = jnp.exp(log_g[None, :] * (C - 1.0 - idx)[:, None])
    U = jnp.einsum('bnkhd,bnkhe->bnhde', kc * w_key[None, None, :, :, None], vc)
    g_C = jnp.exp(log_g * C)[None, :, None, None]

    def step(R, U_c):
        return g_C * R + U_c, R

    R0 = jnp.zeros((B, H, d, d), jnp.float32)
    _, R_prev = lax.scan(step, R0, jnp.moveaxis(U, 1, 0))
    R_prev = jnp.moveaxis(R_prev, 0, 1)
    w_q = jnp.exp(log_g[None, :] * (idx + 1.0)[:, None])
    cross = jnp.einsum('bnqhd,bnhde->bnqhe', qc * w_q[None, None, :, :, None], R_prev)
    return (inner + cross).reshape(B, S, H, d)


def _head_group_norm(o, w):
    B, S, H, d = o.shape
    mu = o.mean(-1, keepdims=True)
    var = jnp.square(o - mu).mean(-1, keepdims=True)
    y = (o - mu) * lax.rsqrt(var + LN_EPS)
    return y.reshape(B, S, H * d) * w.astype(jnp.float32)


def _hybrid_mixer(h, w_in, attn_sinks, attn_norm_w, ret_norm_w, w_out):
    B, S, _ = h.shape
    proj = jnp.einsum('bsd,de->bse', h, w_in)
    offs = [D_ATTN, D_ATTN + D_KV, D_ATTN + 2 * D_KV,
            D_ATTN + 2 * D_KV + D_RET, D_ATTN + 2 * D_KV + 2 * D_RET,
            D_ATTN + 2 * D_KV + 3 * D_RET]
    q_a, k_a, v_a, q_r, k_r, v_r, g_r = jnp.split(proj, offs, axis=-1)
    a = _sliding_window_attention(
        q_a.reshape(B, S, N_Q_ATTN, HEAD_DIM_ATTN),
        k_a.reshape(B, S, N_KV_ATTN, HEAD_DIM_ATTN),
        v_a.reshape(B, S, N_KV_ATTN, HEAD_DIM_ATTN), attn_sinks)
    a = _rms_norm(a, attn_norm_w)
    r = _retention(q_r.reshape(B, S, N_RET, HEAD_DIM_RET),
                   k_r.reshape(B, S, N_RET, HEAD_DIM_RET),
                   v_r.reshape(B, S, N_RET, HEAD_DIM_RET))
    r = (_head_group_norm(r, ret_norm_w) * jax.nn.silu(g_r.astype(jnp.float32))).astype(h.dtype)
    y = jnp.concatenate([a.astype(h.dtype), r], axis=-1)
    return jnp.einsum('bse,ed->bsd', y, w_out)


def _memory_attention(h, mem, w_q, w_kv, w_o):
    B, S, _ = h.shape
    M = mem.shape[1]
    q = jnp.einsum('bsd,de->bse', h, w_q).reshape(B, S, N_MEM_HEADS, HEAD_DIM_MEM)
    k, v = jnp.split(jnp.einsum('bmd,de->bme', mem, w_kv), 2, axis=-1)
    k = k.reshape(B, M, N_MEM_HEADS, HEAD_DIM_MEM)
    v = v.reshape(B, M, N_MEM_HEADS, HEAD_DIM_MEM)
    s = jnp.einsum('bshd,bmhd->bhsm', q, k, preferred_element_type=jnp.float32) * (HEAD_DIM_MEM ** -0.5)
    p = jax.nn.softmax(s, axis=-1)
    o = jnp.einsum('bhsm,bmhd->bshd', p.astype(v.dtype), v).reshape(B, S, D_MODEL)
    return jnp.einsum('bse,ed->bsd', o, w_o)


def _moe(h, w_router, b_router, w_gate_up, b_gate_up, w_down, b_down):
    B, S, D = h.shape
    T = B * S
    A = T * TOP_K
    xt = h.reshape(T, D)
    logits = (jnp.einsum('td,de->te', xt, w_router) + b_router).astype(jnp.float32)
    top_v, top_i = lax.top_k(logits, TOP_K)
    gates = jax.nn.softmax(top_v, axis=-1)
    e_flat = top_i.reshape(A).astype(jnp.int32)
    tok_flat = jnp.arange(A, dtype=jnp.int32) // TOP_K
    g_flat = gates.reshape(A)
    order = jnp.argsort(e_flat)
    e_s, tok_s, g_s = e_flat[order], tok_flat[order], g_flat[order]
    counts = jnp.zeros((N_EXPERTS,), jnp.int32).at[e_flat].add(1)
    start = jnp.cumsum(counts) - counts
    padded = ((counts + MOE_BLOCK - 1) // MOE_BLOCK) * MOE_BLOCK
    pad_end = jnp.cumsum(padded)
    pad_start = pad_end - padded
    dest = pad_start[e_s] + (jnp.arange(A, dtype=jnp.int32) - start[e_s])
    n_blocks = (A + N_EXPERTS * (MOE_BLOCK - 1) + MOE_BLOCK - 1) // MOE_BLOCK
    P = n_blocks * MOE_BLOCK
    slot_tok = jnp.zeros((P,), jnp.int32).at[dest].set(tok_s)
    slot_gate = jnp.zeros((P,), jnp.float32).at[dest].set(g_s)
    block_expert = jnp.minimum(
        jnp.searchsorted(pad_end, jnp.arange(n_blocks, dtype=jnp.int32) * MOE_BLOCK, side='right'),
        N_EXPERTS - 1).astype(jnp.int32)

    def body(acc, blk):
        tok, gate, e = blk
        xb = xt[tok]
        gu = xb @ w_gate_up[e] + b_gate_up[e]
        gl, up = jnp.split(gu, 2, axis=-1)
        gl = jnp.minimum(gl, SWIGLU_LIMIT)
        up = jnp.clip(up, -SWIGLU_LIMIT, SWIGLU_LIMIT)
        act = (up + 1.0) * (gl * jax.nn.sigmoid(SWIGLU_ALPHA * gl))
        yb = (act @ w_down[e] + b_down[e]).astype(jnp.float32)
        return acc.at[tok].add(yb * gate[:, None]), None

    acc0 = jnp.zeros((T, D), jnp.float32)
    out, _ = lax.scan(body, acc0, (slot_tok.reshape(n_blocks, MOE_BLOCK),
                                   slot_gate.reshape(n_blocks, MOE_BLOCK), block_expert))
    return out.reshape(B, S, D).astype(h.dtype)


def setup_inputs(seed: int = 0) -> dict:
    key = jax.random.key(seed)
    ks = jax.random.split(key, 22)
    f32 = jnp.float32
    L = DEPTH

    def nrm(k, shape, scale):
        return jax.random.normal(k, shape, f32) * scale

    return {
        "x": nrm(ks[0], (BATCH, SEQ, D_MODEL), 1.0),
        "mem": nrm(ks[1], (BATCH, N_MEM, D_MODEL), 1.0),
        "w_in": nrm(ks[2], (L, D_MODEL, D_IN), D_MODEL ** -0.5),
        "attn_sinks": nrm(ks[3], (L, N_Q_ATTN), 0.5),
        "attn_norm_w": 1.0 + nrm(ks[4], (L, D_ATTN), 0.02),
        "ret_norm_w": 1.0 + nrm(ks[5], (L, D_RET), 0.02),
        "w_mix_out": nrm(ks[6], (L, D_MIX, D_MODEL), DN_BETA * D_MIX ** -0.5),
        "ln_mix_w": 1.0 + nrm(ks[7], (L, D_MODEL), 0.02),
        "ln_mix_b": nrm(ks[8], (L, D_MODEL), 0.02),
        "w_mem_q": nrm(ks[9], (L, D_MODEL, D_MODEL), D_MODEL ** -0.5),
        "w_mem_kv": nrm(ks[10], (L, D_MODEL, 2 * D_MODEL), D_MODEL ** -0.5),
        "w_mem_out": nrm(ks[11], (L, D_MODEL, D_MODEL), DN_BETA * D_MODEL ** -0.5),
        "ln_mem_w": 1.0 + nrm(ks[12], (L, D_MODEL), 0.02),
        "ln_mem_b": nrm(ks[13], (L, D_MODEL), 0.02),
        "w_router": nrm(ks[14], (L, D_MODEL, N_EXPERTS), D_MODEL ** -0.5),
        "b_router": nrm(ks[15], (L, N_EXPERTS), 0.01),
        "w_gate_up": nrm(ks[16], (L, N_EXPERTS, D_MODEL, 2 * D_EXPERT), D_MODEL ** -0.5),
        "b_gate_up": nrm(ks[17], (L, N_EXPERTS, 2 * D_EXPERT), 0.01),
        "w_down": nrm(ks[18], (L, N_EXPERTS, D_EXPERT, D_MODEL), DN_BETA * D_EXPERT ** -0.5),
        "b_down": nrm(ks[19], (L, N_EXPERTS, D_MODEL), 0.01),
        "ln_moe_w": 1.0 + nrm(ks[20], (L, D_MODEL), 0.02),
        "ln_moe_b": nrm(ks[21], (L, D_MODEL), 0.02),
    }


def reference(x, mem, w_in, attn_sinks, attn_norm_w, ret_norm_w, w_mix_out, ln_mix_w, ln_mix_b,
              w_mem_q, w_mem_kv, w_mem_out, ln_mem_w, ln_mem_b, w_router, b_router,
              w_gate_up, b_gate_up, w_down, b_down, ln_moe_w, ln_moe_b):
    for l in range(DEPTH):
        h = _hybrid_mixer(x, w_in[l], attn_sinks[l], attn_norm_w[l], ret_norm_w[l], w_mix_out[l])
        x = _layer_norm(DN_ALPHA * x + h, ln_mix_w[l], ln_mix_b[l])
        h = _memory_attention(x, mem, w_mem_q[l], w_mem_kv[l], w_mem_out[l])
        x = _layer_norm(DN_ALPHA * x + h, ln_mem_w[l], ln_mem_b[l])
        h = _moe(x, w_router[l], b_router[l], w_gate_up[l], b_gate_up[l], w_down[l], b_down[l])
        x = _layer_norm(DN_ALPHA * x + h, ln_moe_w[l], ln_moe_b[l])
    return x
```

```cpp
#include <hip/hip_runtime.h>
#include <cstdio>
#include <cstdint>

#ifndef MK_FUSED
#define MK_FUSED 0
#endif

#define LAS __attribute__((address_space(3)))
#define GAS __attribute__((address_space(1)))
typedef unsigned short bf16_t;
typedef short bf16x8 __attribute__((ext_vector_type(8)));
typedef short bf16x4 __attribute__((ext_vector_type(4)));
typedef float f32x4 __attribute__((ext_vector_type(4)));
typedef float f32x2 __attribute__((ext_vector_type(2)));
typedef unsigned u32x4 __attribute__((ext_vector_type(4)));
typedef unsigned u32x2 __attribute__((ext_vector_type(2)));

constexpr int BATCH = 2, SEQ = 16384, T = BATCH * SEQ, D = 2048;
constexpr int DIN = 5376;
constexpr int OFF_QA = 0, OFF_KA = 1024, OFF_VA = 1152, OFF_QR = 1280, OFF_KR = 2304, OFF_VR = 3328, OFF_GR = 4352;
constexpr int NCH = SEQ / 128;
constexpr int NEXP = 32, NBLK_MAX = 544, NSLOT = NBLK_MAX * 256;
constexpr float LN_EPS = 1e-5f;
constexpr float DN_ALPHA = 1.18920711500272f;
constexpr int NWAVES = 8, NTHR = 512;

constexpr size_t MiB = (size_t)1 << 20;
constexpr size_t WS_CTL = 0, CTL_ZERO_BYTES = 1 * MiB;
constexpr size_t WS_WIN = 1 * MiB;
constexpr size_t WS_WMIX = WS_WIN + 21 * MiB;
constexpr size_t WS_WQN = WS_WMIX + 8 * MiB;
constexpr size_t WS_WKV = WS_WQN + 8 * MiB;
constexpr size_t WS_WO = WS_WKV + 16 * MiB;
constexpr size_t WS_WR = WS_WO + 8 * MiB;
constexpr size_t WS_WGU = WS_WR + 1 * MiB;
constexpr size_t WS_WD = WS_WGU + 512 * MiB;
constexpr size_t WS_MEMB = WS_WD + 256 * MiB;
constexpr size_t WS_KV = WS_MEMB + 2 * MiB;
constexpr size_t WS_WQK = WS_KV + 4 * MiB;
constexpr size_t WS_WVO = WS_WQK + 8 * MiB;
constexpr size_t WS_SMALL = WS_WVO + 8 * MiB;
constexpr size_t WS_RT = WS_SMALL + 16 * MiB;
constexpr size_t WS_SP = WS_RT + 64 * MiB;
constexpr size_t WS_X1B = WS_SP + 64 * MiB;
constexpr size_t WS_X2B = WS_X1B + 128 * MiB;
constexpr size_t WS_X2 = WS_X2B + 128 * MiB;
constexpr size_t WS_R1 = WS_X2 + 256 * MiB;
constexpr size_t WS_XB = WS_R1;
constexpr size_t WS_PROJ = WS_XB + 128 * MiB;
constexpr size_t WS_U = WS_PROJ + 336 * MiB;
constexpr size_t WS_ACT = WS_R1;
constexpr size_t WS_R2 = WS_R1 + 592 * MiB;
constexpr size_t WS_Y = WS_R2;
constexpr size_t WS_Z = WS_Y + 128 * MiB;
constexpr size_t WS_X1 = WS_Z + 256 * MiB;
constexpr size_t WS_YS = WS_R2;
constexpr size_t WS_END = WS_R2 + 640 * MiB;
static_assert((size_t)NSLOT * 2048 * 2 <= 592 * MiB && (size_t)NSLOT * 2048 * 2 <= 640 * MiB, "overlay sizes");
constexpr size_t SM_LOGITS = 0;
constexpr size_t SM_TOKE = 4 * MiB;
constexpr size_t SM_TOKP = 5 * MiB;
constexpr size_t SM_GATE = 6 * MiB;
constexpr size_t SM_INV = 7 * MiB;
constexpr size_t SM_SLOT = 8 * MiB;
constexpr int CW_BAR = 4096, CW_CNT = 8192;

constexpr int RING_BYTES = 139264;
constexpr int IDX_OFF = RING_BYTES;
constexpr int TAB_OFF = RING_BYTES + 1024;
constexpr int MISC_OFF = RING_BYTES + 1024 + 4096;
constexpr int LDS_BYTES = 147456;
static_assert(MISC_OFF + 256 <= LDS_BYTES, "lds map");

__device__ __forceinline__ unsigned f2bf(float f) { unsigned u = __float_as_uint(f); return (u + 0x7fffu + ((u >> 16) & 1u)) >> 16; }
__device__ __forceinline__ unsigned pk2(float lo, float hi) { return f2bf(lo) | (f2bf(hi) << 16); }
__device__ __forceinline__ float bf2f(unsigned b) { return __uint_as_float(b << 16); }
__device__ __forceinline__ unsigned cvt_pk_bf16(float lo, float hi) { unsigned r; asm volatile("v_cvt_pk_bf16_f32 %0, %1, %2" : "=v"(r) : "v"(lo), "v"(hi)); return r; }
__device__ __forceinline__ f32x4 mfma16(bf16x8 a, bf16x8 b, f32x4 c) { return __builtin_amdgcn_mfma_f32_16x16x32_bf16(a, b, c, 0, 0, 0); }
__device__ __forceinline__ float wave_sum(float v) {
#pragma unroll
    for (int o = 1; o < 64; o <<= 1) v += __shfl_xor(v, o);
    return v;
}
__device__ __forceinline__ float wave_max(float v) {
#pragma unroll
    for (int o = 1; o < 64; o <<= 1) v = fmaxf(v, __shfl_xor(v, o));
    return v;
}
__device__ __forceinline__ float grp16_sum(float v) { v += __shfl_xor(v, 1); v += __shfl_xor(v, 2); v += __shfl_xor(v, 4); v += __shfl_xor(v, 8); return v; }
__device__ __forceinline__ float grp16_max(float v) { v = fmaxf(v, __shfl_xor(v, 1)); v = fmaxf(v, __shfl_xor(v, 2)); v = fmaxf(v, __shfl_xor(v, 4)); v = fmaxf(v, __shfl_xor(v, 8)); return v; }
__device__ __forceinline__ bf16x8 tr_frag(const LAS unsigned char* p, int rs4) {
    const bf16x4 lo = __builtin_amdgcn_ds_read_tr16_b64_v4i16((LAS bf16x4*)p);
    const bf16x4 hi = __builtin_amdgcn_ds_read_tr16_b64_v4i16((LAS bf16x4*)(p + rs4));
    return (bf16x8){lo[0], lo[1], lo[2], lo[3], hi[0], hi[1], hi[2], hi[3]};
}

namespace pg8 {
constexpr int BM = 256, BK = 64, HALF = 128, HTB = HALF * BK * 2, STAGE_BYTES = 8 * HTB, NXCD = 8, WGM = 8;
__host__ __device__ __forceinline__ int lds_byte(int r, int c) { const int st = (r >> 4) * 2 + (c >> 5), rr = r & 15, cc = c & 31, ob = rr * 64 + cc * 2; return st * 1024 + (ob ^ (((ob >> 9) & 1) << 5)); }
__host__ __device__ __forceinline__ void stage_rc(int b, int& R, int& C) { const int st = b / 1024, sb = b % 1024, swz = sb ^ (((sb >> 9) & 1) << 5); R = (st >> 1) * 16 + swz / 64; C = (st & 1) * 32 + (swz % 64) / 2; }
__host__ __device__ __forceinline__ int perm32(int rho) { const int n = rho >> 4, i = rho & 15; return 8 * (i >> 2) + 4 * n + (i & 3); }

struct Unit { int pm, pn, orow, ocol, aux; };

struct StaticOrder {
    int nM, nN, nwg, G, c;
    __device__ void init(int nM_, int nN_, int G_, int c_) { nM = nM_; nN = nN_; nwg = nM * nN; G = G_; c = c_; }
    __device__ bool next(int i, int& pm, int& pn) const {
        const long L = (long)i * G + c; if (L >= nwg) return false;
        int wgid = (int)L; { const int q = nwg / NXCD, r = nwg % NXCD, xcd = wgid % NXCD, off = wgid / NXCD; wgid = (xcd < r ? xcd * (q + 1) : r * (q + 1) + (xcd - r) * q) + off; }
        const int nig = WGM * nN, gid = wgid / nig, fm = gid * WGM, gsz = (nM - fm) < WGM ? (nM - fm) : WGM;
        pm = fm + ((wgid % nig) % gsz); pn = (wgid % nig) / gsz; return true;
    }
};

template <class Epi, class Prob>
__device__ __forceinline__ void gemm_phase(LAS unsigned char* lds, LAS unsigned char* idxtab, const Prob& P, const Epi& E) {
    const int tid = threadIdx.x, wid = __builtin_amdgcn_readfirstlane(tid >> 6), lane = tid & 63, wr = wid >> 2, wc = wid & 3, fr = lane & 15, fq = lane >> 4;
    const int K = P.K, nt = K / BK;
    constexpr bool GATHER = Prob::GATHER;
    const unsigned lda2 = (unsigned)P.lda * 2u, ldb2 = (unsigned)P.ldb * 2u;
    unsigned voffB[2], oc[2][2], on[2][2]; int rA[2]; unsigned cA2[2];
#pragma unroll
    for (int i = 0; i < 2; ++i) { int R, C; stage_rc(tid * 16 + i * 8192, R, C); const int Rb = Epi::PERM ? ((R & ~31) + perm32(R & 31)) : R;
        voffB[i] = (unsigned)Rb * ldb2 + (unsigned)C * 2u; rA[i] = R; cA2[i] = (unsigned)C * 2u;
#pragma unroll
        for (int h = 0; h < 2; ++h) { oc[h][i] = (unsigned)(R + h * HALF) * lda2 + (unsigned)C * 2u; on[h][i] = oc[h][i]; } }
    const size_t kstep = (size_t)(BK * 2);
    const size_t hstepB = (size_t)HALF * ldb2;
    const unsigned ldsw = (unsigned)wid * 1024u;
    const int aoff = lds_byte(wr * 64 + fr, fq * 8), boff = lds_byte(wc * 32 + fr, fq * 8);
#define PG8_SA(b, h) (((b) * 2 + (h)) * HTB)
#define PG8_SB(b, h) ((4 + (b) * 2 + (h)) * HTB)
#define PG8_STAGE(bufoff, gbase, voff) do { _Pragma("unroll") for (int _i = 0; _i < 2; ++_i) \
        __builtin_amdgcn_global_load_lds((const unsigned*)((const char*)(gbase) + (voff)[_i]), (LAS unsigned*)(lds + (bufoff) + ldsw + _i * 8192), 16, 0, 0); } while (0)
#define PG8_LDA(dst, b, h) do { _Pragma("unroll") for (int m = 0; m < 4; ++m) _Pragma("unroll") for (int k = 0; k < 2; ++k) dst[m][k] = *(const LAS bf16x8*)(lds + PG8_SA(b, h) + aoff + m * 2048 + k * 1024); } while (0)
#define PG8_LDB(dst, b, h) do { _Pragma("unroll") for (int n = 0; n < 2; ++n) _Pragma("unroll") for (int k = 0; k < 2; ++k) dst[n][k] = *(const LAS bf16x8*)(lds + PG8_SB(b, h) + boff + n * 2048 + k * 1024); } while (0)
#define PG8_MMA(ai, bj, At, Bt) do { __builtin_amdgcn_s_setprio(1); _Pragma("unroll") for (int m = 0; m < 4; ++m) _Pragma("unroll") for (int n = 0; n < 2; ++n) _Pragma("unroll") for (int k = 0; k < 2; ++k) \
        acc[ai][bj][m][n] = __builtin_amdgcn_mfma_f32_16x16x32_bf16(Bt[n][k], At[m][k], acc[ai][bj][m][n], 0, 0, 0); __builtin_amdgcn_s_setprio(0); } while (0)
#define PG8_WAIT_V(n) asm volatile("s_waitcnt vmcnt(" #n ")" ::: "memory")
#define PG8_WAIT_L(n) asm volatile("s_waitcnt lgkmcnt(" #n ")" ::: "memory")
#define PG8_BAR __builtin_amdgcn_s_barrier()
#define PG8_SCHED __builtin_amdgcn_sched_barrier(0)
    Unit cur, nxt; int ui = 0;
    if (!P.next(0, cur)) return;
    f32x4 acc[2][2][4][2];
#pragma unroll
    for (int a = 0; a < 2; ++a)
#pragma unroll
        for (int b = 0; b < 2; ++b)
#pragma unroll
            for (int m = 0; m < 4; ++m)
#pragma unroll
                for (int n = 0; n < 2; ++n) acc[a][b][m][n] = (f32x4){0.f, 0.f, 0.f, 0.f};
    bf16x8 At[4][2], B0[2][2], B1[2][2];
    const char* cA = P.a_ptr(cur); const char* cB = P.b_ptr(cur);
    if constexpr (GATHER) {
        if (wid < 4) __builtin_amdgcn_global_load_lds((const unsigned*)(P.idx_ptr(cur) + wid * 64 + lane), (LAS unsigned*)(idxtab + wid * 256), 4, 0, 0);
        PG8_WAIT_V(0); PG8_BAR;
#pragma unroll
        for (int i = 0; i < 2; ++i)
#pragma unroll
            for (int h = 0; h < 2; ++h) oc[h][i] = ((const LAS unsigned*)idxtab)[h * HALF + rA[i]] * lda2 + cA2[i];
        PG8_WAIT_L(0); PG8_BAR;
    }
    PG8_STAGE(PG8_SB(0, 0), cB, voffB); PG8_STAGE(PG8_SB(0, 1), cB + hstepB, voffB); PG8_STAGE(PG8_SA(0, 0), cA, oc[0]); PG8_STAGE(PG8_SA(0, 1), cA, oc[1]);
    if (wr == 1) PG8_BAR;
    PG8_WAIT_V(2); PG8_BAR;
    PG8_STAGE(PG8_SB(1, 0), cB + kstep, voffB); PG8_STAGE(PG8_SA(1, 0), cA + kstep, oc[0]); PG8_STAGE(PG8_SB(1, 1), cB + hstepB + kstep, voffB);
    PG8_WAIT_V(6); PG8_BAR;
    for (;;) {
        const bool has_next = P.next(ui + 1, nxt);
        const char* nA = has_next ? P.a_ptr(nxt) : cA; const char* nB = has_next ? P.b_ptr(nxt) : cB;
        if constexpr (GATHER) { if (has_next && wid < 4) __builtin_amdgcn_global_load_lds((const unsigned*)(P.idx_ptr(nxt) + wid * 64 + lane), (LAS unsigned*)(idxtab + wid * 256), 4, 0, 0); }
        for (int t = 0; t < nt; t += 2) {
            const bool last = (t == nt - 2);
            const char* a1 = cA + (size_t)(t + 1) * kstep;
            const char* a2 = last ? nA : cA + (size_t)(t + 2) * kstep; const char* b2 = last ? nB : cB + (size_t)(t + 2) * kstep;
            const char* a3 = a2 + kstep; const char* b3 = b2 + kstep;
            unsigned os[2][2];
            if constexpr (GATHER) {
                if (last && has_next) {
#pragma unroll
                    for (int i = 0; i < 2; ++i)
#pragma unroll
                        for (int h = 0; h < 2; ++h) on[h][i] = ((const LAS unsigned*)idxtab)[h * HALF + rA[i]] * lda2 + cA2[i];
                }
#pragma unroll
                for (int i = 0; i < 2; ++i)
#pragma unroll
                    for (int h = 0; h < 2; ++h) os[h][i] = last ? on[h][i] : oc[h][i];
            } else {
#pragma unroll
                for (int i = 0; i < 2; ++i)
#pragma unroll
                    for (int h = 0; h < 2; ++h) os[h][i] = oc[h][i];
            }
            PG8_LDB(B0, 0, 0); PG8_LDB(B1, 0, 1); PG8_SCHED; PG8_LDA(At, 0, 0); PG8_STAGE(PG8_SA(1, 1), a1, oc[1]);
            PG8_WAIT_V(8); PG8_WAIT_L(0); PG8_BAR; PG8_MMA(0, 0, At, B0); PG8_MMA(0, 1, At, B1); PG8_BAR; PG8_SCHED;
            PG8_LDA(At, 0, 1); PG8_STAGE(PG8_SB(0, 0), b2, voffB); PG8_STAGE(PG8_SB(0, 1), b2 + hstepB, voffB); PG8_STAGE(PG8_SA(0, 0), a2, os[0]);
            PG8_WAIT_V(8); PG8_WAIT_L(0); PG8_BAR; PG8_MMA(1, 0, At, B0); PG8_MMA(1, 1, At, B1); PG8_BAR; PG8_SCHED;
            PG8_LDB(B0, 1, 0); PG8_LDB(B1, 1, 1); PG8_SCHED; PG8_LDA(At, 1, 0); PG8_STAGE(PG8_SA(0, 1), a2, os[1]);
            PG8_WAIT_V(8); PG8_WAIT_L(0); PG8_BAR; PG8_MMA(0, 0, At, B0); PG8_MMA(0, 1, At, B1); PG8_BAR; PG8_SCHED;
            PG8_LDA(At, 1, 1); PG8_STAGE(PG8_SB(1, 0), b3, voffB); PG8_STAGE(PG8_SB(1, 1), b3 + hstepB, voffB); PG8_STAGE(PG8_SA(1, 0), a3, os[0]);
            PG8_WAIT_V(8); PG8_WAIT_L(0); PG8_BAR; PG8_MMA(1, 0, At, B0); PG8_MMA(1, 1, At, B1); PG8_BAR; PG8_SCHED;
        }
        if (wr == 0) PG8_BAR;
        E(acc, cur, wr, wc, fr, fq);
        if (!has_next) break;
#pragma unroll
        for (int a = 0; a < 2; ++a)
#pragma unroll
            for (int b = 0; b < 2; ++b)
#pragma unroll
                for (int m = 0; m < 4; ++m)
#pragma unroll
                    for (int n = 0; n < 2; ++n) acc[a][b][m][n] = (f32x4){0.f, 0.f, 0.f, 0.f};
        cur = nxt; cA = nA; cB = nB; ++ui;
        if constexpr (GATHER) {
#pragma unroll
            for (int i = 0; i < 2; ++i)
#pragma unroll
                for (int h = 0; h < 2; ++h) oc[h][i] = on[h][i];
        }
        if (wr == 1) PG8_BAR;
    }
    PG8_WAIT_V(0);
    PG8_BAR;
#undef PG8_SA
#undef PG8_SB
#undef PG8_STAGE
#undef PG8_LDA
#undef PG8_LDB
#undef PG8_MMA
#undef PG8_WAIT_V
#undef PG8_WAIT_L
#undef PG8_BAR
#undef PG8_SCHED
}

struct EpiBf16 {
    static constexpr bool PERM = true;
    bf16_t* O; int ldc; const float* bias; int bias_stride; float scale;
    __device__ __forceinline__ void operator()(const f32x4 (&acc)[2][2][4][2], const Unit& u, int wr, int wc, int fr, int fq) const {
        const int row0 = u.orow + wr * 64 + fr, col0 = u.ocol + wc * 32 + 8 * fq;
        f32x4 bv[2][2];
#pragma unroll
        for (int bj = 0; bj < 2; ++bj)
#pragma unroll
            for (int n = 0; n < 2; ++n) bv[bj][n] = bias ? *(const f32x4*)(bias + (size_t)u.aux * bias_stride + col0 + bj * HALF + 4 * n) : (f32x4){0.f, 0.f, 0.f, 0.f};
#pragma unroll
        for (int ai = 0; ai < 2; ++ai)
#pragma unroll
            for (int m = 0; m < 4; ++m) { bf16_t* rowp = O + (size_t)(row0 + ai * HALF + m * 16) * ldc + col0;
#pragma unroll
                for (int bj = 0; bj < 2; ++bj) { f32x4 v0 = (acc[ai][bj][m][0] + bv[bj][0]) * scale, v1 = (acc[ai][bj][m][1] + bv[bj][1]) * scale;
                    u32x4 w; w.x = cvt_pk_bf16(v0[0], v0[1]); w.y = cvt_pk_bf16(v0[2], v0[3]); w.z = cvt_pk_bf16(v1[0], v1[1]); w.w = cvt_pk_bf16(v1[2], v1[3]);
                    *(u32x4*)(rowp + bj * HALF) = w; } }
    }
};
struct EpiResF32 {
    static constexpr bool PERM = false;
    const float* res; float* out; int ldc; float alpha;
    __device__ __forceinline__ void operator()(const f32x4 (&acc)[2][2][4][2], const Unit& u, int wr, int wc, int fr, int fq) const {
        const int row0 = u.orow + wr * 64 + fr, col0 = u.ocol + wc * 32 + 4 * fq;
#pragma unroll
        for (int ai = 0; ai < 2; ++ai)
#pragma unroll
            for (int m = 0; m < 4; ++m) { const size_t off = (size_t)(row0 + ai * HALF + m * 16) * ldc + col0;
#pragma unroll
                for (int bj = 0; bj < 2; ++bj)
#pragma unroll
                    for (int n = 0; n < 2; ++n) { const f32x4 r = *(const f32x4*)(res + off + bj * HALF + n * 16); *(f32x4*)(out + off + bj * HALF + n * 16) = r * alpha + acc[ai][bj][m][n]; }
                if (m & 1) asm volatile("" ::: "memory"); }
    }
};
struct EpiRouter {
    static constexpr bool PERM = false;
    float* out; const float* bias;
    __device__ __forceinline__ void operator()(const f32x4 (&acc)[2][2][4][2], const Unit& u, int wr, int wc, int fr, int fq) const {
        if (wc != 0) return;
        const int row0 = u.orow + wr * 64 + fr;
#pragma unroll
        for (int ai = 0; ai < 2; ++ai)
#pragma unroll
            for (int m = 0; m < 4; ++m)
#pragma unroll
                for (int n = 0; n < 2; ++n) { const int c = 16 * n + 4 * fq; const f32x4 b = *(const f32x4*)(bias + c);
                    *(f32x4*)(out + (size_t)(row0 + ai * HALF + m * 16) * 32 + c) = acc[ai][0][m][n] + b; }
    }
};
struct EpiSwiglu {
    static constexpr bool PERM = true;
    bf16_t* O; const float* bias;
    __device__ __forceinline__ void operator()(const f32x4 (&acc)[2][2][4][2], const Unit& u, int wr, int wc, int fr, int fq) const {
        const int row0 = u.orow + wr * 64 + fr, col0 = u.ocol + wc * 32 + 8 * fq;
        const float* bg = bias + (size_t)u.aux * 4096 + col0; const float* bu = bg + 2048;
        const f32x4 g0 = *(const f32x4*)bg, g1 = *(const f32x4*)(bg + 4), u0 = *(const f32x4*)bu, u1 = *(const f32x4*)(bu + 4);
#pragma unroll
        for (int ai = 0; ai < 2; ++ai)
#pragma unroll
            for (int m = 0; m < 4; ++m) {
                f32x4 gl0 = acc[ai][0][m][0] + g0, gl1 = acc[ai][0][m][1] + g1, up0 = acc[ai][1][m][0] + u0, up1 = acc[ai][1][m][1] + u1;
                float r[8];
#pragma unroll
                for (int j = 0; j < 4; ++j) {
                    { const float g = fminf(gl0[j], 7.0f), uu = fminf(fmaxf(up0[j], -7.0f), 7.0f); const float sg = __builtin_amdgcn_rcpf(1.0f + __expf(-1.702f * g)); r[j] = (uu + 1.0f) * (g * sg); }
                    { const float g = fminf(gl1[j], 7.0f), uu = fminf(fmaxf(up1[j], -7.0f), 7.0f); const float sg = __builtin_amdgcn_rcpf(1.0f + __expf(-1.702f * g)); r[4 + j] = (uu + 1.0f) * (g * sg); }
                }
                u32x4 w; w.x = cvt_pk_bf16(r[0], r[1]); w.y = cvt_pk_bf16(r[2], r[3]); w.z = cvt_pk_bf16(r[4], r[5]); w.w = cvt_pk_bf16(r[6], r[7]);
                *(u32x4*)(O + (size_t)(row0 + ai * HALF + m * 16) * 2048 + col0) = w; }
    }
};

struct ProbStd {
    static constexpr bool GATHER = false;
    const bf16_t* A; const bf16_t* Bt; int K, lda, ldb; StaticOrder S; int split_pm; size_t b_split_stride; int orow_extra;
    __device__ void init(const bf16_t* A_, const bf16_t* Bt_, int M, int N, int K_, int lda_, int ldb_, int G, int c) { A = A_; Bt = Bt_; K = K_; lda = lda_; ldb = ldb_; S.init(M / BM, N / BM, G, c); split_pm = 1 << 30; b_split_stride = 0; orow_extra = 0; }
    __device__ bool next(int i, Unit& u) const { if (!S.next(i, u.pm, u.pn)) return false; u.orow = u.pm * BM; u.ocol = u.pn * BM; u.aux = 0; return true; }
    __device__ const char* a_ptr(const Unit& u) const { return (const char*)(A + (size_t)u.pm * BM * lda); }
    __device__ const char* b_ptr(const Unit& u) const { return (const char*)(Bt + (size_t)u.pn * BM * ldb + (u.pm >= split_pm ? b_split_stride : 0)); }
    __device__ const int* idx_ptr(const Unit&) const { return nullptr; }
};
struct ProbFoldA {
    static constexpr bool GATHER = false;
    const bf16_t* kv; const bf16_t* wq; int K, lda, ldb, G, c;
    __device__ bool next(int i, Unit& u) const { const int L = i * G + c; if (L >= 64) return false; const int bh = L >> 3; u.pm = bh; u.pn = L & 7; u.orow = (bh >> 2) * 1024 + (bh & 3) * 256; u.ocol = u.pn * 256; u.aux = 0; return true; }
    __device__ const char* a_ptr(const Unit& u) const { const int b = u.pm >> 2, h = u.pm & 3; return (const char*)(kv + (size_t)b * 256 * 4096 + h * 512); }
    __device__ const char* b_ptr(const Unit& u) const { const int h = u.pm & 3; return (const char*)(wq + (size_t)u.pn * 256 * 2048 + h * 512); }
    __device__ const int* idx_ptr(const Unit&) const { return nullptr; }
};
struct ProbFoldB {
    static constexpr bool GATHER = false;
    const bf16_t* woT; const bf16_t* kv; int K, lda, ldb, G, c;
    __device__ bool next(int i, Unit& u) const { const int L = i * G + c; if (L >= 64) return false; const int bh = L >> 3; u.pm = L & 7; u.pn = bh; u.orow = (bh >> 2) * 2048 + u.pm * 256; u.ocol = (bh & 3) * 256; u.aux = 0; return true; }
    __device__ const char* a_ptr(const Unit& u) const { const int h = u.pn & 3; return (const char*)(woT + (size_t)u.pm * 256 * 2048 + h * 512); }
    __device__ const char* b_ptr(const Unit& u) const { const int b = u.pn >> 2, h = u.pn & 3; return (const char*)(kv + (size_t)b * 256 * 4096 + 2048 + h * 512); }
    __device__ const int* idx_ptr(const Unit&) const { return nullptr; }
};
template <bool G1> struct ProbMoe {
    static constexpr bool GATHER = G1;
    const bf16_t* A; const bf16_t* W; const int* slot_tok; const LAS int* blkexp; int K, lda, ldb; StaticOrder S;
    __device__ bool next(int i, Unit& u) const { if (!S.next(i, u.pm, u.pn)) return false; u.orow = u.pm * BM; u.ocol = u.pn * (G1 ? 128 : 256); u.aux = blkexp[u.pm]; return true; }
    __device__ const char* a_ptr(const Unit& u) const { return G1 ? (const char*)A : (const char*)(A + (size_t)u.pm * BM * lda); }
    __device__ const char* b_ptr(const Unit& u) const { return (const char*)(W + ((size_t)u.aux * (G1 ? 4096 : 2048) + (size_t)u.pn * BM) * 2048); }
    __device__ const int* idx_ptr(const Unit& u) const { return slot_tok + u.pm * BM; }
};
}

#define XB_TMO      128
#define XB_XCNT(j)  (256  + 64 * (j))
#define XB_XSUB(j)  (1280 + 64 * (j))
#define XB_XGEN(j)  (2304 + 64 * (j))
#define XB_TOP      3328
#define XB_TOPGEN   3392
#define XCD_BAR_WORDS 3456
#define XB_SPIN_CAP (1u << 18)
__device__ __forceinline__ unsigned xb_ld(unsigned* p)              { return __hip_atomic_load(p, __ATOMIC_RELAXED, __HIP_MEMORY_SCOPE_AGENT); }
__device__ __forceinline__ unsigned xb_add(unsigned* p, unsigned v) { return __hip_atomic_fetch_add(p, v, __ATOMIC_RELAXED, __HIP_MEMORY_SCOPE_AGENT); }
__device__ __forceinline__ unsigned xb_xcc_id() { return (unsigned)__builtin_amdgcn_s_getreg((3 << 11) | 20) & 0xFu; }
#define XB_SPIN(cond, bar) do { unsigned _sp = 0; while (cond) { __builtin_amdgcn_s_sleep(1); \
    if ((++_sp & 255u) == 0u) { if (xb_ld(&(bar)[XB_TMO])) break; if (_sp > XB_SPIN_CAP) { atomicAdd(&(bar)[XB_TMO], 1u); break; } } } } while (0)
struct XcdBarrier { unsigned* bar; unsigned x; volatile LAS unsigned* st; };
__device__ __forceinline__ XcdBarrier xcd_barrier_post(unsigned* bar, volatile LAS unsigned* st) {
    XcdBarrier b; b.bar = bar; b.x = xb_xcc_id(); b.st = st;
    if (threadIdx.x == 0) (void)xb_add(&bar[XB_XCNT(b.x)], 1u);
    return b;
}
__device__ __forceinline__ void xcd_barrier_complete(unsigned* bar, unsigned x, unsigned& nloc, unsigned& nx) {
    const unsigned G = gridDim.x * gridDim.y * gridDim.z;
    unsigned sum, cnt, mine, sp = 0u;
    for (;;) {
        sum = 0u; cnt = 0u; mine = 0u;
#pragma unroll
        for (unsigned j = 0; j < 16; ++j) { const unsigned c = xb_ld(&bar[XB_XCNT(j)]); sum += c; cnt += (c > 0u) ? 1u : 0u; mine = (j == x) ? c : mine; }
        if (sum == G) break;
        __builtin_amdgcn_s_sleep(1);
        if ((++sp & 255u) == 0u) { if (xb_ld(&bar[XB_TMO])) break; if (sp > XB_SPIN_CAP) { atomicAdd(&bar[XB_TMO], 1u); break; } }
    }
    nloc = mine > 0u ? mine : 1u; nx = cnt > 0u ? cnt : 1u;
}
__device__ __forceinline__ void xcd_barrier(const XcdBarrier& b) {
    asm volatile("s_waitcnt vmcnt(0)" ::: "memory");
    __syncthreads();
    if (threadIdx.x == 0) {
        unsigned* bar = b.bar;
        __builtin_amdgcn_s_waitcnt(0);
        unsigned nloc = b.st[0], nx = b.st[1];
        if (nloc == 0u) { xcd_barrier_complete(bar, b.x, nloc, nx); b.st[0] = nloc; b.st[1] = nx; }
        const unsigned old = xb_add(&bar[XB_XSUB(b.x)], 1u);
        const unsigned gen = old / nloc;
        if (old + 1u == (gen + 1u) * nloc) {
            __builtin_amdgcn_fence(__ATOMIC_RELEASE, "agent");
            asm volatile("s_waitcnt vmcnt(0)" ::: "memory");
            const unsigned og = xb_add(&bar[XB_TOP], 1u);
            const unsigned tg = og / nx;
            if (og + 1u == (tg + 1u) * nx) xb_add(&bar[XB_TOPGEN], 1u);
            else XB_SPIN(xb_ld(&bar[XB_TOPGEN]) == tg, bar);
            __builtin_amdgcn_fence(__ATOMIC_ACQUIRE, "agent");
            xb_add(&bar[XB_XGEN(b.x)], 1u);
            asm volatile("s_waitcnt vmcnt(0)" ::: "memory");
        } else {
            XB_SPIN(xb_ld(&bar[XB_XGEN(b.x)]) == gen, bar);
            __builtin_amdgcn_fence(__ATOMIC_ACQUIRE, "agent");
            asm volatile("s_waitcnt vmcnt(0)" ::: "memory");
        }
    }
    __syncthreads();
}

struct Args {
    const float* in[22]; float* out; unsigned char* ws; int ph_lo, ph_hi;
};
struct Frame {
    LAS unsigned char* lds; int tid, lane, wave, G, bid;
    unsigned char* ws;
};
#define LDS_WAIT() asm volatile("s_waitcnt lgkmcnt(0)" ::: "memory")
#define VM_WAIT() asm volatile("s_waitcnt vmcnt(0)" ::: "memory")

__device__ __forceinline__ void p0_transpose_item(const float* W, int Kdim, int N, bf16_t* WT, int dst_row0, int k0, int n0, LAS float* scr, int lane) {
#pragma unroll 8
    for (int i = 0; i < 32; ++i) { const int kk = 2 * i + (lane >> 5); scr[kk * 33 + (lane & 31)] = W[(size_t)(k0 + kk) * N + n0 + (lane & 31)]; }
    LDS_WAIT(); asm volatile("" ::: "memory");
    const int c = lane & 7;
#pragma unroll
    for (int j = 0; j < 4; ++j) { const int n = (lane >> 3) + 8 * j; const LAS float* s = scr + (8 * c) * 33 + n;
        u32x4 o; o.x = pk2(s[0 * 33], s[1 * 33]); o.y = pk2(s[2 * 33], s[3 * 33]); o.z = pk2(s[4 * 33], s[5 * 33]); o.w = pk2(s[6 * 33], s[7 * 33]);
        *(u32x4*)(WT + (size_t)(dst_row0 + n) * Kdim + k0 + 8 * c) = o; }
    LDS_WAIT(); asm volatile("" ::: "memory");
}
__device__ __forceinline__ void p0_convert(const float* src, bf16_t* dst, size_t n8, size_t i0, size_t stride) {
    for (size_t i = i0; i < n8; i += stride) { const f32x4 a = ((const f32x4*)src)[2 * i], b = ((const f32x4*)src)[2 * i + 1];
        u32x4 o; o.x = pk2(a[0], a[1]); o.y = pk2(a[2], a[3]); o.z = pk2(b[0], b[1]); o.w = pk2(b[2], b[3]); ((u32x4*)dst)[i] = o; }
}
__device__ __forceinline__ void phase_prep(const Frame& F, const Args& a) {
    LAS float* scr = (LAS float*)(F.lds + F.wave * 16384);
    const int gw = F.bid * NWAVES + F.wave, NGW = F.G * NWAVES;
    const float *w_in = a.in[2], *w_mix = a.in[6], *w_q = a.in[9], *w_kv = a.in[10], *w_o = a.in[11], *w_r = a.in[14], *w_gu = a.in[16], *w_d = a.in[18];
    bf16_t *WIN = (bf16_t*)(F.ws + WS_WIN), *WMIX = (bf16_t*)(F.ws + WS_WMIX), *WQN = (bf16_t*)(F.ws + WS_WQN), *WKV = (bf16_t*)(F.ws + WS_WKV), *WO = (bf16_t*)(F.ws + WS_WO),
           *WR = (bf16_t*)(F.ws + WS_WR), *WGU = (bf16_t*)(F.ws + WS_WGU), *WD = (bf16_t*)(F.ws + WS_WD);
    constexpr int I_IN = 32 * (DIN / 32), I_MIX = 32 * 64, I_KV = 32 * 128, I_O = 32 * 64, I_R = 32, I_GU = 32 * 128, I_D = 32 * 64;
    constexpr int NITEMS = I_IN + I_MIX + I_KV + I_O + I_R + NEXP * I_GU + NEXP * I_D;
    for (int it = gw; it < NITEMS; it += NGW) {
        int r = it;
        if (r < I_IN) { const int nblk = DIN / 32, kb = r / nblk, nb = r % nblk; p0_transpose_item(w_in, 2048, DIN, WIN, nb * 32, kb * 64, nb * 32, scr, F.lane); continue; } r -= I_IN;
        if (r < I_MIX) { const int kb = r / 64, nb = r % 64; p0_transpose_item(w_mix, 2048, 2048, WMIX, nb * 32, kb * 64, nb * 32, scr, F.lane); continue; } r -= I_MIX;
        if (r < I_KV) { const int kb = r / 128, nb = r % 128; p0_transpose_item(w_kv, 2048, 4096, WKV, nb * 32, kb * 64, nb * 32, scr, F.lane); continue; } r -= I_KV;
        if (r < I_O) { const int kb = r / 64, nb = r % 64; p0_transpose_item(w_o, 2048, 2048, WO, nb * 32, kb * 64, nb * 32, scr, F.lane); continue; } r -= I_O;
        if (r < I_R) { p0_transpose_item(w_r, 2048, 32, WR, 0, r * 64, 0, scr, F.lane); continue; } r -= I_R;
        if (r < NEXP * I_GU) { const int e = r / I_GU, q = r % I_GU, kb = q / 128, nb = q % 128, n0 = nb * 32;
            const int dst = (n0 < 2048) ? ((n0 >> 7) * 256 + (n0 & 127)) : (((n0 - 2048) >> 7) * 256 + 128 + ((n0 - 2048) & 127));
            p0_transpose_item(w_gu + (size_t)e * 2048 * 4096, 2048, 4096, WGU + (size_t)e * 4096 * 2048, dst, kb * 64, n0, scr, F.lane); continue; } r -= NEXP * I_GU;
        { const int e = r / I_D, q = r % I_D, kb = q / 64, nb = q % 64; p0_transpose_item(w_d + (size_t)e * 2048 * 2048, 2048, 2048, WD + (size_t)e * 2048 * 2048, nb * 32, kb * 64, nb * 32, scr, F.lane); }
    }
    const size_t gt = (size_t)F.bid * NTHR + F.tid, NGT = (size_t)F.G * NTHR;
    p0_convert(w_q, WQN, (size_t)2048 * 2048 / 8, gt, NGT);
    p0_convert(a.in[0], (bf16_t*)(F.ws + WS_XB), (size_t)T * D / 8, gt, NGT);
    p0_convert(a.in[1], (bf16_t*)(F.ws + WS_MEMB), (size_t)512 * 2048 / 8, gt, NGT);
    for (size_t i = gt; i < (size_t)224 * 2048 / 8; i += NGT) ((u32x4*)(WR + 32 * 2048))[i] = (u32x4){0u, 0u, 0u, 0u};
}

constexpr int SWA_KRS = 144;
constexpr int SWA_PRS = 336;
constexpr int SWA_K_OFF = 0, SWA_V_OFF = 256 * SWA_KRS, SWA_P_OFF = 2 * 256 * SWA_KRS, SWA_SSQ_OFF = SWA_P_OFF + 8 * 16 * SWA_PRS;
static_assert(SWA_SSQ_OFF + 512 <= RING_BYTES, "swa lds");
__device__ __forceinline__ void swa_item(const Frame& F, const bf16_t* proj, bf16_t* y, const float* sinks, const float* normw, int b, int n) {
    LAS unsigned char* Kl = F.lds + SWA_K_OFF; LAS unsigned char* Vl = F.lds + SWA_V_OFF; LAS unsigned char* Pl = F.lds + SWA_P_OFF + F.wave * 16 * SWA_PRS;
    LAS float* ssq = (LAS float*)(F.lds + SWA_SSQ_OFF);
    const int lane = F.lane, fr = lane & 15, g = lane >> 4, q4 = (lane & 15) >> 2, p4 = lane & 3;
    const size_t tok0 = (size_t)b * SEQ + (size_t)n * 128;
    if (F.tid < 128) ssq[F.tid] = 0.f;
    for (int h = 0; h < 2; ++h) {
        __syncthreads();
#pragma unroll
        for (int i = 0; i < 4; ++i) { const int id = F.tid + 512 * i, key = id >> 3, c = id & 7;
            u32x4 kv = (u32x4){0u, 0u, 0u, 0u}, vv = kv;
            if (n > 0 || key >= 128) { const bf16_t* src = proj + (tok0 - 128 + key) * DIN + h * 64 + c * 8; kv = *(const u32x4*)(src + OFF_KA); vv = *(const u32x4*)(src + OFF_VA); }
            *(LAS u32x4*)(Kl + key * SWA_KRS + c * 16) = kv; *(LAS u32x4*)(Vl + key * SWA_KRS + c * 16) = vv; }
        __syncthreads();
        const int hq = h * 8 + F.wave;
        const float slope = exp2f(-0.5f * (float)(hq + 1)), sink = sinks[hq];
        for (int rt = 0; rt < 8; ++rt) {
            const int i0 = rt * 16, kt0 = rt < 6 ? rt : 6;
            bf16x8 qf[2];
#pragma unroll
            for (int ks = 0; ks < 2; ++ks) qf[ks] = *(const bf16x8*)(proj + (tok0 + i0 + fr) * DIN + OFF_QA + hq * 64 + ks * 32 + 8 * g);
            f32x4 s[10];
#pragma unroll
            for (int tt = 0; tt < 10; ++tt) { f32x4 acc = (f32x4){0.f, 0.f, 0.f, 0.f};
#pragma unroll
                for (int ks = 0; ks < 2; ++ks) { const bf16x8 kf = *(const LAS bf16x8*)(Kl + ((kt0 + tt) * 16 + fr) * SWA_KRS + (ks * 32 + 8 * g) * 2); acc = mfma16(qf[ks], kf, acc); }
                s[tt] = acc; }
            float mx[4] = {-1e30f, -1e30f, -1e30f, -1e30f};
#pragma unroll
            for (int tt = 0; tt < 10; ++tt)
#pragma unroll
                for (int r = 0; r < 4; ++r) { const int i = i0 + 4 * g + r, j = (kt0 + tt) * 16 + fr, dist = i + 128 - j;
                    const bool valid = dist >= 0 && dist < 128 && (n > 0 || j >= 128);
                    const float v = valid ? s[tt][r] * 0.125f - slope * (float)dist : -1e30f; s[tt][r] = v; mx[r] = fmaxf(mx[r], v); }
            float l[4];
#pragma unroll
            for (int r = 0; r < 4; ++r) { mx[r] = fmaxf(grp16_max(mx[r]), sink); l[r] = 0.f; }
#pragma unroll
            for (int tt = 0; tt < 10; ++tt)
#pragma unroll
                for (int r = 0; r < 4; ++r) { const float p = __expf(s[tt][r] - mx[r]); l[r] += p; *(LAS bf16_t*)(Pl + (4 * g + r) * SWA_PRS + (tt * 16 + fr) * 2) = (bf16_t)f2bf(p); }
#pragma unroll
            for (int r = 0; r < 4; ++r) l[r] = grp16_sum(l[r]) + __expf(sink - mx[r]);
            f32x4 o[4];
#pragma unroll
            for (int dt = 0; dt < 4; ++dt) o[dt] = (f32x4){0.f, 0.f, 0.f, 0.f};
#pragma unroll
            for (int kk = 0; kk < 5; ++kk) { const bf16x8 pf = *(const LAS bf16x8*)(Pl + fr * SWA_PRS + (kk * 32 + 8 * g) * 2);
#pragma unroll
                for (int dt = 0; dt < 4; ++dt) { const bf16x8 vf = tr_frag(Vl + (kt0 * 16 + kk * 32 + 8 * g + q4) * SWA_KRS + (dt * 16 + 4 * p4) * 2, 4 * SWA_KRS); o[dt] = mfma16(pf, vf, o[dt]); } }
            float sq[4] = {0.f, 0.f, 0.f, 0.f};
#pragma unroll
            for (int r = 0; r < 4; ++r) { const float il = 1.0f / l[r];
#pragma unroll
                for (int dt = 0; dt < 4; ++dt) { const float v = o[dt][r] * il; sq[r] += v * v; y[(tok0 + i0 + 4 * g + r) * 2048 + hq * 64 + dt * 16 + fr] = (bf16_t)f2bf(v); } }
#pragma unroll
            for (int r = 0; r < 4; ++r) { const float t = grp16_sum(sq[r]); if (fr == 0) atomicAdd((float*)&ssq[i0 + 4 * g + r], t); }
        }
    }
    VM_WAIT(); __syncthreads();
    for (int id = F.tid; id < 128 * 128; id += NTHR) { const int tk = id >> 7, c = id & 127; const float rs = 1.0f / sqrtf(ssq[tk] * (1.0f / 1024.0f) + LN_EPS);
        bf16_t* p = y + (tok0 + tk) * 2048 + c * 8; const u32x4 v = *(const u32x4*)p; const f32x4 w0 = *(const f32x4*)(normw + c * 8), w1 = *(const f32x4*)(normw + c * 8 + 4);
        u32x4 o; o.x = pk2(bf2f(v.x & 0xffffu) * rs * w0[0], bf2f(v.x >> 16) * rs * w0[1]); o.y = pk2(bf2f(v.y & 0xffffu) * rs * w0[2], bf2f(v.y >> 16) * rs * w0[3]);
        o.z = pk2(bf2f(v.z & 0xffffu) * rs * w1[0], bf2f(v.z >> 16) * rs * w1[1]); o.w = pk2(bf2f(v.w & 0xffffu) * rs * w1[2], bf2f(v.w >> 16) * rs * w1[3]);
        *(u32x4*)p = o; }
    __syncthreads();
}

constexpr int RET_RS = 272;
constexpr int RET_TILE = 128 * RET_RS;
__device__ __forceinline__ float ret_log2g(int h) { return log2f(1.0f - exp2f(-5.0f - (float)h)); }
__device__ __forceinline__ void ret_u_item(const Frame& F, const bf16_t* proj, float* Ut, int b, int c, int h) {
    LAS unsigned char* Kl = F.lds; LAS unsigned char* Vl = F.lds + RET_TILE;
    const int lane = F.lane, fr = lane & 15, g = lane >> 4, q4 = (lane & 15) >> 2, p4 = lane & 3, w = F.wave;
    const size_t tok0 = (size_t)b * SEQ + (size_t)c * 128; const float l2g = ret_log2g(h);
    __syncthreads();
#pragma unroll
    for (int i = 0; i < 4; ++i) { const int id = F.tid + 512 * i, key = id >> 4, ch = id & 15;
        const bf16_t* src = proj + (tok0 + key) * DIN + h * 128 + ch * 8; const u32x4 kv = *(const u32x4*)(src + OFF_KR), vv = *(const u32x4*)(src + OFF_VR);
        const float wk = exp2f(l2g * (float)(127 - key)) * 0.08838834764831845f;
        u32x4 ks; ks.x = pk2(bf2f(kv.x & 0xffffu) * wk, bf2f(kv.x >> 16) * wk); ks.y = pk2(bf2f(kv.y & 0xffffu) * wk, bf2f(kv.y >> 16) * wk);
        ks.z = pk2(bf2f(kv.z & 0xffffu) * wk, bf2f(kv.z >> 16) * wk); ks.w = pk2(bf2f(kv.w & 0xffffu) * wk, bf2f(kv.w >> 16) * wk);
        *(LAS u32x4*)(Kl + key * RET_RS + ch * 16) = ks; *(LAS u32x4*)(Vl + key * RET_RS + ch * 16) = vv; }
    __syncthreads();
    f32x4 acc[8];
#pragma unroll
    for (int et = 0; et < 8; ++et) acc[et] = (f32x4){0.f, 0.f, 0.f, 0.f};
#pragma unroll
    for (int kk = 0; kk < 4; ++kk) { const bf16x8 af = tr_frag(Kl + (kk * 32 + 8 * g + q4) * RET_RS + (w * 16 + 4 * p4) * 2, 4 * RET_RS);
#pragma unroll
        for (int et = 0; et < 8; ++et) { const bf16x8 bf = tr_frag(Vl + (kk * 32 + 8 * g + q4) * RET_RS + (et * 16 + 4 * p4) * 2, 4 * RET_RS); acc[et] = mfma16(af, bf, acc[et]); } }
    float* dst = Ut + (((size_t)b * NCH + c) * 8 + h) * 16384;
#pragma unroll
    for (int et = 0; et < 8; ++et) *(f32x4*)(dst + (et * 16 + fr) * 128 + w * 16 + 4 * g) = acc[et];
}
__device__ __forceinline__ void phase_scan(const Frame& F, const float* Ut, bf16_t* Rt) {
    const int gt = F.bid * NTHR + F.tid;
    for (int e2 = gt; e2 < 2 * 8 * 8192; e2 += F.G * NTHR) {
        const int b = e2 >> 16, h = (e2 >> 13) & 7, ed = (e2 & 8191) * 2;
        const float gC = exp2f(ret_log2g(h) * 128.0f);
        const float* up = Ut + ((size_t)b * NCH * 8 + h) * 16384 + ed; bf16_t* rp = Rt + ((size_t)b * NCH * 8 + h) * 16384 + ed;
        f32x2 st = (f32x2){0.f, 0.f};
        for (int c0 = 0; c0 < NCH; c0 += 8) {
            f32x2 u[8];
#pragma unroll
            for (int j = 0; j < 8; ++j) u[j] = *(const f32x2*)(up + (size_t)(c0 + j) * 8 * 16384);
#pragma unroll
            for (int j = 0; j < 8; ++j) { *(unsigned*)(rp + (size_t)(c0 + j) * 8 * 16384) = pk2(st.x, st.y); st = st * gC + u[j]; }
        }
    }
}
__device__ __forceinline__ void ret_o_item(const Frame& F, const bf16_t* proj, const bf16_t* Rt, bf16_t* y, const float* normw, int b, int c, int h) {
    LAS unsigned char* Kl = F.lds; LAS unsigned char* Vl = F.lds + RET_TILE; LAS unsigned char* Rl = F.lds + 2 * RET_TILE; LAS unsigned char* Sl = F.lds + 3 * RET_TILE + F.wave * 16 * RET_RS;
    const int lane = F.lane, fr = lane & 15, g = lane >> 4, q4 = (lane & 15) >> 2, p4 = lane & 3, w = F.wave;
    const size_t tok0 = (size_t)b * SEQ + (size_t)c * 128; const float l2g = ret_log2g(h);
    const bf16_t* rsrc = Rt + (((size_t)b * NCH + c) * 8 + h) * 16384;
    __syncthreads();
#pragma unroll
    for (int i = 0; i < 4; ++i) { const int id = F.tid + 512 * i, key = id >> 4, ch = id & 15;
        const bf16_t* src = proj + (tok0 + key) * DIN + h * 128 + ch * 8;
        *(LAS u32x4*)(Kl + key * RET_RS + ch * 16) = *(const u32x4*)(src + OFF_KR); *(LAS u32x4*)(Vl + key * RET_RS + ch * 16) = *(const u32x4*)(src + OFF_VR);
        *(LAS u32x4*)(Rl + key * RET_RS + ch * 16) = *(const u32x4*)(rsrc + key * 128 + ch * 8); }
    bf16x8 qf[4];
#pragma unroll
    for (int kk = 0; kk < 4; ++kk) qf[kk] = *(const bf16x8*)(proj + (tok0 + w * 16 + fr) * DIN + OFF_QR + h * 128 + kk * 32 + 8 * g);
    __syncthreads();
#pragma unroll
    for (int kt = 0; kt < 8; ++kt) {
        f32x4 acc = (f32x4){0.f, 0.f, 0.f, 0.f};
        if (kt <= w) {
#pragma unroll
            for (int kk = 0; kk < 4; ++kk) { const bf16x8 kf = *(const LAS bf16x8*)(Kl + (kt * 16 + fr) * RET_RS + (kk * 32 + 8 * g) * 2); acc = mfma16(qf[kk], kf, acc); }
        }
#pragma unroll
        for (int r = 0; r < 4; ++r) { const int qi = w * 16 + 4 * g + r, kj = kt * 16 + fr, df = qi - kj;
            const float v = df >= 0 ? acc[r] * 0.08838834764831845f * exp2f(l2g * (float)df) : 0.f;
            *(LAS bf16_t*)(Sl + (4 * g + r) * RET_RS + kj * 2) = (bf16_t)f2bf(v); }
    }
    f32x4 oi[8], oc[8];
#pragma unroll
    for (int et = 0; et < 8; ++et) { oi[et] = (f32x4){0.f, 0.f, 0.f, 0.f}; oc[et] = (f32x4){0.f, 0.f, 0.f, 0.f}; }
#pragma unroll
    for (int kk = 0; kk < 4; ++kk) {
        if (2 * kk <= w) { const bf16x8 sf = *(const LAS bf16x8*)(Sl + fr * RET_RS + (kk * 32 + 8 * g) * 2);
#pragma unroll
            for (int et = 0; et < 8; ++et) { const bf16x8 vf = tr_frag(Vl + (kk * 32 + 8 * g + q4) * RET_RS + (et * 16 + 4 * p4) * 2, 4 * RET_RS); oi[et] = mfma16(sf, vf, oi[et]); } }
#pragma unroll
        for (int et = 0; et < 8; ++et) { const bf16x8 rf = *(const LAS bf16x8*)(Rl + (et * 16 + fr) * RET_RS + (kk * 32 + 8 * g) * 2); oc[et] = mfma16(qf[kk], rf, oc[et]); }
    }
#pragma unroll
    for (int r = 0; r < 4; ++r) { const int qi = w * 16 + 4 * g + r; const float wq = exp2f(l2g * (float)(qi + 1));
        float v[8], s = 0.f;
#pragma unroll
        for (int et = 0; et < 8; ++et) { v[et] = oi[et][r] + wq * oc[et][r]; s += v[et]; }
        const float mu = grp16_sum(s) * (1.0f / 128.0f); float qv = 0.f;
#pragma unroll
        for (int et = 0; et < 8; ++et) { v[et] -= mu; qv += v[et] * v[et]; }
        const float rstd = 1.0f / sqrtf(grp16_sum(qv) * (1.0f / 128.0f) + LN_EPS);
        const bf16_t* gp = proj + (tok0 + qi) * DIN + OFF_GR + h * 128; bf16_t* yp = y + (tok0 + qi) * 2048 + 1024 + h * 128;
#pragma unroll
        for (int et = 0; et < 8; ++et) { const int e = et * 16 + fr; const float gt = bf2f(gp[e]); const float sw = gt * __builtin_amdgcn_rcpf(1.0f + __expf(-gt));
            yp[e] = (bf16_t)f2bf(v[et] * rstd * normw[h * 128 + e] * sw); }
    }
}

__device__ __forceinline__ void phase_ln(const Frame& F, const float* z, const float* w, const float* bb, float* xo, bf16_t* xb) {
    const int gw = F.bid * NWAVES + F.wave, NGW = F.G * NWAVES;
    for (int m = gw; m < T; m += NGW) {
        const f32x4* zr = (const f32x4*)(z + (size_t)m * D) + F.lane; f32x4 v[8]; float s = 0.f;
#pragma unroll
        for (int j = 0; j < 8; ++j) { v[j] = zr[64 * j]; s += (v[j][0] + v[j][1]) + (v[j][2] + v[j][3]); }
        const float mean = wave_sum(s) * (1.0f / D); float q = 0.f;
#pragma unroll
        for (int j = 0; j < 8; ++j) { v[j] = v[j] - mean; q += (v[j][0] * v[j][0] + v[j][1] * v[j][1]) + (v[j][2] * v[j][2] + v[j][3] * v[j][3]); }
        const float rstd = 1.0f / sqrtf(wave_sum(q) * (1.0f / D) + LN_EPS);
#pragma unroll
        for (int j = 0; j < 8; ++j) { const f32x4 ww = ((const f32x4*)w)[F.lane + 64 * j], b4 = ((const f32x4*)bb)[F.lane + 64 * j]; const f32x4 o = v[j] * rstd * ww + b4;
            ((f32x4*)(xo + (size_t)m * D))[F.lane + 64 * j] = o; u32x2 p; p.x = pk2(o[0], o[1]); p.y = pk2(o[2], o[3]); ((u32x2*)(xb + (size_t)m * D))[F.lane + 64 * j] = p; }
    }
}
__device__ __forceinline__ void phase_softmax(const Frame& F, bf16_t* sp) {
    const int gw = F.bid * NWAVES + F.wave, NGW = F.G * NWAVES;
    for (int m = gw; m < T; m += NGW) {
#pragma unroll
        for (int h = 0; h < 4; ++h) { u32x2* p = (u32x2*)(sp + (size_t)m * 1024 + h * 256) + F.lane; const u32x2 v = *p;
            float a0 = bf2f(v.x & 0xffffu), a1 = bf2f(v.x >> 16), a2 = bf2f(v.y & 0xffffu), a3 = bf2f(v.y >> 16);
            const float mx = wave_max(fmaxf(fmaxf(a0, a1), fmaxf(a2, a3)));
            a0 = __expf(a0 - mx); a1 = __expf(a1 - mx); a2 = __expf(a2 - mx); a3 = __expf(a3 - mx);
            const float il = 1.0f / wave_sum((a0 + a1) + (a2 + a3));
            u32x2 o; o.x = pk2(a0 * il, a1 * il); o.y = pk2(a2 * il, a3 * il); *p = o; }
    }
}
__device__ __forceinline__ void phase_route1(const Frame& F, const float* logits, int* tok_e, int* tok_p, float* gates, int* slot_tok, unsigned* gcnt) {
    LAS float* lg = (LAS float*)F.lds;
    LAS int* lcnt = (LAS int*)(F.lds + 128 * 33 * 4); LAS int* lbase = lcnt + 32;
    for (int i = F.bid * NTHR + F.tid; i < NSLOT; i += F.G * NTHR) slot_tok[i] = 0;
    for (int t0 = F.bid * 128; t0 < T; t0 += F.G * 128) {
        __syncthreads();
        for (int i = F.tid; i < 128 * 32; i += NTHR) lg[(i >> 5) * 33 + (i & 31)] = logits[(size_t)t0 * 32 + i];
        if (F.tid < 32) lcnt[F.tid] = 0;
        __syncthreads();
        int id[4] = {0, 0, 0, 0}, lp[4] = {0, 0, 0, 0}; float v[4] = {0.f, 0.f, 0.f, 0.f};
        if (F.tid < 128) {
            unsigned used = 0u;
#pragma unroll
            for (int k = 0; k < 4; ++k) { float best = -3.0e38f; int bi = 0;
                for (int e = 0; e < 32; ++e) { const float x = lg[F.tid * 33 + e]; if (!((used >> e) & 1u) && x > best) { best = x; bi = e; } }
                used |= 1u << bi; v[k] = best; id[k] = bi; }
            float ex[4], sum = 0.f;
#pragma unroll
            for (int k = 0; k < 4; ++k) { ex[k] = __expf(v[k] - v[0]); sum += ex[k]; }
#pragma unroll
            for (int k = 0; k < 4; ++k) { gates[(size_t)(t0 + F.tid) * 4 + k] = ex[k] / sum; lp[k] = atomicAdd((int*)&lcnt[id[k]], 1); }
        }
        __syncthreads();
        if (F.tid < 32) lbase[F.tid] = (int)__hip_atomic_fetch_add(gcnt + F.tid, (unsigned)lcnt[F.tid], __ATOMIC_RELAXED, __HIP_MEMORY_SCOPE_AGENT);
        __syncthreads();
        if (F.tid < 128) {
#pragma unroll
            for (int k = 0; k < 4; ++k) { tok_e[(size_t)(t0 + F.tid) * 4 + k] = id[k]; tok_p[(size_t)(t0 + F.tid) * 4 + k] = lbase[id[k]] + lp[k]; }
        }
    }
}
__device__ __forceinline__ void moe_tables(const Frame& F, unsigned* gcnt, LAS int* pstart, LAS int* blkexp) {
    __syncthreads();
    if (F.tid == 0) { int acc = 0; for (int e = 0; e < 32; ++e) { pstart[e] = acc; const int cnt = (int)__hip_atomic_load(gcnt + e, __ATOMIC_RELAXED, __HIP_MEMORY_SCOPE_AGENT); acc += ((cnt + 255) >> 8) << 8; } pstart[32] = acc; }
    __syncthreads();
    for (int j = F.tid; j < NBLK_MAX; j += NTHR) { int e = 0; for (int k = 1; k < 32; ++k) if (pstart[k] <= j * 256) e = k; blkexp[j] = e; }
    __syncthreads();
}
__device__ __forceinline__ void phase_route2(const Frame& F, const int* tok_e, const int* tok_p, int* inv, int* slot_tok, unsigned* gcnt) {
    LAS int* pstart = (LAS int*)(F.lds + TAB_OFF); LAS int* blkexp = pstart + 64;
    moe_tables(F, gcnt, pstart, blkexp);
    for (int i = F.bid * NTHR + F.tid; i < T * 4; i += F.G * NTHR) { const int e = tok_e[i], dest = pstart[e] + tok_p[i]; inv[i] = dest; slot_tok[dest] = i >> 2; }
}
__device__ __forceinline__ void phase_final(const Frame& F, const float* x2, const bf16_t* ys, const int* inv, const float* gates, const float* w, const float* bb, float* out) {
    const int gw = F.bid * NWAVES + F.wave, NGW = F.G * NWAVES;
    for (int m = gw; m < T; m += NGW) {
        const f32x4* xr = (const f32x4*)(x2 + (size_t)m * D) + F.lane; f32x4 v[8];
#pragma unroll
        for (int j = 0; j < 8; ++j) v[j] = xr[64 * j] * DN_ALPHA;
#pragma unroll
        for (int k = 0; k < 4; ++k) { const int s = inv[(size_t)m * 4 + k]; const float gk = gates[(size_t)m * 4 + k]; const u32x2* yr = (const u32x2*)(ys + (size_t)s * D) + F.lane;
#pragma unroll
            for (int j = 0; j < 8; ++j) { const u32x2 p = yr[64 * j]; v[j][0] += gk * bf2f(p.x & 0xffffu); v[j][1] += gk * bf2f(p.x >> 16); v[j][2] += gk * bf2f(p.y & 0xffffu); v[j][3] += gk * bf2f(p.y >> 16); } }
        float s = 0.f;
#pragma unroll
        for (int j = 0; j < 8; ++j) s += (v[j][0] + v[j][1]) + (v[j][2] + v[j][3]);
        const float mean = wave_sum(s) * (1.0f / D); float q = 0.f;
#pragma unroll
        for (int j = 0; j < 8; ++j) { v[j] = v[j] - mean; q += (v[j][0] * v[j][0] + v[j][1] * v[j][1]) + (v[j][2] * v[j][2] + v[j][3] * v[j][3]); }
        const float rstd = 1.0f / sqrtf(wave_sum(q) * (1.0f / D) + LN_EPS);
#pragma unroll
        for (int j = 0; j < 8; ++j) { const f32x4 ww = ((const f32x4*)w)[F.lane + 64 * j], b4 = ((const f32x4*)bb)[F.lane + 64 * j]; ((f32x4*)(out + (size_t)m * D))[F.lane + 64 * j] = v[j] * rstd * ww + b4; }
    }
}

constexpr int NPHASE = 17;
__global__ void __launch_bounds__(NTHR, 2) fwd_kernel(Args args) {
    extern __shared__ __attribute__((aligned(16))) unsigned char lds_raw[];
    Frame F; F.lds = (LAS unsigned char*)lds_raw; F.tid = threadIdx.x; F.lane = F.tid & 63; F.wave = __builtin_amdgcn_readfirstlane(F.tid >> 6); F.G = gridDim.x; F.bid = blockIdx.x; F.ws = args.ws;
    unsigned* ctl = (unsigned*)(args.ws + WS_CTL);
    volatile LAS unsigned* MISC = (volatile LAS unsigned*)(F.lds + MISC_OFF);
    if (F.tid < 32) MISC[F.tid] = 0u;
    __syncthreads();
    XcdBarrier bar; bar.bar = ctl + CW_BAR; bar.x = 0; bar.st = MISC + 8;
    if (MK_FUSED) bar = xcd_barrier_post(ctl + CW_BAR, MISC + 8);
    const int lo = args.ph_lo, hi = args.ph_hi;
#define IN(k) (lo <= (k) && (k) < hi)
#define SEAM(k) do { if (IN(k) && IN((k) + 1)) xcd_barrier(bar); } while (0)
    unsigned char* ws = args.ws;
    bf16_t* xb = (bf16_t*)(ws + WS_XB); bf16_t* proj = (bf16_t*)(ws + WS_PROJ); bf16_t* y = (bf16_t*)(ws + WS_Y); float* z = (float*)(ws + WS_Z);
    float* x1 = (float*)(ws + WS_X1); bf16_t* x1b = (bf16_t*)(ws + WS_X1B); float* x2 = (float*)(ws + WS_X2); bf16_t* x2b = (bf16_t*)(ws + WS_X2B);
    bf16_t* kv = (bf16_t*)(ws + WS_KV); bf16_t* wqk = (bf16_t*)(ws + WS_WQK); bf16_t* wvo = (bf16_t*)(ws + WS_WVO); bf16_t* sp = (bf16_t*)(ws + WS_SP);
    float* Ut = (float*)(ws + WS_U); bf16_t* Rt = (bf16_t*)(ws + WS_RT);
    float* logits = (float*)(ws + WS_SMALL + SM_LOGITS); int* tok_e = (int*)(ws + WS_SMALL + SM_TOKE); int* tok_p = (int*)(ws + WS_SMALL + SM_TOKP);
    float* gates = (float*)(ws + WS_SMALL + SM_GATE); int* inv = (int*)(ws + WS_SMALL + SM_INV); int* slot_tok = (int*)(ws + WS_SMALL + SM_SLOT);
    bf16_t* act = (bf16_t*)(ws + WS_ACT); bf16_t* ysl = (bf16_t*)(ws + WS_YS);
    unsigned* gcnt = ctl + CW_CNT;
    LAS unsigned char* idxtab = F.lds + IDX_OFF;

    if (IN(0)) { phase_prep(F, args); } SEAM(0);
    if (IN(1)) {
        { pg8::ProbStd P; P.init(xb, (const bf16_t*)(ws + WS_WIN), T, DIN, 2048, 2048, 2048, F.G, F.bid); pg8::EpiBf16 E{proj, DIN, nullptr, 0, 1.0f}; pg8::gemm_phase(F.lds, idxtab, P, E); }
        { pg8::ProbStd P; P.init((const bf16_t*)(ws + WS_MEMB), (const bf16_t*)(ws + WS_WKV), 512, 4096, 2048, 2048, 2048, F.G, F.bid); pg8::EpiBf16 E{kv, 4096, nullptr, 0, 1.0f}; pg8::gemm_phase(F.lds, idxtab, P, E); }
    } SEAM(1);
    if (IN(2)) {
        for (int it = F.bid; it < BATCH * NCH; it += F.G) swa_item(F, proj, y, args.in[3], args.in[4], it / NCH, it % NCH);
        for (int it = F.bid; it < BATCH * NCH * 8; it += F.G) ret_u_item(F, proj, Ut, it / (NCH * 8), (it >> 3) % NCH, it & 7);
        __syncthreads();
        { pg8::ProbFoldA P{kv, (const bf16_t*)(ws + WS_WQN), 512, 4096, 2048, F.G, F.bid}; pg8::EpiBf16 E{wqk, 2048, nullptr, 0, 0.04419417382415922f}; pg8::gemm_phase(F.lds, idxtab, P, E); }
        { pg8::ProbFoldB P{(const bf16_t*)(ws + WS_WO), kv, 512, 2048, 4096, F.G, F.bid}; pg8::EpiBf16 E{wvo, 1024, nullptr, 0, 1.0f}; pg8::gemm_phase(F.lds, idxtab, P, E); }
    } SEAM(2);
    if (IN(3)) { phase_scan(F, Ut, Rt); } SEAM(3);
    if (IN(4)) { for (int it = F.bid; it < BATCH * NCH * 8; it += F.G) ret_o_item(F, proj, Rt, y, args.in[5], it / (NCH * 8), (it >> 3) % NCH, it & 7); __syncthreads(); } SEAM(4);
    if (IN(5)) { pg8::ProbStd P; P.init(y, (const bf16_t*)(ws + WS_WMIX), T, 2048, 2048, 2048, 2048, F.G, F.bid); pg8::EpiResF32 E{args.in[0], z, 2048, DN_ALPHA}; pg8::gemm_phase(F.lds, idxtab, P, E); } SEAM(5);
    if (IN(6)) { phase_ln(F, z, args.in[7], args.in[8], x1, x1b); } SEAM(6);
    if (IN(7)) { pg8::ProbStd P; P.init(x1b, wqk, T, 1024, 2048, 2048, 2048, F.G, F.bid); P.split_pm = 64; P.b_split_stride = (size_t)1024 * 2048; pg8::EpiBf16 E{sp, 1024, nullptr, 0, 1.0f}; pg8::gemm_phase(F.lds, idxtab, P, E); } SEAM(7);
    if (IN(8)) { phase_softmax(F, sp); } SEAM(8);
    if (IN(9)) { pg8::ProbStd P; P.init(sp, wvo, T, 2048, 1024, 1024, 1024, F.G, F.bid); P.split_pm = 64; P.b_split_stride = (size_t)2048 * 1024; pg8::EpiResF32 E{x1, z, 2048, DN_ALPHA}; pg8::gemm_phase(F.lds, idxtab, P, E); } SEAM(9);
    if (IN(10)) { phase_ln(F, z, args.in[12], args.in[13], x2, x2b); } SEAM(10);
    if (IN(11)) { pg8::ProbStd P; P.init(x2b, (const bf16_t*)(ws + WS_WR), T, 256, 2048, 2048, 2048, F.G, F.bid); pg8::EpiRouter E{logits, args.in[15]}; pg8::gemm_phase(F.lds, idxtab, P, E); } SEAM(11);
    if (IN(12)) { phase_route1(F, logits, tok_e, tok_p, gates, slot_tok, gcnt); } SEAM(12);
    if (IN(13)) { phase_route2(F, tok_e, tok_p, inv, slot_tok, gcnt); } SEAM(13);
    if (IN(14)) {
        LAS int* pstart = (LAS int*)(F.lds + TAB_OFF); LAS int* blkexp = pstart + 64; moe_tables(F, gcnt, pstart, blkexp);
        pg8::ProbMoe<true> P; P.A = x2b; P.W = (const bf16_t*)(ws + WS_WGU); P.slot_tok = slot_tok; P.blkexp = blkexp; P.K = 2048; P.lda = 2048; P.ldb = 2048; P.S.init(pstart[32] >> 8, 16, F.G, F.bid);
        pg8::EpiSwiglu E{act, args.in[17]}; pg8::gemm_phase(F.lds, idxtab, P, E);
    } SEAM(14);
    if (IN(15)) {
        LAS int* pstart = (LAS int*)(F.lds + TAB_OFF); LAS int* blkexp = pstart + 64; moe_tables(F, gcnt, pstart, blkexp);
        pg8::ProbMoe<false> P; P.A = act; P.W = (const bf16_t*)(ws + WS_WD); P.slot_tok = slot_tok; P.blkexp = blkexp; P.K = 2048; P.lda = 2048; P.ldb = 2048; P.S.init(pstart[32] >> 8, 8, F.G, F.bid);
        pg8::EpiBf16 E{ysl, 2048, args.in[19], 2048, 1.0f}; pg8::gemm_phase(F.lds, idxtab, P, E);
    } SEAM(15);
    if (IN(16)) { phase_final(F, x2, ysl, inv, gates, args.in[20], args.in[21], args.out); }
#undef IN
#undef SEAM
}

extern "C" void kernel_launch(void* const* d_in, const int* in_sizes, int n_in, void* d_out, int out_size, void* d_ws, size_t ws_size, hipStream_t stream) {
    static int grid = 0;
    if (grid == 0) {
        if (n_in != 22 || out_size != T * D || ws_size < WS_END) { fprintf(stderr, "kernel_launch: unexpected shapes (n_in %d out %d ws %zu need %zu)\n", n_in, out_size, ws_size, (size_t)WS_END); grid = -1; return; }
        int dev = 0, cus = 0, per_cu = 0;
        if (hipGetDevice(&dev) != hipSuccess || hipDeviceGetAttribute(&cus, hipDeviceAttributeMultiprocessorCount, dev) != hipSuccess) { grid = -1; return; }
        if (hipFuncSetAttribute((const void*)fwd_kernel, hipFuncAttributeMaxDynamicSharedMemorySize, LDS_BYTES) != hipSuccess) { fprintf(stderr, "kernel_launch: hipFuncSetAttribute failed\n"); grid = -1; return; }
        if (hipOccupancyMaxActiveBlocksPerMultiprocessor(&per_cu, (const void*)fwd_kernel, NTHR, LDS_BYTES) != hipSuccess || per_cu < 1) fprintf(stderr, "kernel_launch: occupancy query reports %d\n", per_cu);
        (void)hipGetLastError();
        grid = cus;
    }
    if (grid < 0) return;
    (void)hipMemsetAsync((char*)d_ws + WS_CTL, 0, CTL_ZERO_BYTES, stream);
    Args a{};
    for (int i = 0; i < 22; ++i) a.in[i] = (const float*)d_in[i];
    a.out = (float*)d_out; a.ws = (unsigned char*)d_ws;
#if MK_FUSED
    a.ph_lo = 0; a.ph_hi = NPHASE;
    hipLaunchKernelGGL(fwd_kernel, dim3(grid), dim3(NTHR), LDS_BYTES, stream, a);
#else
    for (int p = 0; p < NPHASE; ++p) { a.ph_lo = p; a.ph_hi = p + 1; hipLaunchKernelGGL(fwd_kernel, dim3(grid), dim3(NTHR), LDS_BYTES, stream, a); }
#endif
}
```

```cpp
#include <hip/hip_runtime.h>
#include <cstdio>
#include <cstdint>

#ifndef MK_FUSED
#define MK_FUSED 1
#endif

#define LAS __attribute__((address_space(3)))
#define GAS __attribute__((address_space(1)))
typedef unsigned short bf16_t;
typedef short bf16x8 __attribute__((ext_vector_type(8)));
typedef short bf16x4 __attribute__((ext_vector_type(4)));
typedef float f32x4 __attribute__((ext_vector_type(4)));
typedef float f32x2 __attribute__((ext_vector_type(2)));
typedef unsigned u32x4 __attribute__((ext_vector_type(4)));
typedef unsigned u32x2 __attribute__((ext_vector_type(2)));

constexpr int BATCH = 2, SEQ = 16384, T = BATCH * SEQ, D = 2048;
constexpr int DIN = 5376;
constexpr int OFF_QA = 0, OFF_KA = 1024, OFF_VA = 1152, OFF_QR = 1280, OFF_KR = 2304, OFF_VR = 3328, OFF_GR = 4352;
constexpr int NCH = SEQ / 128;
constexpr int NEXP = 32, NBLK_MAX = 544, NSLOT = NBLK_MAX * 256;
constexpr float LN_EPS = 1e-5f;
constexpr float DN_ALPHA = 1.18920711500272f;
constexpr int NWAVES = 8, NTHR = 512;

constexpr size_t MiB = (size_t)1 << 20;
constexpr size_t WS_CTL = 0, CTL_ZERO_BYTES = 1 * MiB;
constexpr size_t WS_WIN = 1 * MiB;
constexpr size_t WS_WMIX = WS_WIN + 21 * MiB;
constexpr size_t WS_WQN = WS_WMIX + 8 * MiB;
constexpr size_t WS_WKV = WS_WQN + 8 * MiB;
constexpr size_t WS_WO = WS_WKV + 16 * MiB;
constexpr size_t WS_WR = WS_WO + 8 * MiB;
constexpr size_t WS_WGU = WS_WR + 1 * MiB;
constexpr size_t WS_WD = WS_WGU + 512 * MiB;
constexpr size_t WS_MEMB = WS_WD + 256 * MiB;
constexpr size_t WS_KV = WS_MEMB + 2 * MiB;
constexpr size_t WS_WQK = WS_KV + 4 * MiB;
constexpr size_t WS_WVO = WS_WQK + 8 * MiB;
constexpr size_t WS_SMALL = WS_WVO + 8 * MiB;
constexpr size_t WS_RT = WS_SMALL + 16 * MiB;
constexpr size_t WS_SP = WS_RT + 64 * MiB;
constexpr size_t WS_X1B = WS_SP + 64 * MiB;
constexpr size_t WS_X2B = WS_X1B + 128 * MiB;
constexpr size_t WS_X2 = WS_X2B + 128 * MiB;
constexpr size_t WS_R1 = WS_X2 + 256 * MiB;
constexpr size_t WS_XB = WS_R1;
constexpr size_t WS_PROJ = WS_XB + 128 * MiB;
constexpr size_t WS_U = WS_PROJ + 336 * MiB;
constexpr size_t WS_ACT = WS_R1;
constexpr size_t WS_R2 = WS_R1 + 592 * MiB;
constexpr size_t WS_Y = WS_R2;
constexpr size_t WS_Z = WS_Y + 128 * MiB;
constexpr size_t WS_X1 = WS_Z + 256 * MiB;
constexpr size_t WS_YS = WS_R2;
constexpr size_t WS_END = WS_R2 + 640 * MiB;
static_assert((size_t)NSLOT * 2048 * 2 <= 592 * MiB && (size_t)NSLOT * 2048 * 2 <= 640 * MiB, "overlay sizes");
constexpr size_t SM_LOGITS = 0;
constexpr size_t SM_TOKE = 4 * MiB;
constexpr size_t SM_TOKP = 5 * MiB;
constexpr size_t SM_GATE = 6 * MiB;
constexpr size_t SM_INV = 7 * MiB;
constexpr size_t SM_SLOT = 8 * MiB;
constexpr int CW_BAR = 4096, CW_CNT = 8192;

constexpr int RING_BYTES = 139264;
constexpr int IDX_OFF = RING_BYTES;
constexpr int TAB_OFF = RING_BYTES + 1024;
constexpr int MISC_OFF = RING_BYTES + 1024 + 4096;
constexpr int LDS_BYTES = 147456;
static_assert(MISC_OFF + 256 <= LDS_BYTES, "lds map");

__device__ __forceinline__ unsigned f2bf(float f) { unsigned u = __float_as_uint(f); return (u + 0x7fffu + ((u >> 16) & 1u)) >> 16; }
__device__ __forceinline__ unsigned pk2(float lo, float hi) { return f2bf(lo) | (f2bf(hi) << 16); }
__device__ __forceinline__ float bf2f(unsigned b) { return __uint_as_float(b << 16); }
__device__ __forceinline__ unsigned cvt_pk_bf16(float lo, float hi) { unsigned r; asm volatile("v_cvt_pk_bf16_f32 %0, %1, %2" : "=v"(r) : "v"(lo), "v"(hi)); return r; }
__device__ __forceinline__ f32x4 mfma16(bf16x8 a, bf16x8 b, f32x4 c) { return __builtin_amdgcn_mfma_f32_16x16x32_bf16(a, b, c, 0, 0, 0); }
__device__ __forceinline__ float wave_sum(float v) {
#pragma unroll
    for (int o = 1; o < 64; o <<= 1) v += __shfl_xor(v, o);
    return v;
}
__device__ __forceinline__ float wave_max(float v) {
#pragma unroll
    for (int o = 1; o < 64; o <<= 1) v = fmaxf(v, __shfl_xor(v, o));
    return v;
}
__device__ __forceinline__ float grp16_sum(float v) { v += __shfl_xor(v, 1); v += __shfl_xor(v, 2); v += __shfl_xor(v, 4); v += __shfl_xor(v, 8); return v; }
__device__ __forceinline__ float grp16_max(float v) { v = fmaxf(v, __shfl_xor(v, 1)); v = fmaxf(v, __shfl_xor(v, 2)); v = fmaxf(v, __shfl_xor(v, 4)); v = fmaxf(v, __shfl_xor(v, 8)); return v; }
__device__ __forceinline__ bf16x8 tr_frag(const LAS unsigned char* p, int rs4) {
    const bf16x4 lo = __builtin_amdgcn_ds_read_tr16_b64_v4i16((LAS bf16x4*)p);
    const bf16x4 hi = __builtin_amdgcn_ds_read_tr16_b64_v4i16((LAS bf16x4*)(p + rs4));
    return (bf16x8){lo[0], lo[1], lo[2], lo[3], hi[0], hi[1], hi[2], hi[3]};
}

namespace pg8 {
constexpr int BM = 256, BK = 64, HALF = 128, HTB = HALF * BK * 2, STAGE_BYTES = 8 * HTB, NXCD = 8, WGM = 8;
__host__ __device__ __forceinline__ int lds_byte(int r, int c) { const int st = (r >> 4) * 2 + (c >> 5), rr = r & 15, cc = c & 31, ob = rr * 64 + cc * 2; return st * 1024 + (ob ^ (((ob >> 9) & 1) << 5)); }
__host__ __device__ __forceinline__ void stage_rc(int b, int& R, int& C) { const int st = b / 1024, sb = b % 1024, swz = sb ^ (((sb >> 9) & 1) << 5); R = (st >> 1) * 16 + swz / 64; C = (st & 1) * 32 + (swz % 64) / 2; }
__host__ __device__ __forceinline__ int perm32(int rho) { const int n = rho >> 4, i = rho & 15; return 8 * (i >> 2) + 4 * n + (i & 3); }

struct Unit { int pm, pn, orow, ocol, aux; };

struct StaticOrder {
    int nM, nN, nwg, G, c;
    __device__ void init(int nM_, int nN_, int G_, int c_) { nM = nM_; nN = nN_; nwg = nM * nN; G = G_; c = c_; }
    __device__ bool next(int i, int& pm, int& pn) const {
        const long L = (long)i * G + c; if (L >= nwg) return false;
        int wgid = (int)L; { const int q = nwg / NXCD, r = nwg % NXCD, xcd = wgid % NXCD, off = wgid / NXCD; wgid = (xcd < r ? xcd * (q + 1) : r * (q + 1) + (xcd - r) * q) + off; }
        const int nig = WGM * nN, gid = wgid / nig, fm = gid * WGM, gsz = (nM - fm) < WGM ? (nM - fm) : WGM;
        pm = fm + ((wgid % nig) % gsz); pn = (wgid % nig) / gsz; return true;
    }
};

template <class Epi, class Prob>
__device__ __forceinline__ void gemm_phase(LAS unsigned char* lds, LAS unsigned char* idxtab, const Prob& P, const Epi& E) {
    const int tid = threadIdx.x, wid = __builtin_amdgcn_readfirstlane(tid >> 6), lane = tid & 63, wr = wid >> 2, wc = wid & 3, fr = lane & 15, fq = lane >> 4;
    const int K = P.K, nt = K / BK;
    constexpr bool GATHER = Prob::GATHER;
    const unsigned lda2 = (unsigned)P.lda * 2u, ldb2 = (unsigned)P.ldb * 2u;
    unsigned voffB[2], oc[2][2], on[2][2]; int rA[2]; unsigned cA2[2];
#pragma unroll
    for (int i = 0; i < 2; ++i) { int R, C; stage_rc(tid * 16 + i * 8192, R, C); const int Rb = Epi::PERM ? ((R & ~31) + perm32(R & 31)) : R;
        voffB[i] = (unsigned)Rb * ldb2 + (unsigned)C * 2u; rA[i] = R; cA2[i] = (unsigned)C * 2u;
#pragma unroll
        for (int h = 0; h < 2; ++h) { oc[h][i] = (unsigned)(R + h * HALF) * lda2 + (unsigned)C * 2u; on[h][i] = oc[h][i]; } }
    const size_t kstep = (size_t)(BK * 2);
    const size_t hstepB = (size_t)HALF * ldb2;
    const unsigned ldsw = (unsigned)wid * 1024u;
    const int aoff = lds_byte(wr * 64 + fr, fq * 8), boff = lds_byte(wc * 32 + fr, fq * 8);
#define PG8_SA(b, h) (((b) * 2 + (h)) * HTB)
#define PG8_SB(b, h) ((4 + (b) * 2 + (h)) * HTB)
#define PG8_STAGE(bufoff, gbase, voff) do { _Pragma("unroll") for (int _i = 0; _i < 2; ++_i) \
        __builtin_amdgcn_global_load_lds((const unsigned*)((const char*)(gbase) + (voff)[_i]), (LAS unsigned*)(lds + (bufoff) + ldsw + _i * 8192), 16, 0, 0); } while (0)
#define PG8_LDA(dst, b, h) do { _Pragma("unroll") for (int m = 0; m < 4; ++m) _Pragma("unroll") for (int k = 0; k < 2; ++k) dst[m][k] = *(const LAS bf16x8*)(lds + PG8_SA(b, h) + aoff + m * 2048 + k * 1024); } while (0)
#define PG8_LDB(dst, b, h) do { _Pragma("unroll") for (int n = 0; n < 2; ++n) _Pragma("unroll") for (int k = 0; k < 2; ++k) dst[n][k] = *(const LAS bf16x8*)(lds + PG8_SB(b, h) + boff + n * 2048 + k * 1024); } while (0)
#define PG8_MMA(ai, bj, At, Bt) do { __builtin_amdgcn_s_setprio(1); _Pragma("unroll") for (int m = 0; m < 4; ++m) _Pragma("unroll") for (int n = 0; n < 2; ++n) _Pragma("unroll") for (int k = 0; k < 2; ++k) \
        acc[ai][bj][m][n] = __builtin_amdgcn_mfma_f32_16x16x32_bf16(Bt[n][k], At[m][k], acc[ai][bj][m][n], 0, 0, 0); __builtin_amdgcn_s_setprio(0); } while (0)
#define PG8_WAIT_V(n) asm volatile("s_waitcnt vmcnt(" #n ")" ::: "memory")
#define PG8_WAIT_L(n) asm volatile("s_waitcnt lgkmcnt(" #n ")" ::: "memory")
#define PG8_BAR __builtin_amdgcn_s_barrier()
#define PG8_SCHED __builtin_amdgcn_sched_barrier(0)
    Unit cur, nxt; int ui = 0;
    if (!P.next(0, cur)) return;
    f32x4 acc[2][2][4][2];
#pragma unroll
    for (int a = 0; a < 2; ++a)
#pragma unroll
        for (int b = 0; b < 2; ++b)
#pragma unroll
            for (int m = 0; m < 4; ++m)
#pragma unroll
                for (int n = 0; n < 2; ++n) acc[a][b][m][n] = (f32x4){0.f, 0.f, 0.f, 0.f};
    bf16x8 At[4][2], B0[2][2], B1[2][2];
    const char* cA = P.a_ptr(cur); const char* cB = P.b_ptr(cur);
    if constexpr (GATHER) {
        if (wid < 4) __builtin_amdgcn_global_load_lds((const unsigned*)(P.idx_ptr(cur) + wid * 64 + lane), (LAS unsigned*)(idxtab + wid * 256), 4, 0, 0);
        PG8_WAIT_V(0); PG8_BAR;
#pragma unroll
        for (int i = 0; i < 2; ++i)
#pragma unroll
            for (int h = 0; h < 2; ++h) oc[h][i] = ((const LAS unsigned*)idxtab)[h * HALF + rA[i]] * lda2 + cA2[i];
        PG8_WAIT_L(0); PG8_BAR;
    }
    PG8_STAGE(PG8_SB(0, 0), cB, voffB); PG8_STAGE(PG8_SB(0, 1), cB + hstepB, voffB); PG8_STAGE(PG8_SA(0, 0), cA, oc[0]); PG8_STAGE(PG8_SA(0, 1), cA, oc[1]);
    if (wr == 1) PG8_BAR;
    PG8_WAIT_V(2); PG8_BAR;
    PG8_STAGE(PG8_SB(1, 0), cB + kstep, voffB); PG8_STAGE(PG8_SA(1, 0), cA + kstep, oc[0]); PG8_STAGE(PG8_SB(1, 1), cB + hstepB + kstep, voffB);
    PG8_WAIT_V(6); PG8_BAR;
    for (;;) {
        const bool has_next = P.next(ui + 1, nxt);
        const char* nA = has_next ? P.a_ptr(nxt) : cA; const char* nB = has_next ? P.b_ptr(nxt) : cB;
        if constexpr (GATHER) { if (has_next && wid < 4) __builtin_amdgcn_global_load_lds((const unsigned*)(P.idx_ptr(nxt) + wid * 64 + lane), (LAS unsigned*)(idxtab + wid * 256), 4, 0, 0); }
        for (int t = 0; t < nt; t += 2) {
            const bool last = (t == nt - 2);
            const char* a1 = cA + (size_t)(t + 1) * kstep;
            const char* a2 = last ? nA : cA + (size_t)(t + 2) * kstep; const char* b2 = last ? nB : cB + (size_t)(t + 2) * kstep;
            const char* a3 = a2 + kstep; const char* b3 = b2 + kstep;
            unsigned os[2][2];
            if constexpr (GATHER) {
                if (last && has_next) {
#pragma unroll
                    for (int i = 0; i < 2; ++i)
#pragma unroll
                        for (int h = 0; h < 2; ++h) on[h][i] = ((const LAS unsigned*)idxtab)[h * HALF + rA[i]] * lda2 + cA2[i];
                }
#pragma unroll
                for (int i = 0; i < 2; ++i)
#pragma unroll
                    for (int h = 0; h < 2; ++h) os[h][i] = last ? on[h][i] : oc[h][i];
            } else {
#pragma unroll
                for (int i = 0; i < 2; ++i)
#pragma unroll
                    for (int h = 0; h < 2; ++h) os[h][i] = oc[h][i];
            }
            PG8_LDB(B0, 0, 0); PG8_LDB(B1, 0, 1); PG8_SCHED; PG8_LDA(At, 0, 0); PG8_STAGE(PG8_SA(1, 1), a1, oc[1]);
            PG8_WAIT_V(8); PG8_WAIT_L(0); PG8_BAR; PG8_MMA(0, 0, At, B0); PG8_MMA(0, 1, At, B1); PG8_BAR; PG8_SCHED;
            PG8_LDA(At, 0, 1); PG8_STAGE(PG8_SB(0, 0), b2, voffB); PG8_STAGE(PG8_SB(0, 1), b2 + hstepB, voffB); PG8_STAGE(PG8_SA(0, 0), a2, os[0]);
            PG8_WAIT_V(8); PG8_WAIT_L(0); PG8_BAR; PG8_MMA(1, 0, At, B0); PG8_MMA(1, 1, At, B1); PG8_BAR; PG8_SCHED;
            PG8_LDB(B0, 1, 0); PG8_LDB(B1, 1, 1); PG8_SCHED; PG8_LDA(At, 1, 0); PG8_STAGE(PG8_SA(0, 1), a2, os[1]);
            PG8_WAIT_V(8); PG8_WAIT_L(0); PG8_BAR; PG8_MMA(0, 0, At, B0); PG8_MMA(0, 1, At, B1); PG8_BAR; PG8_SCHED;
            PG8_LDA(At, 1, 1); PG8_STAGE(PG8_SB(1, 0), b3, voffB); PG8_STAGE(PG8_SB(1, 1), b3 + hstepB, voffB); PG8_STAGE(PG8_SA(1, 0), a3, os[0]);
            PG8_WAIT_V(8); PG8_WAIT_L(0); PG8_BAR; PG8_MMA(1, 0, At, B0); PG8_MMA(1, 1, At, B1); PG8_BAR; PG8_SCHED;
        }
        if (wr == 0) PG8_BAR;
        E(acc, cur, wr, wc, fr, fq);
        if (!has_next) break;
#pragma unroll
        for (int a = 0; a < 2; ++a)
#pragma unroll
            for (int b = 0; b < 2; ++b)
#pragma unroll
                for (int m = 0; m < 4; ++m)
#pragma unroll
                    for (int n = 0; n < 2; ++n) acc[a][b][m][n] = (f32x4){0.f, 0.f, 0.f, 0.f};
        cur = nxt; cA = nA; cB = nB; ++ui;
        if constexpr (GATHER) {
#pragma unroll
            for (int i = 0; i < 2; ++i)
#pragma unroll
                for (int h = 0; h < 2; ++h) oc[h][i] = on[h][i];
        }
        if (wr == 1) PG8_BAR;
    }
    PG8_WAIT_V(0);
    PG8_BAR;
#undef PG8_SA
#undef PG8_SB
#undef PG8_STAGE
#undef PG8_LDA
#undef PG8_LDB
#undef PG8_MMA
#undef PG8_WAIT_V
#undef PG8_WAIT_L
#undef PG8_BAR
#undef PG8_SCHED
}

struct EpiBf16 {
    static constexpr bool PERM = true;
    bf16_t* O; int ldc; const float* bias; int bias_stride; float scale;
    __device__ __forceinline__ void operator()(const f32x4 (&acc)[2][2][4][2], const Unit& u, int wr, int wc, int fr, int fq) const {
        const int row0 = u.orow + wr * 64 + fr, col0 = u.ocol + wc * 32 + 8 * fq;
        f32x4 bv[2][2];
#pragma unroll
        for (int bj = 0; bj < 2; ++bj)
#pragma unroll
            for (int n = 0; n < 2; ++n) bv[bj][n] = bias ? *(const f32x4*)(bias + (size_t)u.aux * bias_stride + col0 + bj * HALF + 4 * n) : (f32x4){0.f, 0.f, 0.f, 0.f};
#pragma unroll
        for (int ai = 0; ai < 2; ++ai)
#pragma unroll
            for (int m = 0; m < 4; ++m) { bf16_t* rowp = O + (size_t)(row0 + ai * HALF + m * 16) * ldc + col0;
#pragma unroll
                for (int bj = 0; bj < 2; ++bj) { f32x4 v0 = (acc[ai][bj][m][0] + bv[bj][0]) * scale, v1 = (acc[ai][bj][m][1] + bv[bj][1]) * scale;
                    u32x4 w; w.x = cvt_pk_bf16(v0[0], v0[1]); w.y = cvt_pk_bf16(v0[2], v0[3]); w.z = cvt_pk_bf16(v1[0], v1[1]); w.w = cvt_pk_bf16(v1[2], v1[3]);
                    *(u32x4*)(rowp + bj * HALF) = w; } }
    }
};
struct EpiResF32 {
    static constexpr bool PERM = false;
    const float* res; float* out; int ldc; float alpha;
    __device__ __forceinline__ void operator()(const f32x4 (&acc)[2][2][4][2], const Unit& u, int wr, int wc, int fr, int fq) const {
        const int row0 = u.orow + wr * 64 + fr, col0 = u.ocol + wc * 32 + 4 * fq;
#pragma unroll
        for (int ai = 0; ai < 2; ++ai)
#pragma unroll
            for (int m = 0; m < 4; ++m) { const size_t off = (size_t)(row0 + ai * HALF + m * 16) * ldc + col0;
#pragma unroll
                for (int bj = 0; bj < 2; ++bj)
#pragma unroll
                    for (int n = 0; n < 2; ++n) { const f32x4 r = *(const f32x4*)(res + off + bj * HALF + n * 16); *(f32x4*)(out + off + bj * HALF + n * 16) = r * alpha + acc[ai][bj][m][n]; }
                if (m & 1) asm volatile("" ::: "memory"); }
    }
};
struct EpiRouter {
    static constexpr bool PERM = false;
    float* out; const float* bias;
    __device__ __forceinline__ void operator()(const f32x4 (&acc)[2][2][4][2], const Unit& u, int wr, int wc, int fr, int fq) const {
        if (wc != 0) return;
        const int row0 = u.orow + wr * 64 + fr;
#pragma unroll
        for (int ai = 0; ai < 2; ++ai)
#pragma unroll
            for (int m = 0; m < 4; ++m)
#pragma unroll
                for (int n = 0; n < 2; ++n) { const int c = 16 * n + 4 * fq; const f32x4 b = *(const f32x4*)(bias + c);
                    *(f32x4*)(out + (size_t)(row0 + ai * HALF + m * 16) * 32 + c) = acc[ai][0][m][n] + b; }
    }
};
struct EpiSwiglu {
    static constexpr bool PERM = true;
    bf16_t* O; const float* bias;
    __device__ __forceinline__ void operator()(const f32x4 (&acc)[2][2][4][2], const Unit& u, int wr, int wc, int fr, int fq) const {
        const int row0 = u.orow + wr * 64 + fr, col0 = u.ocol + wc * 32 + 8 * fq;
        const float* bg = bias + (size_t)u.aux * 4096 + col0; const float* bu = bg + 2048;
        const f32x4 g0 = *(const f32x4*)bg, g1 = *(const f32x4*)(bg + 4), u0 = *(const f32x4*)bu, u1 = *(const f32x4*)(bu + 4);
#pragma unroll
        for (int ai = 0; ai < 2; ++ai)
#pragma unroll
            for (int m = 0; m < 4; ++m) {
                f32x4 gl0 = acc[ai][0][m][0] + g0, gl1 = acc[ai][0][m][1] + g1, up0 = acc[ai][1][m][0] + u0, up1 = acc[ai][1][m][1] + u1;
                float r[8];
#pragma unroll
                for (int j = 0; j < 4; ++j) {
                    { const float g = fminf(gl0[j], 7.0f), uu = fminf(fmaxf(up0[j], -7.0f), 7.0f); const float sg = __builtin_amdgcn_rcpf(1.0f + __expf(-1.702f * g)); r[j] = (uu + 1.0f) * (g * sg); }
                    { const float g = fminf(gl1[j], 7.0f), uu = fminf(fmaxf(up1[j], -7.0f), 7.0f); const float sg = __builtin_amdgcn_rcpf(1.0f + __expf(-1.702f * g)); r[4 + j] = (uu + 1.0f) * (g * sg); }
                }
                u32x4 w; w.x = cvt_pk_bf16(r[0], r[1]); w.y = cvt_pk_bf16(r[2], r[3]); w.z = cvt_pk_bf16(r[4], r[5]); w.w = cvt_pk_bf16(r[6], r[7]);
                *(u32x4*)(O + (size_t)(row0 + ai * HALF + m * 16) * 2048 + col0) = w; }
    }
};

struct ProbStd {
    static constexpr bool GATHER = false;
    const bf16_t* A; const bf16_t* Bt; int K, lda, ldb; StaticOrder S; int split_pm; size_t b_split_stride; int orow_extra;
    __device__ void init(const bf16_t* A_, const bf16_t* Bt_, int M, int N, int K_, int lda_, int ldb_, int G, int c) { A = A_; Bt = Bt_; K = K_; lda = lda_; ldb = ldb_; S.init(M / BM, N / BM, G, c); split_pm = 1 << 30; b_split_stride = 0; orow_extra = 0; }
    __device__ bool next(int i, Unit& u) const { if (!S.next(i, u.pm, u.pn)) return false; u.orow = u.pm * BM; u.ocol = u.pn * BM; u.aux = 0; return true; }
    __device__ const char* a_ptr(const Unit& u) const { return (const char*)(A + (size_t)u.pm * BM * lda); }
    __device__ const char* b_ptr(const Unit& u) const { return (const char*)(Bt + (size_t)u.pn * BM * ldb + (u.pm >= split_pm ? b_split_stride : 0)); }
    __device__ const int* idx_ptr(const Unit&) const { return nullptr; }
};
struct ProbFoldA {
    static constexpr bool GATHER = false;
    const bf16_t* kv; const bf16_t* wq; int K, lda, ldb, G, c;
    __device__ bool next(int i, Unit& u) const { const int L = i * G + c; if (L >= 64) return false; const int bh = L >> 3; u.pm = bh; u.pn = L & 7; u.orow = (bh >> 2) * 1024 + (bh & 3) * 256; u.ocol = u.pn * 256; u.aux = 0; return true; }
    __device__ const char* a_ptr(const Unit& u) const { const int b = u.pm >> 2, h = u.pm & 3; return (const char*)(kv + (size_t)b * 256 * 4096 + h * 512); }
    __device__ const char* b_ptr(const Unit& u) const { const int h = u.pm & 3; return (const char*)(wq + (size_t)u.pn * 256 * 2048 + h * 512); }
    __device__ const int* idx_ptr(const Unit&) const { return nullptr; }
};
struct ProbFoldB {
    static constexpr bool GATHER = false;
    const bf16_t* woT; const bf16_t* kv; int K, lda, ldb, G, c;
    __device__ bool next(int i, Unit& u) const { const int L = i * G + c; if (L >= 64) return false; const int bh = L >> 3; u.pm = L & 7; u.pn = bh; u.orow = (bh >> 2) * 2048 + u.pm * 256; u.ocol = (bh & 3) * 256; u.aux = 0; return true; }
    __device__ const char* a_ptr(const Unit& u) const { const int h = u.pn & 3; return (const char*)(woT + (size_t)u.pm * 256 * 2048 + h * 512); }
    __device__ const char* b_ptr(const Unit& u) const { const int b = u.pn >> 2, h = u.pn & 3; return (const char*)(kv + (size_t)b * 256 * 4096 + 2048 + h * 512); }
    __device__ const int* idx_ptr(const Unit&) const { return nullptr; }
};
template <bool G1> struct ProbMoe {
    static constexpr bool GATHER = G1;
    const bf16_t* A; const bf16_t* W; const int* slot_tok; const LAS int* blkexp; int K, lda, ldb; StaticOrder S;
    __device__ bool next(int i, Unit& u) const { if (!S.next(i, u.pm, u.pn)) return false; u.orow = u.pm * BM; u.ocol = u.pn * (G1 ? 128 : 256); u.aux = blkexp[u.pm]; return true; }
    __device__ const char* a_ptr(const Unit& u) const { return G1 ? (const char*)A : (const char*)(A + (size_t)u.pm * BM * lda); }
    __device__ const char* b_ptr(const Unit& u) const { return (const char*)(W + ((size_t)u.aux * (G1 ? 4096 : 2048) + (size_t)u.pn * BM) * 2048); }
    __device__ const int* idx_ptr(const Unit& u) const { return slot_tok + u.pm * BM; }
};
}

#define XB_TMO      128
#define XB_XCNT(j)  (256  + 64 * (j))
#define XB_XSUB(j)  (1280 + 64 * (j))
#define XB_XGEN(j)  (2304 + 64 * (j))
#define XB_TOP      3328
#define XB_TOPGEN   3392
#define XCD_BAR_WORDS 3456
#define XB_SPIN_CAP (1u << 18)
__device__ __forceinline__ unsigned xb_ld(unsigned* p)              { return __hip_atomic_load(p, __ATOMIC_RELAXED, __HIP_MEMORY_SCOPE_AGENT); }
__device__ __forceinline__ unsigned xb_add(unsigned* p, unsigned v) { return __hip_atomic_fetch_add(p, v, __ATOMIC_RELAXED, __HIP_MEMORY_SCOPE_AGENT); }
__device__ __forceinline__ unsigned xb_xcc_id() { return (unsigned)__builtin_amdgcn_s_getreg((3 << 11) | 20) & 0xFu; }
#define XB_SPIN(cond, bar) do { unsigned _sp = 0; while (cond) { __builtin_amdgcn_s_sleep(1); \
    if ((++_sp & 255u) == 0u) { if (xb_ld(&(bar)[XB_TMO])) break; if (_sp > XB_SPIN_CAP) { atomicAdd(&(bar)[XB_TMO], 1u); break; } } } } while (0)
struct XcdBarrier { unsigned* bar; unsigned x; volatile LAS unsigned* st; };
__device__ __forceinline__ XcdBarrier xcd_barrier_post(unsigned* bar, volatile LAS unsigned* st) {
    XcdBarrier b; b.bar = bar; b.x = xb_xcc_id(); b.st = st;
    if (threadIdx.x == 0) (void)xb_add(&bar[XB_XCNT(b.x)], 1u);
    return b;
}
__device__ __forceinline__ void xcd_barrier_complete(unsigned* bar, unsigned x, unsigned& nloc, unsigned& nx) {
    const unsigned G = gridDim.x * gridDim.y * gridDim.z;
    unsigned sum, cnt, mine, sp = 0u;
    for (;;) {
        sum = 0u; cnt = 0u; mine = 0u;
#pragma unroll
        for (unsigned j = 0; j < 16; ++j) { const unsigned c = xb_ld(&bar[XB_XCNT(j)]); sum += c; cnt += (c > 0u) ? 1u : 0u; mine = (j == x) ? c : mine; }
        if (sum == G) break;
        __builtin_amdgcn_s_sleep(1);
        if ((++sp & 255u) == 0u) { if (xb_ld(&bar[XB_TMO])) break; if (sp > XB_SPIN_CAP) { atomicAdd(&bar[XB_TMO], 1u); break; } }
    }
    nloc = mine > 0u ? mine : 1u; nx = cnt > 0u ? cnt : 1u;
}
__device__ __forceinline__ void xcd_barrier(const XcdBarrier& b) {
    asm volatile("s_waitcnt vmcnt(0)" ::: "memory");
    __syncthreads();
    if (threadIdx.x == 0) {
        unsigned* bar = b.bar;
        __builtin_amdgcn_s_waitcnt(0);
        unsigned nloc = b.st[0], nx = b.st[1];
        if (nloc == 0u) { xcd_barrier_complete(bar, b.x, nloc, nx); b.st[0] = nloc; b.st[1] = nx; }
        const unsigned old = xb_add(&bar[XB_XSUB(b.x)], 1u);
        const unsigned gen = old / nloc;
        if (old + 1u == (gen + 1u) * nloc) {
            __builtin_amdgcn_fence(__ATOMIC_RELEASE, "agent");
            asm volatile("s_waitcnt vmcnt(0)" ::: "memory");
            const unsigned og = xb_add(&bar[XB_TOP], 1u);
            const unsigned tg = og / nx;
            if (og + 1u == (tg + 1u) * nx) xb_add(&bar[XB_TOPGEN], 1u);
            else XB_SPIN(xb_ld(&bar[XB_TOPGEN]) == tg, bar);
            __builtin_amdgcn_fence(__ATOMIC_ACQUIRE, "agent");
            xb_add(&bar[XB_XGEN(b.x)], 1u);
            asm volatile("s_waitcnt vmcnt(0)" ::: "memory");
        } else {
            XB_SPIN(xb_ld(&bar[XB_XGEN(b.x)]) == gen, bar);
            __builtin_amdgcn_fence(__ATOMIC_ACQUIRE, "agent");
            asm volatile("s_waitcnt vmcnt(0)" ::: "memory");
        }
    }
    __syncthreads();
}

struct Args {
    const float* in[22]; float* out; unsigned char* ws; int ph_lo, ph_hi;
};
struct Frame {
    LAS unsigned char* lds; int tid, lane, wave, G, bid;
    unsigned char* ws;
};
#define LDS_WAIT() asm volatile("s_waitcnt lgkmcnt(0)" ::: "memory")
#define VM_WAIT() asm volatile("s_waitcnt vmcnt(0)" ::: "memory")

__device__ __forceinline__ void p0_transpose_item(const float* W, int Kdim, int N, bf16_t* WT, int dst_row0, int k0, int n0, LAS float* scr, int lane) {
#pragma unroll 8
    for (int i = 0; i < 32; ++i) { const int kk = 2 * i + (lane >> 5); scr[kk * 33 + (lane & 31)] = W[(size_t)(k0 + kk) * N + n0 + (lane & 31)]; }
    LDS_WAIT(); asm volatile("" ::: "memory");
    const int c = lane & 7;
#pragma unroll
    for (int j = 0; j < 4; ++j) { const int n = (lane >> 3) + 8 * j; const LAS float* s = scr + (8 * c) * 33 + n;
        u32x4 o; o.x = pk2(s[0 * 33], s[1 * 33]); o.y = pk2(s[2 * 33], s[3 * 33]); o.z = pk2(s[4 * 33], s[5 * 33]); o.w = pk2(s[6 * 33], s[7 * 33]);
        *(u32x4*)(WT + (size_t)(dst_row0 + n) * Kdim + k0 + 8 * c) = o; }
    LDS_WAIT(); asm volatile("" ::: "memory");
}
__device__ __forceinline__ void p0_convert(const float* src, bf16_t* dst, size_t n8, size_t i0, size_t stride) {
    for (size_t i = i0; i < n8; i += stride) { const f32x4 a = ((const f32x4*)src)[2 * i], b = ((const f32x4*)src)[2 * i + 1];
        u32x4 o; o.x = pk2(a[0], a[1]); o.y = pk2(a[2], a[3]); o.z = pk2(b[0], b[1]); o.w = pk2(b[2], b[3]); ((u32x4*)dst)[i] = o; }
}
__device__ __forceinline__ void phase_prep(const Frame& F, const Args& a) {
    LAS float* scr = (LAS float*)(F.lds + F.wave * 16384);
    const int gw = F.bid * NWAVES + F.wave, NGW = F.G * NWAVES;
    const float *w_in = a.in[2], *w_mix = a.in[6], *w_q = a.in[9], *w_kv = a.in[10], *w_o = a.in[11], *w_r = a.in[14], *w_gu = a.in[16], *w_d = a.in[18];
    bf16_t *WIN = (bf16_t*)(F.ws + WS_WIN), *WMIX = (bf16_t*)(F.ws + WS_WMIX), *WQN = (bf16_t*)(F.ws + WS_WQN), *WKV = (bf16_t*)(F.ws + WS_WKV), *WO = (bf16_t*)(F.ws + WS_WO),
           *WR = (bf16_t*)(F.ws + WS_WR), *WGU = (bf16_t*)(F.ws + WS_WGU), *WD = (bf16_t*)(F.ws + WS_WD);
    constexpr int I_IN = 32 * (DIN / 32), I_MIX = 32 * 64, I_KV = 32 * 128, I_O = 32 * 64, I_R = 32, I_GU = 32 * 128, I_D = 32 * 64;
    constexpr int NITEMS = I_IN + I_MIX + I_KV + I_O + I_R + NEXP * I_GU + NEXP * I_D;
    for (int it = gw; it < NITEMS; it += NGW) {
        int r = it;
        if (r < I_IN) { const int nblk = DIN / 32, kb = r / nblk, nb = r % nblk; p0_transpose_item(w_in, 2048, DIN, WIN, nb * 32, kb * 64, nb * 32, scr, F.lane); continue; } r -= I_IN;
        if (r < I_MIX) { const int kb = r / 64, nb = r % 64; p0_transpose_item(w_mix, 2048, 2048, WMIX, nb * 32, kb * 64, nb * 32, scr, F.lane); continue; } r -= I_MIX;
        if (r < I_KV) { const int kb = r / 128, nb = r % 128; p0_transpose_item(w_kv, 2048, 4096, WKV, nb * 32, kb * 64, nb * 32, scr, F.lane); continue; } r -= I_KV;
        if (r < I_O) { const int kb = r / 64, nb = r % 64; p0_transpose_item(w_o, 2048, 2048, WO, nb * 32, kb * 64, nb * 32, scr, F.lane); continue; } r -= I_O;
        if (r < I_R) { p0_transpose_item(w_r, 2048, 32, WR, 0, r * 64, 0, scr, F.lane); continue; } r -= I_R;
        if (r < NEXP * I_GU) { const int e = r / I_GU, q = r % I_GU, kb = q / 128, nb = q % 128, n0 = nb * 32;
            const int dst = (n0 < 2048) ? ((n0 >> 7) * 256 + (n0 & 127)) : (((n0 - 2048) >> 7) * 256 + 128 + ((n0 - 2048) & 127));
            p0_transpose_item(w_gu + (size_t)e * 2048 * 4096, 2048, 4096, WGU + (size_t)e * 4096 * 2048, dst, kb * 64, n0, scr, F.lane); continue; } r -= NEXP * I_GU;
        { const int e = r / I_D, q = r % I_D, kb = q / 64, nb = q % 64; p0_transpose_item(w_d + (size_t)e * 2048 * 2048, 2048, 2048, WD + (size_t)e * 2048 * 2048, nb * 32, kb * 64, nb * 32, scr, F.lane); }
    }
    const size_t gt = (size_t)F.bid * NTHR + F.tid, NGT = (size_t)F.G * NTHR;
    p0_convert(w_q, WQN, (size_t)2048 * 2048 / 8, gt, NGT);
    p0_convert(a.in[0], (bf16_t*)(F.ws + WS_XB), (size_t)T * D / 8, gt, NGT);
    p0_convert(a.in[1], (bf16_t*)(F.ws + WS_MEMB), (size_t)512 * 2048 / 8, gt, NGT);
    for (size_t i = gt; i < (size_t)224 * 2048 / 8; i += NGT) ((u32x4*)(WR + 32 * 2048))[i] = (u32x4){0u, 0u, 0u, 0u};
}

constexpr int SWA_KRS = 144;
constexpr int SWA_PRS = 336;
constexpr int SWA_K_OFF = 0, SWA_V_OFF = 256 * SWA_KRS, SWA_P_OFF = 2 * 256 * SWA_KRS, SWA_SSQ_OFF = SWA_P_OFF + 8 * 16 * SWA_PRS;
static_assert(SWA_SSQ_OFF + 512 <= RING_BYTES, "swa lds");
__device__ __forceinline__ void swa_item(const Frame& F, const bf16_t* proj, bf16_t* y, const float* sinks, const float* normw, int b, int n) {
    LAS unsigned char* Kl = F.lds + SWA_K_OFF; LAS unsigned char* Vl = F.lds + SWA_V_OFF; LAS unsigned char* Pl = F.lds + SWA_P_OFF + F.wave * 16 * SWA_PRS;
    LAS float* ssq = (LAS float*)(F.lds + SWA_SSQ_OFF);
    const int lane = F.lane, fr = lane & 15, g = lane >> 4, q4 = (lane & 15) >> 2, p4 = lane & 3;
    const size_t tok0 = (size_t)b * SEQ + (size_t)n * 128;
    if (F.tid < 128) ssq[F.tid] = 0.f;
    for (int h = 0; h < 2; ++h) {
        __syncthreads();
#pragma unroll
        for (int i = 0; i < 4; ++i) { const int id = F.tid + 512 * i, key = id >> 3, c = id & 7;
            u32x4 kv = (u32x4){0u, 0u, 0u, 0u}, vv = kv;
            if (n > 0 || key >= 128) { const bf16_t* src = proj + (tok0 - 128 + key) * DIN + h * 64 + c * 8; kv = *(const u32x4*)(src + OFF_KA); vv = *(const u32x4*)(src + OFF_VA); }
            *(LAS u32x4*)(Kl + key * SWA_KRS + c * 16) = kv; *(LAS u32x4*)(Vl + key * SWA_KRS + c * 16) = vv; }
        __syncthreads();
        const int hq = h * 8 + F.wave;
        const float slope = exp2f(-0.5f * (float)(hq + 1)), sink = sinks[hq];
        for (int rt = 0; rt < 8; ++rt) {
            const int i0 = rt * 16, kt0 = rt < 6 ? rt : 6;
            bf16x8 qf[2];
#pragma unroll
            for (int ks = 0; ks < 2; ++ks) qf[ks] = *(const bf16x8*)(proj + (tok0 + i0 + fr) * DIN + OFF_QA + hq * 64 + ks * 32 + 8 * g);
            f32x4 s[10];
#pragma unroll
            for (int tt = 0; tt < 10; ++tt) { f32x4 acc = (f32x4){0.f, 0.f, 0.f, 0.f};
#pragma unroll
                for (int ks = 0; ks < 2; ++ks) { const bf16x8 kf = *(const LAS bf16x8*)(Kl + ((kt0 + tt) * 16 + fr) * SWA_KRS + (ks * 32 + 8 * g) * 2); acc = mfma16(qf[ks], kf, acc); }
                s[tt] = acc; }
            float mx[4] = {-1e30f, -1e30f, -1e30f, -1e30f};
#pragma unroll
            for (int tt = 0; tt < 10; ++tt)
#pragma unroll
                for (int r = 0; r < 4; ++r) { const int i = i0 + 4 * g + r, j = (kt0 + tt) * 16 + fr, dist = i + 128 - j;
                    const bool valid = dist >= 0 && dist < 128 && (n > 0 || j >= 128);
                    const float v = valid ? s[tt][r] * 0.125f - slope * (float)dist : -1e30f; s[tt][r] = v; mx[r] = fmaxf(mx[r], v); }
            float l[4];
#pragma unroll
            for (int r = 0; r < 4; ++r) { mx[r] = fmaxf(grp16_max(mx[r]), sink); l[r] = 0.f; }
#pragma unroll
            for (int tt = 0; tt < 10; ++tt)
#pragma unroll
                for (int r = 0; r < 4; ++r) { const float p = __expf(s[tt][r] - mx[r]); l[r] += p; *(LAS bf16_t*)(Pl + (4 * g + r) * SWA_PRS + (tt * 16 + fr) * 2) = (bf16_t)f2bf(p); }
#pragma unroll
            for (int r = 0; r < 4; ++r) l[r] = grp16_sum(l[r]) + __expf(sink - mx[r]);
            f32x4 o[4];
#pragma unroll
            for (int dt = 0; dt < 4; ++dt) o[dt] = (f32x4){0.f, 0.f, 0.f, 0.f};
#pragma unroll
            for (int kk = 0; kk < 5; ++kk) { const bf16x8 pf = *(const LAS bf16x8*)(Pl + fr * SWA_PRS + (kk * 32 + 8 * g) * 2);
#pragma unroll
                for (int dt = 0; dt < 4; ++dt) { const bf16x8 vf = tr_frag(Vl + (kt0 * 16 + kk * 32 + 8 * g + q4) * SWA_KRS + (dt * 16 + 4 * p4) * 2, 4 * SWA_KRS); o[dt] = mfma16(pf, vf, o[dt]); } }
            float sq[4] = {0.f, 0.f, 0.f, 0.f};
#pragma unroll
            for (int r = 0; r < 4; ++r) { const float il = 1.0f / l[r];
#pragma unroll
                for (int dt = 0; dt < 4; ++dt) { const float v = o[dt][r] * il; sq[r] += v * v; y[(tok0 + i0 + 4 * g + r) * 2048 + hq * 64 + dt * 16 + fr] = (bf16_t)f2bf(v); } }
#pragma unroll
            for (int r = 0; r < 4; ++r) { const float t = grp16_sum(sq[r]); if (fr == 0) atomicAdd((float*)&ssq[i0 + 4 * g + r], t); }
        }
    }
    VM_WAIT(); __syncthreads();
    for (int id = F.tid; id < 128 * 128; id += NTHR) { const int tk = id >> 7, c = id & 127; const float rs = 1.0f / sqrtf(ssq[tk] * (1.0f / 1024.0f) + LN_EPS);
        bf16_t* p = y + (tok0 + tk) * 2048 + c * 8; const u32x4 v = *(const u32x4*)p; const f32x4 w0 = *(const f32x4*)(normw + c * 8), w1 = *(const f32x4*)(normw + c * 8 + 4);
        u32x4 o; o.x = pk2(bf2f(v.x & 0xffffu) * rs * w0[0], bf2f(v.x >> 16) * rs * w0[1]); o.y = pk2(bf2f(v.y & 0xffffu) * rs * w0[2], bf2f(v.y >> 16) * rs * w0[3]);
        o.z = pk2(bf2f(v.z & 0xffffu) * rs * w1[0], bf2f(v.z >> 16) * rs * w1[1]); o.w = pk2(bf2f(v.w & 0xffffu) * rs * w1[2], bf2f(v.w >> 16) * rs * w1[3]);
        *(u32x4*)p = o; }
    __syncthreads();
}

constexpr int RET_RS = 272;
constexpr int RET_TILE = 128 * RET_RS;
__device__ __forceinline__ float ret_log2g(int h) { return log2f(1.0f - exp2f(-5.0f - (float)h)); }
__device__ __forceinline__ void ret_u_item(const Frame& F, const bf16_t* proj, float* Ut, int b, int c, int h) {
    LAS unsigned char* Kl = F.lds; LAS unsigned char* Vl = F.lds + RET_TILE;
    const int lane = F.lane, fr = lane & 15, g = lane >> 4, q4 = (lane & 15) >> 2, p4 = lane & 3, w = F.wave;
    const size_t tok0 = (size_t)b * SEQ + (size_t)c * 128; const float l2g = ret_log2g(h);
    __syncthreads();
#pragma unroll
    for (int i = 0; i < 4; ++i) { const int id = F.tid + 512 * i, key = id >> 4, ch = id & 15;
        const bf16_t* src = proj + (tok0 + key) * DIN + h * 128 + ch * 8; const u32x4 kv = *(const u32x4*)(src + OFF_KR), vv = *(const u32x4*)(src + OFF_VR);
        const float wk = exp2f(l2g * (float)(127 - key)) * 0.08838834764831845f;
        u32x4 ks; ks.x = pk2(bf2f(kv.x & 0xffffu) * wk, bf2f(kv.x >> 16) * wk); ks.y = pk2(bf2f(kv.y & 0xffffu) * wk, bf2f(kv.y >> 16) * wk);
        ks.z = pk2(bf2f(kv.z & 0xffffu) * wk, bf2f(kv.z >> 16) * wk); ks.w = pk2(bf2f(kv.w & 0xffffu) * wk, bf2f(kv.w >> 16) * wk);
        *(LAS u32x4*)(Kl + key * RET_RS + ch * 16) = ks; *(LAS u32x4*)(Vl + key * RET_RS + ch * 16) = vv; }
    __syncthreads();
    f32x4 acc[8];
#pragma unroll
    for (int et = 0; et < 8; ++et) acc[et] = (f32x4){0.f, 0.f, 0.f, 0.f};
#pragma unroll
    for (int kk = 0; kk < 4; ++kk) { const bf16x8 af = tr_frag(Kl + (kk * 32 + 8 * g + q4) * RET_RS + (w * 16 + 4 * p4) * 2, 4 * RET_RS);
#pragma unroll
        for (int et = 0; et < 8; ++et) { const bf16x8 bf = tr_frag(Vl + (kk * 32 + 8 * g + q4) * RET_RS + (et * 16 + 4 * p4) * 2, 4 * RET_RS); acc[et] = mfma16(af, bf, acc[et]); } }
    float* dst = Ut + (((size_t)b * NCH + c) * 8 + h) * 16384;
#pragma unroll
    for (int et = 0; et < 8; ++et) *(f32x4*)(dst + (et * 16 + fr) * 128 + w * 16 + 4 * g) = acc[et];
}
__device__ __forceinline__ void phase_scan(const Frame& F, const float* Ut, bf16_t* Rt) {
    const int gt = F.bid * NTHR + F.tid;
    for (int e2 = gt; e2 < 2 * 8 * 8192; e2 += F.G * NTHR) {
        const int b = e2 >> 16, h = (e2 >> 13) & 7, ed = (e2 & 8191) * 2;
        const float gC = exp2f(ret_log2g(h) * 128.0f);
        const float* up = Ut + ((size_t)b * NCH * 8 + h) * 16384 + ed; bf16_t* rp = Rt + ((size_t)b * NCH * 8 + h) * 16384 + ed;
        f32x2 st = (f32x2){0.f, 0.f};
        for (int c0 = 0; c0 < NCH; c0 += 8) {
            f32x2 u[8];
#pragma unroll
            for (int j = 0; j < 8; ++j) u[j] = *(const f32x2*)(up + (size_t)(c0 + j) * 8 * 16384);
#pragma unroll
            for (int j = 0; j < 8; ++j) { *(unsigned*)(rp + (size_t)(c0 + j) * 8 * 16384) = pk2(st.x, st.y); st = st * gC + u[j]; }
        }
    }
}
__device__ __forceinline__ void ret_o_item(const Frame& F, const bf16_t* proj, const bf16_t* Rt, bf16_t* y, const float* normw, int b, int c, int h) {
    LAS unsigned char* Kl = F.lds; LAS unsigned char* Vl = F.lds + RET_TILE; LAS unsigned char* Rl = F.lds + 2 * RET_TILE; LAS unsigned char* Sl = F.lds + 3 * RET_TILE + F.wave * 16 * RET_RS;
    const int lane = F.lane, fr = lane & 15, g = lane >> 4, q4 = (lane & 15) >> 2, p4 = lane & 3, w = F.wave;
    const size_t tok0 = (size_t)b * SEQ + (size_t)c * 128; const float l2g = ret_log2g(h);
    const bf16_t* rsrc = Rt + (((size_t)b * NCH + c) * 8 + h) * 16384;
    __syncthreads();
#pragma unroll
    for (int i = 0; i < 4; ++i) { const int id = F.tid + 512 * i, key = id >> 4, ch = id & 15;
        const bf16_t* src = proj + (tok0 + key) * DIN + h * 128 + ch * 8;
        *(LAS u32x4*)(Kl + key * RET_RS + ch * 16) = *(const u32x4*)(src + OFF_KR); *(LAS u32x4*)(Vl + key * RET_RS + ch * 16) = *(const u32x4*)(src + OFF_VR);
        *(LAS u32x4*)(Rl + key * RET_RS + ch * 16) = *(const u32x4*)(rsrc + key * 128 + ch * 8); }
    bf16x8 qf[4];
#pragma unroll
    for (int kk = 0; kk < 4; ++kk) qf[kk] = *(const bf16x8*)(proj + (tok0 + w * 16 + fr) * DIN + OFF_QR + h * 128 + kk * 32 + 8 * g);
    __syncthreads();
#pragma unroll
    for (int kt = 0; kt < 8; ++kt) {
        f32x4 acc = (f32x4){0.f, 0.f, 0.f, 0.f};
        if (kt <= w) {
#pragma unroll
            for (int kk = 0; kk < 4; ++kk) { const bf16x8 kf = *(const LAS bf16x8*)(Kl + (kt * 16 + fr) * RET_RS + (kk * 32 + 8 * g) * 2); acc = mfma16(qf[kk], kf, acc); }
        }
#pragma unroll
        for (int r = 0; r < 4; ++r) { const int qi = w * 16 + 4 * g + r, kj = kt * 16 + fr, df = qi - kj;
            const float v = df >= 0 ? acc[r] * 0.08838834764831845f * exp2f(l2g * (float)df) : 0.f;
            *(LAS bf16_t*)(Sl + (4 * g + r) * RET_RS + kj * 2) = (bf16_t)f2bf(v); }
    }
    f32x4 oi[8], oc[8];
#pragma unroll
    for (int et = 0; et < 8; ++et) { oi[et] = (f32x4){0.f, 0.f, 0.f, 0.f}; oc[et] = (f32x4){0.f, 0.f, 0.f, 0.f}; }
#pragma unroll
    for (int kk = 0; kk < 4; ++kk) {
        if (2 * kk <= w) { const bf16x8 sf = *(const LAS bf16x8*)(Sl + fr * RET_RS + (kk * 32 + 8 * g) * 2);
#pragma unroll
            for (int et = 0; et < 8; ++et) { const bf16x8 vf = tr_frag(Vl + (kk * 32 + 8 * g + q4) * RET_RS + (et * 16 + 4 * p4) * 2, 4 * RET_RS); oi[et] = mfma16(sf, vf, oi[et]); } }
#pragma unroll
        for (int et = 0; et < 8; ++et) { const bf16x8 rf = *(const LAS bf16x8*)(Rl + (et * 16 + fr) * RET_RS + (kk * 32 + 8 * g) * 2); oc[et] = mfma16(qf[kk], rf, oc[et]); }
    }
#pragma unroll
    for (int r = 0; r < 4; ++r) { const int qi = w * 16 + 4 * g + r; const float wq = exp2f(l2g * (float)(qi + 1));
        float v[8], s = 0.f;
#pragma unroll
        for (int et = 0; et < 8; ++et) { v[et] = oi[et][r] + wq * oc[et][r]; s += v[et]; }
        const float mu = grp16_sum(s) * (1.0f / 128.0f); float qv = 0.f;
#pragma unroll
        for (int et = 0; et < 8; ++et) { v[et] -= mu; qv += v[et] * v[et]; }
        const float rstd = 1.0f / sqrtf(grp16_sum(qv) * (1.0f / 128.0f) + LN_EPS);
        const bf16_t* gp = proj + (tok0 + qi) * DIN + OFF_GR + h * 128; bf16_t* yp = y + (tok0 + qi) * 2048 + 1024 + h * 128;
#pragma unroll
        for (int et = 0; et < 8; ++et) { const int e = et * 16 + fr; const float gt = bf2f(gp[e]); const float sw = gt * __builtin_amdgcn_rcpf(1.0f + __expf(-gt));
            yp[e] = (bf16_t)f2bf(v[et] * rstd * normw[h * 128 + e] * sw); }
    }
}

__device__ __forceinline__ void phase_ln(const Frame& F, const float* z, const float* w, const float* bb, float* xo, bf16_t* xb) {
    const int gw = F.bid * NWAVES + F.wave, NGW = F.G * NWAVES;
    for (int m = gw; m < T; m += NGW) {
        const f32x4* zr = (const f32x4*)(z + (size_t)m * D) + F.lane; f32x4 v[8]; float s = 0.f;
#pragma unroll
        for (int j = 0; j < 8; ++j) { v[j] = zr[64 * j]; s += (v[j][0] + v[j][1]) + (v[j][2] + v[j][3]); }
        const float mean = wave_sum(s) * (1.0f / D); float q = 0.f;
#pragma unroll
        for (int j = 0; j < 8; ++j) { v[j] = v[j] - mean; q += (v[j][0] * v[j][0] + v[j][1] * v[j][1]) + (v[j][2] * v[j][2] + v[j][3] * v[j][3]); }
        const float rstd = 1.0f / sqrtf(wave_sum(q) * (1.0f / D) + LN_EPS);
#pragma unroll
        for (int j = 0; j < 8; ++j) { const f32x4 ww = ((const f32x4*)w)[F.lane + 64 * j], b4 = ((const f32x4*)bb)[F.lane + 64 * j]; const f32x4 o = v[j] * rstd * ww + b4;
            ((f32x4*)(xo + (size_t)m * D))[F.lane + 64 * j] = o; u32x2 p; p.x = pk2(o[0], o[1]); p.y = pk2(o[2], o[3]); ((u32x2*)(xb + (size_t)m * D))[F.lane + 64 * j] = p; }
    }
}
__device__ __forceinline__ void phase_softmax(const Frame& F, bf16_t* sp) {
    const int gw = F.bid * NWAVES + F.wave, NGW = F.G * NWAVES;
    for (int m = gw; m < T; m += NGW) {
#pragma unroll
        for (int h = 0; h < 4; ++h) { u32x2* p = (u32x2*)(sp + (size_t)m * 1024 + h * 256) + F.lane; const u32x2 v = *p;
            float a0 = bf2f(v.x & 0xffffu), a1 = bf2f(v.x >> 16), a2 = bf2f(v.y & 0xffffu), a3 = bf2f(v.y >> 16);
            const float mx = wave_max(fmaxf(fmaxf(a0, a1), fmaxf(a2, a3)));
            a0 = __expf(a0 - mx); a1 = __expf(a1 - mx); a2 = __expf(a2 - mx); a3 = __expf(a3 - mx);
            const float il = 1.0f / wave_sum((a0 + a1) + (a2 + a3));
            u32x2 o; o.x = pk2(a0 * il, a1 * il); o.y = pk2(a2 * il, a3 * il); *p = o; }
    }
}
__device__ __forceinline__ void phase_route1(const Frame& F, const float* logits, int* tok_e, int* tok_p, float* gates, int* slot_tok, unsigned* gcnt) {
    LAS float* lg = (LAS float*)F.lds;
    LAS int* lcnt = (LAS int*)(F.lds + 128 * 33 * 4); LAS int* lbase = lcnt + 32;
    for (int i = F.bid * NTHR + F.tid; i < NSLOT; i += F.G * NTHR) slot_tok[i] = 0;
    for (int t0 = F.bid * 128; t0 < T; t0 += F.G * 128) {
        __syncthreads();
        for (int i = F.tid; i < 128 * 32; i += NTHR) lg[(i >> 5) * 33 + (i & 31)] = logits[(size_t)t0 * 32 + i];
        if (F.tid < 32) lcnt[F.tid] = 0;
        __syncthreads();
        int id[4] = {0, 0, 0, 0}, lp[4] = {0, 0, 0, 0}; float v[4] = {0.f, 0.f, 0.f, 0.f};
        if (F.tid < 128) {
            unsigned used = 0u;
#pragma unroll
            for (int k = 0; k < 4; ++k) { float best = -3.0e38f; int bi = 0;
                for (int e = 0; e < 32; ++e) { const float x = lg[F.tid * 33 + e]; if (!((used >> e) & 1u) && x > best) { best = x; bi = e; } }
                used |= 1u << bi; v[k] = best; id[k] = bi; }
            float ex[4], sum = 0.f;
#pragma unroll
            for (int k = 0; k < 4; ++k) { ex[k] = __expf(v[k] - v[0]); sum += ex[k]; }
#pragma unroll
            for (int k = 0; k < 4; ++k) { gates[(size_t)(t0 + F.tid) * 4 + k] = ex[k] / sum; lp[k] = atomicAdd((int*)&lcnt[id[k]], 1); }
        }
        __syncthreads();
        if (F.tid < 32) lbase[F.tid] = (int)__hip_atomic_fetch_add(gcnt + F.tid, (unsigned)lcnt[F.tid], __ATOMIC_RELAXED, __HIP_MEMORY_SCOPE_AGENT);
        __syncthreads();
        if (F.tid < 128) {
#pragma unroll
            for (int k = 0; k < 4; ++k) { tok_e[(size_t)(t0 + F.tid) * 4 + k] = id[k]; tok_p[(size_t)(t0 + F.tid) * 4 + k] = lbase[id[k]] + lp[k]; }
        }
    }
}
__device__ __forceinline__ void moe_tables(const Frame& F, unsigned* gcnt, LAS int* pstart, LAS int* blkexp) {
    __syncthreads();
    if (F.tid == 0) { int acc = 0; for (int e = 0; e < 32; ++e) { pstart[e] = acc; const int cnt = (int)__hip_atomic_load(gcnt + e, __ATOMIC_RELAXED, __HIP_MEMORY_SCOPE_AGENT); acc += ((cnt + 255) >> 8) << 8; } pstart[32] = acc; }
    __syncthreads();
    for (int j = F.tid; j < NBLK_MAX; j += NTHR) { int e = 0; for (int k = 1; k < 32; ++k) if (pstart[k] <= j * 256) e = k; blkexp[j] = e; }
    __syncthreads();
}
__device__ __forceinline__ void phase_route2(const Frame& F, const int* tok_e, const int* tok_p, int* inv, int* slot_tok, unsigned* gcnt) {
    LAS int* pstart = (LAS int*)(F.lds + TAB_OFF); LAS int* blkexp = pstart + 64;
    moe_tables(F, gcnt, pstart, blkexp);
    for (int i = F.bid * NTHR + F.tid; i < T * 4; i += F.G * NTHR) { const int e = tok_e[i], dest = pstart[e] + tok_p[i]; inv[i] = dest; slot_tok[dest] = i >> 2; }
}
__device__ __forceinline__ void phase_final(const Frame& F, const float* x2, const bf16_t* ys, const int* inv, const float* gates, const float* w, const float* bb, float* out) {
    const int gw = F.bid * NWAVES + F.wave, NGW = F.G * NWAVES;
    for (int m = gw; m < T; m += NGW) {
        const f32x4* xr = (const f32x4*)(x2 + (size_t)m * D) + F.lane; f32x4 v[8];
#pragma unroll
        for (int j = 0; j < 8; ++j) v[j] = xr[64 * j] * DN_ALPHA;
#pragma unroll
        for (int k = 0; k < 4; ++k) { const int s = inv[(size_t)m * 4 + k]; const float gk = gates[(size_t)m * 4 + k]; const u32x2* yr = (const u32x2*)(ys + (size_t)s * D) + F.lane;
#pragma unroll
            for (int j = 0; j < 8; ++j) { const u32x2 p = yr[64 * j]; v[j][0] += gk * bf2f(p.x & 0xffffu); v[j][1] += gk * bf2f(p.x >> 16); v[j][2] += gk * bf2f(p.y & 0xffffu); v[j][3] += gk * bf2f(p.y >> 16); } }
        float s = 0.f;
#pragma unroll
        for (int j = 0; j < 8; ++j) s += (v[j][0] + v[j][1]) + (v[j][2] + v[j][3]);
        const float mean = wave_sum(s) * (1.0f / D); float q = 0.f;
#pragma unroll
        for (int j = 0; j < 8; ++j) { v[j] = v[j] - mean; q += (v[j][0] * v[j][0] + v[j][1] * v[j][1]) + (v[j][2] * v[j][2] + v[j][3] * v[j][3]); }
        const float rstd = 1.0f / sqrtf(wave_sum(q) * (1.0f / D) + LN_EPS);
#pragma unroll
        for (int j = 0; j < 8; ++j) { const f32x4 ww = ((const f32x4*)w)[F.lane + 64 * j], b4 = ((const f32x4*)bb)[F.lane + 64 * j]; ((f32x4*)(out + (size_t)m * D))[F.lane + 64 * j] = v[j] * rstd * ww + b4; }
    }
}

constexpr int NPHASE = 17;
__global__ void __launch_bounds__(NTHR, 2) fwd_kernel(Args args) {
    extern __shared__ __attribute__((aligned(16))) unsigned char lds_raw[];
    Frame F; F.lds = (LAS unsigned char*)lds_raw; F.tid = threadIdx.x; F.lane = F.tid & 63; F.wave = __builtin_amdgcn_readfirstlane(F.tid >> 6); F.G = gridDim.x; F.bid = blockIdx.x; F.ws = args.ws;
    unsigned* ctl = (unsigned*)(args.ws + WS_CTL);
    volatile LAS unsigned* MISC = (volatile LAS unsigned*)(F.lds + MISC_OFF);
    if (F.tid < 32) MISC[F.tid] = 0u;
    __syncthreads();
    XcdBarrier bar; bar.bar = ctl + CW_BAR; bar.x = 0; bar.st = MISC + 8;
    if (MK_FUSED) bar = xcd_barrier_post(ctl + CW_BAR, MISC + 8);
    const int lo = args.ph_lo, hi = args.ph_hi;
#define IN(k) (lo <= (k) && (k) < hi)
#define SEAM(k) do { if (IN(k) && IN((k) + 1)) xcd_barrier(bar); } while (0)
    unsigned char* ws = args.ws;
    bf16_t* xb = (bf16_t*)(ws + WS_XB); bf16_t* proj = (bf16_t*)(ws + WS_PROJ); bf16_t* y = (bf16_t*)(ws + WS_Y); float* z = (float*)(ws + WS_Z);
    float* x1 = (float*)(ws + WS_X1); bf16_t* x1b = (bf16_t*)(ws + WS_X1B); float* x2 = (float*)(ws + WS_X2); bf16_t* x2b = (bf16_t*)(ws + WS_X2B);
    bf16_t* kv = (bf16_t*)(ws + WS_KV); bf16_t* wqk = (bf16_t*)(ws + WS_WQK); bf16_t* wvo = (bf16_t*)(ws + WS_WVO); bf16_t* sp = (bf16_t*)(ws + WS_SP);
    float* Ut = (float*)(ws + WS_U); bf16_t* Rt = (bf16_t*)(ws + WS_RT);
    float* logits = (float*)(ws + WS_SMALL + SM_LOGITS); int* tok_e = (int*)(ws + WS_SMALL + SM_TOKE); int* tok_p = (int*)(ws + WS_SMALL + SM_TOKP);
    float* gates = (float*)(ws + WS_SMALL + SM_GATE); int* inv = (int*)(ws + WS_SMALL + SM_INV); int* slot_tok = (int*)(ws + WS_SMALL + SM_SLOT);
    bf16_t* act = (bf16_t*)(ws + WS_ACT); bf16_t* ysl = (bf16_t*)(ws + WS_YS);
    unsigned* gcnt = ctl + CW_CNT;
    LAS unsigned char* idxtab = F.lds + IDX_OFF;

    if (IN(0)) { phase_prep(F, args); } SEAM(0);
    if (IN(1)) {
        { pg8::ProbStd P; P.init(xb, (const bf16_t*)(ws + WS_WIN), T, DIN, 2048, 2048, 2048, F.G, F.bid); pg8::EpiBf16 E{proj, DIN, nullptr, 0, 1.0f}; pg8::gemm_phase(F.lds, idxtab, P, E); }
        { pg8::ProbStd P; P.init((const bf16_t*)(ws + WS_MEMB), (const bf16_t*)(ws + WS_WKV), 512, 4096, 2048, 2048, 2048, F.G, F.bid); pg8::EpiBf16 E{kv, 4096, nullptr, 0, 1.0f}; pg8::gemm_phase(F.lds, idxtab, P, E); }
    } SEAM(1);
    if (IN(2)) {
        for (int it = F.bid; it < BATCH * NCH; it += F.G) swa_item(F, proj, y, args.in[3], args.in[4], it / NCH, it % NCH);
        for (int it = F.bid; it < BATCH * NCH * 8; it += F.G) ret_u_item(F, proj, Ut, it / (NCH * 8), (it >> 3) % NCH, it & 7);
        __syncthreads();
        { pg8::ProbFoldA P{kv, (const bf16_t*)(ws + WS_WQN), 512, 4096, 2048, F.G, F.bid}; pg8::EpiBf16 E{wqk, 2048, nullptr, 0, 0.04419417382415922f}; pg8::gemm_phase(F.lds, idxtab, P, E); }
        { pg8::ProbFoldB P{(const bf16_t*)(ws + WS_WO), kv, 512, 2048, 4096, F.G, F.bid}; pg8::EpiBf16 E{wvo, 1024, nullptr, 0, 1.0f}; pg8::gemm_phase(F.lds, idxtab, P, E); }
    } SEAM(2);
    if (IN(3)) { phase_scan(F, Ut, Rt); } SEAM(3);
    if (IN(4)) { for (int it = F.bid; it < BATCH * NCH * 8; it += F.G) ret_o_item(F, proj, Rt, y, args.in[5], it / (NCH * 8), (it >> 3) % NCH, it & 7); __syncthreads(); } SEAM(4);
    if (IN(5)) { pg8::ProbStd P; P.init(y, (const bf16_t*)(ws + WS_WMIX), T, 2048, 2048, 2048, 2048, F.G, F.bid); pg8::EpiResF32 E{args.in[0], z, 2048, DN_ALPHA}; pg8::gemm_phase(F.lds, idxtab, P, E); } SEAM(5);
    if (IN(6)) { phase_ln(F, z, args.in[7], args.in[8], x1, x1b); } SEAM(6);
    if (IN(7)) { pg8::ProbStd P; P.init(x1b, wqk, T, 1024, 2048, 2048, 2048, F.G, F.bid); P.split_pm = 64; P.b_split_stride = (size_t)1024 * 2048; pg8::EpiBf16 E{sp, 1024, nullptr, 0, 1.0f}; pg8::gemm_phase(F.lds, idxtab, P, E); } SEAM(7);
    if (IN(8)) { phase_softmax(F, sp); } SEAM(8);
    if (IN(9)) { pg8::ProbStd P; P.init(sp, wvo, T, 2048, 1024, 1024, 1024, F.G, F.bid); P.split_pm = 64; P.b_split_stride = (size_t)2048 * 1024; pg8::EpiResF32 E{x1, z, 2048, DN_ALPHA}; pg8::gemm_phase(F.lds, idxtab, P, E); } SEAM(9);
    if (IN(10)) { phase_ln(F, z, args.in[12], args.in[13], x2, x2b); } SEAM(10);
    if (IN(11)) { pg8::ProbStd P; P.init(x2b, (const bf16_t*)(ws + WS_WR), T, 256, 2048, 2048, 2048, F.G, F.bid); pg8::EpiRouter E{logits, args.in[15]}; pg8::gemm_phase(F.lds, idxtab, P, E); } SEAM(11);
    if (IN(12)) { phase_route1(F, logits, tok_e, tok_p, gates, slot_tok, gcnt); } SEAM(12);
    if (IN(13)) { phase_route2(F, tok_e, tok_p, inv, slot_tok, gcnt); } SEAM(13);
    if (IN(14)) {
        LAS int* pstart = (LAS int*)(F.lds + TAB_OFF); LAS int* blkexp = pstart + 64; moe_tables(F, gcnt, pstart, blkexp);
        pg8::ProbMoe<true> P; P.A = x2b; P.W = (const bf16_t*)(ws + WS_WGU); P.slot_tok = slot_tok; P.blkexp = blkexp; P.K = 2048; P.lda = 2048; P.ldb = 2048; P.S.init(pstart[32] >> 8, 16, F.G, F.bid);
        pg8::EpiSwiglu E{act, args.in[17]}; pg8::gemm_phase(F.lds, idxtab, P, E);
    } SEAM(14);
    if (IN(15)) {
        LAS int* pstart = (LAS int*)(F.lds + TAB_OFF); LAS int* blkexp = pstart + 64; moe_tables(F, gcnt, pstart, blkexp);
        pg8::ProbMoe<false> P; P.A = act; P.W = (const bf16_t*)(ws + WS_WD); P.slot_tok = slot_tok; P.blkexp = blkexp; P.K = 2048; P.lda = 2048; P.ldb = 2048; P.S.init(pstart[32] >> 8, 8, F.G, F.bid);
        pg8::EpiBf16 E{ysl, 2048, args.in[19], 2048, 1.0f}; pg8::gemm_phase(F.lds, idxtab, P, E);
    } SEAM(15);
    if (IN(16)) { phase_final(F, x2, ysl, inv, gates, args.in[20], args.in[21], args.out); }
#undef IN
#undef SEAM
}

extern "C" void kernel_launch(void* const* d_in, const int* in_sizes, int n_in, void* d_out, int out_size, void* d_ws, size_t ws_size, hipStream_t stream) {
    static int grid = 0;
    if (grid == 0) {
        if (n_in != 22 || out_size != T * D || ws_size < WS_END) { fprintf(stderr, "kernel_launch: unexpected shapes (n_in %d out %d ws %zu need %zu)\n", n_in, out_size, ws_size, (size_t)WS_END); grid = -1; return; }
        int dev = 0, cus = 0, per_cu = 0;
        if (hipGetDevice(&dev) != hipSuccess || hipDeviceGetAttribute(&cus, hipDeviceAttributeMultiprocessorCount, dev) != hipSuccess) { grid = -1; return; }
        if (hipFuncSetAttribute((const void*)fwd_kernel, hipFuncAttributeMaxDynamicSharedMemorySize, LDS_BYTES) != hipSuccess) { fprintf(stderr, "kernel_launch: hipFuncSetAttribute failed\n"); grid = -1; return; }
        if (hipOccupancyMaxActiveBlocksPerMultiprocessor(&per_cu, (const void*)fwd_kernel, NTHR, LDS_BYTES) != hipSuccess || per_cu < 1) fprintf(stderr, "kernel_launch: occupancy query reports %d\n", per_cu);
        (void)hipGetLastError();
        grid = cus;
    }
    if (grid < 0) return;
    (void)hipMemsetAsync((char*)d_ws + WS_CTL, 0, CTL_ZERO_BYTES, stream);
    Args a{};
    for (int i = 0; i < 22; ++i) a.in[i] = (const float*)d_in[i];
    a.out = (float*)d_out; a.ws = (unsigned char*)d_ws;
#if MK_FUSED
    a.ph_lo = 0; a.ph_hi = NPHASE;
    hipLaunchKernelGGL(fwd_kernel, dim3(grid), dim3(NTHR), LDS_BYTES, stream, a);
#else
    for (int p = 0; p < NPHASE; ++p) { a.ph_lo = p; a.ph_hi = p + 1; hipLaunchKernelGGL(fwd_kernel, dim3(grid), dim3(NTHR), LDS_BYTES, stream, a); }
#endif
}
```

```cpp
#include <hip/hip_runtime.h>
#include <cstdio>
#include <cstdint>

#ifndef MK_FUSED
#define MK_FUSED 1
#endif

#ifndef DUP_MASK
#define DUP_MASK 0
#endif
#define LAS __attribute__((address_space(3)))
#define GAS __attribute__((address_space(1)))
typedef unsigned short bf16_t;
typedef short bf16x8 __attribute__((ext_vector_type(8)));
typedef short bf16x4 __attribute__((ext_vector_type(4)));
typedef float f32x4 __attribute__((ext_vector_type(4)));
typedef float f32x2 __attribute__((ext_vector_type(2)));
typedef unsigned u32x4 __attribute__((ext_vector_type(4)));
typedef unsigned u32x2 __attribute__((ext_vector_type(2)));
typedef int i32x8 __attribute__((ext_vector_type(8)));
typedef int i32x4 __attribute__((ext_vector_type(4)));
constexpr int W8_SCALE_BYTE = 0x78787878;
constexpr float W8_MUL = 128.0f;

constexpr int BATCH = 2, SEQ = 16384, T = BATCH * SEQ, D = 2048;
constexpr int DIN = 5376;
constexpr int OFF_QA = 0, OFF_KA = 1024, OFF_VA = 1152, OFF_QR = 1280, OFF_KR = 2304, OFF_VR = 3328, OFF_GR = 4352;
constexpr int NCH = SEQ / 128;
constexpr int NEXP = 32, NBLK_MAX = 544, NSLOT = NBLK_MAX * 256;
constexpr float LN_EPS = 1e-5f;
constexpr float DN_ALPHA = 1.18920711500272f;
constexpr int NWAVES = 8, NTHR = 512;

constexpr size_t MiB = (size_t)1 << 20;
constexpr size_t WS_CTL = 0, CTL_ZERO_BYTES = 1 * MiB;
constexpr size_t WS_WIN = 1 * MiB;
constexpr size_t WS_WMIX = WS_WIN + 21 * MiB;
constexpr size_t WS_WQN = WS_WMIX + 8 * MiB;
constexpr size_t WS_WKV = WS_WQN + 8 * MiB;
constexpr size_t WS_WO = WS_WKV + 16 * MiB;
constexpr size_t WS_WR = WS_WO + 8 * MiB;
constexpr size_t WS_WGU = WS_WR + 1 * MiB;
constexpr size_t WS_X2Q = WS_WGU + 256 * MiB;
constexpr size_t WS_WD = WS_WGU + 512 * MiB;
constexpr size_t WS_MEMB = WS_WD + 256 * MiB;
constexpr size_t WS_KV = WS_MEMB + 2 * MiB;
constexpr size_t WS_WQK = WS_KV + 4 * MiB;
constexpr size_t WS_WVO = WS_WQK + 8 * MiB;
constexpr size_t WS_SMALL = WS_WVO + 8 * MiB;
constexpr size_t WS_RT = WS_SMALL + 16 * MiB;
constexpr size_t WS_SP = WS_RT + 64 * MiB;
constexpr size_t WS_X1B = WS_SP + 64 * MiB;
constexpr size_t WS_X2B = WS_X1B + 128 * MiB;
constexpr size_t WS_X2 = WS_X2B + 128 * MiB;
constexpr size_t WS_R1 = WS_X2 + 256 * MiB;
constexpr size_t WS_XB = WS_R1;
constexpr size_t WS_PROJ = WS_XB + 128 * MiB;
constexpr size_t WS_U = WS_PROJ + 336 * MiB;
constexpr size_t WS_ACT = WS_R1;
constexpr size_t WS_R2 = WS_R1 + 592 * MiB;
constexpr size_t WS_Y = WS_R2;
constexpr size_t WS_Z = WS_Y + 128 * MiB;
constexpr size_t WS_X1 = WS_Z + 256 * MiB;
constexpr size_t WS_YS = WS_R2;
constexpr size_t WS_END = WS_R2 + 640 * MiB;
static_assert((size_t)NSLOT * 2048 * 2 <= 592 * MiB && (size_t)NSLOT * 2048 * 2 <= 640 * MiB, "overlay sizes");
constexpr size_t SM_LOGITS = 0;
constexpr size_t SM_TOKE = 4 * MiB;
constexpr size_t SM_TOKP = 5 * MiB;
constexpr size_t SM_GATE = 6 * MiB;
constexpr size_t SM_INV = 7 * MiB;
constexpr size_t SM_SLOT = 8 * MiB;
constexpr int CW_BAR = 4096, CW_CNT = 8192;

constexpr int RING_BYTES = 139264;
constexpr int IDX_OFF = RING_BYTES;
constexpr int TAB_OFF = RING_BYTES + 1024;
constexpr int MISC_OFF = RING_BYTES + 1024 + 4096;
constexpr int LDS_BYTES = 147456;
static_assert(MISC_OFF + 256 <= LDS_BYTES, "lds map");

__device__ __forceinline__ unsigned f2bf(float f) { unsigned u = __float_as_uint(f); return (u + 0x7fffu + ((u >> 16) & 1u)) >> 16; }
__device__ __forceinline__ unsigned pk2(float lo, float hi) { return f2bf(lo) | (f2bf(hi) << 16); }
__device__ __forceinline__ float bf2f(unsigned b) { return __uint_as_float(b << 16); }
__device__ __forceinline__ unsigned cvt_pk_bf16(float lo, float hi) { unsigned r; asm volatile("v_cvt_pk_bf16_f32 %0, %1, %2" : "=v"(r) : "v"(lo), "v"(hi)); return r; }
__device__ __forceinline__ f32x4 mfma16(bf16x8 a, bf16x8 b, f32x4 c) { return __builtin_amdgcn_mfma_f32_16x16x32_bf16(a, b, c, 0, 0, 0); }
__device__ __forceinline__ float wave_sum(float v) {
#pragma unroll
    for (int o = 1; o < 64; o <<= 1) v += __shfl_xor(v, o);
    return v;
}
__device__ __forceinline__ float wave_max(float v) {
#pragma unroll
    for (int o = 1; o < 64; o <<= 1) v = fmaxf(v, __shfl_xor(v, o));
    return v;
}
__device__ __forceinline__ float grp16_sum(float v) { v += __shfl_xor(v, 1); v += __shfl_xor(v, 2); v += __shfl_xor(v, 4); v += __shfl_xor(v, 8); return v; }
__device__ __forceinline__ float grp16_max(float v) { v = fmaxf(v, __shfl_xor(v, 1)); v = fmaxf(v, __shfl_xor(v, 2)); v = fmaxf(v, __shfl_xor(v, 4)); v = fmaxf(v, __shfl_xor(v, 8)); return v; }
__device__ __forceinline__ bf16x8 tr_frag(const LAS unsigned char* p, int rs4) {
    const bf16x4 lo = __builtin_amdgcn_ds_read_tr16_b64_v4i16((LAS bf16x4*)p);
    const bf16x4 hi = __builtin_amdgcn_ds_read_tr16_b64_v4i16((LAS bf16x4*)(p + rs4));
    return (bf16x8){lo[0], lo[1], lo[2], lo[3], hi[0], hi[1], hi[2], hi[3]};
}

namespace pg8 {
constexpr int BM = 256, BK = 64, HALF = 128, HTB = HALF * BK * 2, STAGE_BYTES = 8 * HTB, NXCD = 8, WGM = 8;
__host__ __device__ __forceinline__ int lds_byte(int r, int c) { const int st = (r >> 4) * 2 + (c >> 5), rr = r & 15, cc = c & 31, ob = rr * 64 + cc * 2; return st * 1024 + (ob ^ (((ob >> 9) & 1) << 5)); }
__host__ __device__ __forceinline__ void stage_rc(int b, int& R, int& C) { const int st = b / 1024, sb = b % 1024, swz = sb ^ (((sb >> 9) & 1) << 5); R = (st >> 1) * 16 + swz / 64; C = (st & 1) * 32 + (swz % 64) / 2; }
__host__ __device__ __forceinline__ int perm32(int rho) { const int n = rho >> 4, i = rho & 15; return 8 * (i >> 2) + 4 * n + (i & 3); }

struct Unit { int pm, pn, orow, ocol, aux; };

struct StaticOrder {
    int nM, nN, nwg, G, c;
    __device__ void init(int nM_, int nN_, int G_, int c_) { nM = nM_; nN = nN_; nwg = nM * nN; G = G_; c = c_; }
    __device__ bool next(int i, int& pm, int& pn) const {
        const long L = (long)i * G + c; if (L >= nwg) return false;
        int wgid = (int)L; { const int q = nwg / NXCD, r = nwg % NXCD, xcd = wgid % NXCD, off = wgid / NXCD; wgid = (xcd < r ? xcd * (q + 1) : r * (q + 1) + (xcd - r) * q) + off; }
        const int nig = WGM * nN, gid = wgid / nig, fm = gid * WGM, gsz = (nM - fm) < WGM ? (nM - fm) : WGM;
        pm = fm + ((wgid % nig) % gsz); pn = (wgid % nig) / gsz; return true;
    }
};

template <class Epi, class Prob>
__device__ __forceinline__ void gemm_phase(LAS unsigned char* lds, LAS unsigned char* idxtab, const Prob& P, const Epi& E) {
    const int tid = threadIdx.x, wid = __builtin_amdgcn_readfirstlane(tid >> 6), lane = tid & 63, wr = wid >> 2, wc = wid & 3, fr = lane & 15, fq = lane >> 4;
    const int K = P.K, nt = Prob::FP8 ? K / 128 : K / BK;
    constexpr bool GATHER = Prob::GATHER; constexpr bool FP8 = Prob::FP8; constexpr unsigned ES = FP8 ? 1u : 2u;
    const unsigned lda2 = (unsigned)P.lda * ES, ldb2 = (unsigned)P.ldb * ES;
    unsigned voffB, oc[2][2], on[2][2]; int rA[2]; unsigned cA2;
    { int R, C; stage_rc(tid * 16, R, C); const int Rb = Epi::PERM ? ((R & ~31) + perm32(R & 31)) : R;
        voffB = (unsigned)Rb * ldb2 + (unsigned)C * 2u; rA[0] = R; rA[1] = R + 64; cA2 = (unsigned)C * 2u;
#pragma unroll
        for (int i = 0; i < 2; ++i)
#pragma unroll
            for (int h = 0; h < 2; ++h) { oc[h][i] = (unsigned)R * lda2 + cA2; on[h][i] = oc[h][i]; } }
    const size_t pstepA = (size_t)64 * lda2, pstepB = (size_t)64 * ldb2, hstepA = (size_t)HALF * lda2;
    const size_t kstep = (size_t)(BK * 2);
    const size_t hstepB = (size_t)HALF * ldb2;
    const unsigned ldsw = (unsigned)wid * 1024u, ldsbase = (unsigned)(size_t)lds;
    const int aoff = lds_byte(wr * 64 + fr, fq * 8), boff = lds_byte(wc * 32 + fr, fq * 8);
#define PG8_SA(b, h) (((b) * 2 + (h)) * HTB)
#define PG8_SB(b, h) ((4 + (b) * 2 + (h)) * HTB)
#define PG8_GLDS(ldsdst, gptr, voff32) do { unsigned keep_; asm volatile("s_mov_b32 %0, m0\n\ts_mov_b32 m0, %2\n\ts_nop 0\n\tglobal_load_lds_dwordx4 %1, %3\n\ts_mov_b32 m0, %0" \
        : "=&s"(keep_) : "v"(voff32), "s"(ldsdst), "s"(gptr) : "memory"); } while (0)
#define PG8_STAGE_B(bufoff, gbase) do { PG8_GLDS(ldsbase + (unsigned)(bufoff) + ldsw, (const char*)(gbase), voffB); PG8_GLDS(ldsbase + (unsigned)(bufoff) + ldsw + 8192u, (const char*)(gbase) + pstepB, voffB); } while (0)
#define PG8_STAGE_A(bufoff, gbase, o, h) do { if constexpr (GATHER) { PG8_GLDS(ldsbase + (unsigned)(bufoff) + ldsw, (const char*)(gbase), (o)[h][0]); PG8_GLDS(ldsbase + (unsigned)(bufoff) + ldsw + 8192u, (const char*)(gbase), (o)[h][1]); } \
        else { PG8_GLDS(ldsbase + (unsigned)(bufoff) + ldsw, (const char*)(gbase) + (h) * hstepA, oc[0][0]); PG8_GLDS(ldsbase + (unsigned)(bufoff) + ldsw + 8192u, (const char*)(gbase) + (h) * hstepA + pstepA, oc[0][0]); } } while (0)
#define PG8_LDA(dst, b, h) do { _Pragma("unroll") for (int m = 0; m < 4; ++m) { \
        if constexpr (FP8) { const i32x4 lo_ = *(const LAS i32x4*)(lds + PG8_SA(b, h) + aoff + m * 2048), hi_ = *(const LAS i32x4*)(lds + PG8_SA(b, h) + aoff + m * 2048 + 1024); \
            dst##8[m] = (i32x8){lo_.x, lo_.y, lo_.z, lo_.w, hi_.x, hi_.y, hi_.z, hi_.w}; } \
        else { _Pragma("unroll") for (int k = 0; k < 2; ++k) dst[m][k] = *(const LAS bf16x8*)(lds + PG8_SA(b, h) + aoff + m * 2048 + k * 1024); } } } while (0)
#define PG8_LDB(dst, b, h) do { _Pragma("unroll") for (int n = 0; n < 2; ++n) { \
        if constexpr (FP8) { const i32x4 lo_ = *(const LAS i32x4*)(lds + PG8_SB(b, h) + boff + n * 2048), hi_ = *(const LAS i32x4*)(lds + PG8_SB(b, h) + boff + n * 2048 + 1024); \
            dst##8[n] = (i32x8){lo_.x, lo_.y, lo_.z, lo_.w, hi_.x, hi_.y, hi_.z, hi_.w}; } \
        else { _Pragma("unroll") for (int k = 0; k < 2; ++k) dst[n][k] = *(const LAS bf16x8*)(lds + PG8_SB(b, h) + boff + n * 2048 + k * 1024); } } } while (0)
#define PG8_MMA(ai, bj, At, Bt) do { __builtin_amdgcn_s_setprio(1); _Pragma("unroll") for (int m = 0; m < 4; ++m) _Pragma("unroll") for (int n = 0; n < 2; ++n) { \
        if constexpr (FP8) asm volatile("s_nop 1\n\tv_mfma_scale_f32_16x16x128_f8f6f4 %0, %1, %2, %0, %3, %4 op_sel_hi:[0,0,0]" : "+v"(acc[ai][bj][m][n]) : "v"(Bt##8[n]), "v"(At##8[m]), "v"(sclW), "v"(sclA)); \
        else { _Pragma("unroll") for (int k = 0; k < 2; ++k) acc[ai][bj][m][n] = __builtin_amdgcn_mfma_f32_16x16x32_bf16(Bt[n][k], At[m][k], acc[ai][bj][m][n], 0, 0, 0); } } \
        __builtin_amdgcn_s_setprio(0); } while (0)
#define PG8_WAIT_V(n) asm volatile("s_waitcnt vmcnt(" #n ")" ::: "memory")
#define PG8_WAIT_L(n) asm volatile("s_waitcnt lgkmcnt(" #n ")" ::: "memory")
#define PG8_BAR __builtin_amdgcn_s_barrier()
#define PG8_SCHED __builtin_amdgcn_sched_barrier(0)
    Unit cur, nxt; int ui = 0;
    if (!P.next(0, cur)) return;
    f32x4 acc[2][2][4][2];
#pragma unroll
    for (int a = 0; a < 2; ++a)
#pragma unroll
        for (int b = 0; b < 2; ++b)
#pragma unroll
            for (int m = 0; m < 4; ++m)
#pragma unroll
                for (int n = 0; n < 2; ++n) acc[a][b][m][n] = (f32x4){0.f, 0.f, 0.f, 0.f};
    bf16x8 At[4][2], B0[2][2], B1[2][2]; i32x8 At8[4], B08[2], B18[2]; const int sclW = W8_SCALE_BYTE, sclA = 0x7f7f7f7f;
    const char* cA = P.a_ptr(cur); const char* cB = P.b_ptr(cur);
    if constexpr (GATHER) {
        if (wid < 4) __builtin_amdgcn_global_load_lds((const unsigned*)(P.idx_ptr(cur) + wid * 64 + lane), (LAS unsigned*)(idxtab + wid * 256), 4, 0, 0);
        PG8_WAIT_V(0); PG8_BAR;
#pragma unroll
        for (int i = 0; i < 2; ++i)
#pragma unroll
            for (int h = 0; h < 2; ++h) oc[h][i] = ((const LAS unsigned*)idxtab)[h * HALF + rA[i]] * lda2 + cA2;
        PG8_WAIT_L(0); PG8_BAR;
    }
    PG8_STAGE_B(PG8_SB(0, 0), cB); PG8_STAGE_B(PG8_SB(0, 1), cB + hstepB); PG8_STAGE_A(PG8_SA(0, 0), cA, oc, 0); PG8_STAGE_A(PG8_SA(0, 1), cA, oc, 1);
    if (wr == 1) PG8_BAR;
    PG8_WAIT_V(2); PG8_BAR;
    PG8_STAGE_B(PG8_SB(1, 0), cB + kstep); PG8_STAGE_A(PG8_SA(1, 0), cA + kstep, oc, 0); PG8_STAGE_B(PG8_SB(1, 1), cB + hstepB + kstep);
    PG8_WAIT_V(6); PG8_BAR;
    for (;;) {
        const bool has_next = P.next(ui + 1, nxt);
        const char* nA = has_next ? P.a_ptr(nxt) : cA; const char* nB = has_next ? P.b_ptr(nxt) : cB;
        if constexpr (GATHER) { if (has_next && wid < 4) __builtin_amdgcn_global_load_lds((const unsigned*)(P.idx_ptr(nxt) + wid * 64 + lane), (LAS unsigned*)(idxtab + wid * 256), 4, 0, 0); }
        for (int t = 0; t < nt; t += 2) {
            const bool last = (t == nt - 2);
            const char* a1 = cA + (size_t)(t + 1) * kstep;
            const char* a2 = last ? nA : cA + (size_t)(t + 2) * kstep; const char* b2 = last ? nB : cB + (size_t)(t + 2) * kstep;
            const char* a3 = a2 + kstep; const char* b3 = b2 + kstep;
            unsigned os[2][2];
            if constexpr (GATHER) {
                if (last && has_next) {
#pragma unroll
                    for (int i = 0; i < 2; ++i)
#pragma unroll
                        for (int h = 0; h < 2; ++h) on[h][i] = ((const LAS unsigned*)idxtab)[h * HALF + rA[i]] * lda2 + cA2;
                }
#pragma unroll
                for (int i = 0; i < 2; ++i)
#pragma unroll
                    for (int h = 0; h < 2; ++h) os[h][i] = last ? on[h][i] : oc[h][i];
            } else {
#pragma unroll
                for (int i = 0; i < 2; ++i)
#pragma unroll
                    for (int h = 0; h < 2; ++h) os[h][i] = oc[h][i];
            }
            PG8_LDB(B0, 0, 0); PG8_LDB(B1, 0, 1); PG8_SCHED; PG8_LDA(At, 0, 0); PG8_STAGE_A(PG8_SA(1, 1), a1, oc, 1);
            PG8_WAIT_V(8); PG8_WAIT_L(0); PG8_BAR; PG8_MMA(0, 0, At, B0); PG8_MMA(0, 1, At, B1); PG8_BAR; PG8_SCHED;
            PG8_LDA(At, 0, 1); PG8_STAGE_B(PG8_SB(0, 0), b2); PG8_STAGE_B(PG8_SB(0, 1), b2 + hstepB); PG8_STAGE_A(PG8_SA(0, 0), a2, os, 0);
            PG8_WAIT_V(8); PG8_WAIT_L(0); PG8_BAR; PG8_MMA(1, 0, At, B0); PG8_MMA(1, 1, At, B1); PG8_BAR; PG8_SCHED;
            PG8_LDB(B0, 1, 0); PG8_LDB(B1, 1, 1); PG8_SCHED; PG8_LDA(At, 1, 0); PG8_STAGE_A(PG8_SA(0, 1), a2, os, 1);
            PG8_WAIT_V(8); PG8_WAIT_L(0); PG8_BAR; PG8_MMA(0, 0, At, B0); PG8_MMA(0, 1, At, B1); PG8_BAR; PG8_SCHED;
            PG8_LDA(At, 1, 1); PG8_STAGE_B(PG8_SB(1, 0), b3); PG8_STAGE_B(PG8_SB(1, 1), b3 + hstepB); PG8_STAGE_A(PG8_SA(1, 0), a3, os, 0);
            PG8_WAIT_V(8); PG8_WAIT_L(0); PG8_BAR; PG8_MMA(1, 0, At, B0); PG8_MMA(1, 1, At, B1); PG8_BAR; PG8_SCHED;
        }
        if constexpr (FP8) { asm volatile("s_nop 15\n\ts_nop 15\n\ts_nop 7" ::: "memory"); PG8_SCHED; }
        if (wr == 0) PG8_BAR;
        E(acc, cur, wr, wc, fr, fq);
        if (!has_next) break;
#pragma unroll
        for (int a = 0; a < 2; ++a)
#pragma unroll
            for (int b = 0; b < 2; ++b)
#pragma unroll
                for (int m = 0; m < 4; ++m)
#pragma unroll
                    for (int n = 0; n < 2; ++n) acc[a][b][m][n] = (f32x4){0.f, 0.f, 0.f, 0.f};
        cur = nxt; cA = nA; cB = nB; ++ui;
        if constexpr (GATHER) {
#pragma unroll
            for (int i = 0; i < 2; ++i)
#pragma unroll
                for (int h = 0; h < 2; ++h) oc[h][i] = on[h][i];
        }
        if (wr == 1) PG8_BAR;
    }
    PG8_WAIT_V(0);
    PG8_BAR;
#undef PG8_SA
#undef PG8_SB
#undef PG8_STAGE_A
#undef PG8_STAGE_B
#undef PG8_GLDS
#undef PG8_LDA
#undef PG8_LDB
#undef PG8_MMA
#undef PG8_WAIT_V
#undef PG8_WAIT_L
#undef PG8_BAR
#undef PG8_SCHED
}

struct EpiBf16 {
    static constexpr bool PERM = true;
    bf16_t* O; int ldc; const float* bias; int bias_stride; float scale;
    __device__ __forceinline__ void operator()(const f32x4 (&acc)[2][2][4][2], const Unit& u, int wr, int wc, int fr, int fq) const {
        const int row0 = u.orow + wr * 64 + fr, col0 = u.ocol + wc * 32 + 8 * fq;
        f32x4 bv[2][2];
#pragma unroll
        for (int bj = 0; bj < 2; ++bj)
#pragma unroll
            for (int n = 0; n < 2; ++n) bv[bj][n] = bias ? *(const f32x4*)(bias + (size_t)u.aux * bias_stride + col0 + bj * HALF + 4 * n) : (f32x4){0.f, 0.f, 0.f, 0.f};
#pragma unroll
        for (int ai = 0; ai < 2; ++ai)
#pragma unroll
            for (int m = 0; m < 4; ++m) { bf16_t* rowp = O + (size_t)(row0 + ai * HALF + m * 16) * ldc + col0;
#pragma unroll
                for (int bj = 0; bj < 2; ++bj) { f32x4 v0 = (acc[ai][bj][m][0] + bv[bj][0]) * scale, v1 = (acc[ai][bj][m][1] + bv[bj][1]) * scale;
                    u32x4 w; w.x = cvt_pk_bf16(v0[0], v0[1]); w.y = cvt_pk_bf16(v0[2], v0[3]); w.z = cvt_pk_bf16(v1[0], v1[1]); w.w = cvt_pk_bf16(v1[2], v1[3]);
                    *(u32x4*)(rowp + bj * HALF) = w; } }
    }
};
struct EpiResF32 {
    static constexpr bool PERM = false;
    const float* res; float* out; int ldc; float alpha;
    __device__ __forceinline__ void operator()(const f32x4 (&acc)[2][2][4][2], const Unit& u, int wr, int wc, int fr, int fq) const {
        const int row0 = u.orow + wr * 64 + fr, col0 = u.ocol + wc * 32 + 4 * fq;
#pragma unroll
        for (int ai = 0; ai < 2; ++ai)
#pragma unroll
            for (int m = 0; m < 4; ++m) { const size_t off = (size_t)(row0 + ai * HALF + m * 16) * ldc + col0;
#pragma unroll
                for (int bj = 0; bj < 2; ++bj)
#pragma unroll
                    for (int n = 0; n < 2; ++n) { const f32x4 r = *(const f32x4*)(res + off + bj * HALF + n * 16); *(f32x4*)(out + off + bj * HALF + n * 16) = r * alpha + acc[ai][bj][m][n]; }
                if (m & 1) asm volatile("" ::: "memory"); }
    }
};
struct EpiRouter {
    static constexpr bool PERM = false;
    float* out; const float* bias;
    __device__ __forceinline__ void operator()(const f32x4 (&acc)[2][2][4][2], const Unit& u, int wr, int wc, int fr, int fq) const {
        if (wc != 0) return;
        const int row0 = u.orow + wr * 64 + fr;
#pragma unroll
        for (int ai = 0; ai < 2; ++ai)
#pragma unroll
            for (int m = 0; m < 4; ++m)
#pragma unroll
                for (int n = 0; n < 2; ++n) { const int c = 16 * n + 4 * fq; const f32x4 b = *(const f32x4*)(bias + c);
                    *(f32x4*)(out + (size_t)(row0 + ai * HALF + m * 16) * 32 + c) = acc[ai][0][m][n] + b; }
    }
};
struct EpiSwiglu {
    static constexpr bool PERM = true;
    unsigned char* O; const float* bias;
    __device__ __forceinline__ void operator()(const f32x4 (&acc)[2][2][4][2], const Unit& u, int wr, int wc, int fr, int fq) const {
        const int row0 = u.orow + wr * 64 + fr, col0 = u.ocol + wc * 32 + 8 * fq;
        const float* bg = bias + (size_t)u.aux * 4096 + col0; const float* bu = bg + 2048;
        const f32x4 g0 = *(const f32x4*)bg, g1 = *(const f32x4*)(bg + 4), u0 = *(const f32x4*)bu, u1 = *(const f32x4*)(bu + 4);
#pragma unroll
        for (int ai = 0; ai < 2; ++ai)
#pragma unroll
            for (int m = 0; m < 4; ++m) {
                f32x4 gl0 = acc[ai][0][m][0] + g0, gl1 = acc[ai][0][m][1] + g1, up0 = acc[ai][1][m][0] + u0, up1 = acc[ai][1][m][1] + u1;
                float r[8];
#pragma unroll
                for (int j = 0; j < 4; ++j) {
                    { const float g = fminf(gl0[j], 7.0f), uu = fminf(fmaxf(up0[j], -7.0f), 7.0f); const float sg = __builtin_amdgcn_rcpf(1.0f + __expf(-1.702f * g)); r[j] = (uu + 1.0f) * (g * sg); }
                    { const float g = fminf(gl1[j], 7.0f), uu = fminf(fmaxf(up1[j], -7.0f), 7.0f); const float sg = __builtin_amdgcn_rcpf(1.0f + __expf(-1.702f * g)); r[4 + j] = (uu + 1.0f) * (g * sg); }
                }
                int w0 = __builtin_amdgcn_cvt_pk_fp8_f32(r[0], r[1], 0, false); w0 = __builtin_amdgcn_cvt_pk_fp8_f32(r[2], r[3], w0, true);
                int w1 = __builtin_amdgcn_cvt_pk_fp8_f32(r[4], r[5], 0, false); w1 = __builtin_amdgcn_cvt_pk_fp8_f32(r[6], r[7], w1, true);
                *(u32x2*)(O + (size_t)(row0 + ai * HALF + m * 16) * 2048 + col0) = (u32x2){(unsigned)w0, (unsigned)w1}; }
    }
};

struct ProbStd {
    static constexpr bool GATHER = false, FP8 = false;
    const bf16_t* A; const bf16_t* Bt; int K, lda, ldb; StaticOrder S; int split_pm; size_t b_split_stride; int orow_extra;
    __device__ void init(const bf16_t* A_, const bf16_t* Bt_, int M, int N, int K_, int lda_, int ldb_, int G, int c) { A = A_; Bt = Bt_; K = K_; lda = lda_; ldb = ldb_; S.init(M / BM, N / BM, G, c); split_pm = 1 << 30; b_split_stride = 0; orow_extra = 0; }
    __device__ bool next(int i, Unit& u) const { if (!S.next(i, u.pm, u.pn)) return false; u.orow = u.pm * BM; u.ocol = u.pn * BM; u.aux = 0; return true; }
    __device__ const char* a_ptr(const Unit& u) const { return (const char*)(A + (size_t)u.pm * BM * lda); }
    __device__ const char* b_ptr(const Unit& u) const { return (const char*)(Bt + (size_t)u.pn * BM * ldb + (u.pm >= split_pm ? b_split_stride : 0)); }
    __device__ const int* idx_ptr(const Unit&) const { return nullptr; }
};
struct ProbFoldA {
    static constexpr bool GATHER = false, FP8 = false;
    const bf16_t* kv; const bf16_t* wq; int K, lda, ldb, G, c;
    __device__ bool next(int i, Unit& u) const { const int L = i * G + c; if (L >= 64) return false; const int bh = L >> 3; u.pm = bh; u.pn = L & 7; u.orow = (bh >> 2) * 1024 + (bh & 3) * 256; u.ocol = u.pn * 256; u.aux = 0; return true; }
    __device__ const char* a_ptr(const Unit& u) const { const int b = u.pm >> 2, h = u.pm & 3; return (const char*)(kv + (size_t)b * 256 * 4096 + h * 512); }
    __device__ const char* b_ptr(const Unit& u) const { const int h = u.pm & 3; return (const char*)(wq + (size_t)u.pn * 256 * 2048 + h * 512); }
    __device__ const int* idx_ptr(const Unit&) const { return nullptr; }
};
struct ProbFoldB {
    static constexpr bool GATHER = false, FP8 = false;
    const bf16_t* woT; const bf16_t* kv; int K, lda, ldb, G, c;
    __device__ bool next(int i, Unit& u) const { const int L = i * G + c; if (L >= 64) return false; const int bh = L >> 3; u.pm = L & 7; u.pn = bh; u.orow = (bh >> 2) * 2048 + u.pm * 256; u.ocol = (bh & 3) * 256; u.aux = 0; return true; }
    __device__ const char* a_ptr(const Unit& u) const { const int h = u.pn & 3; return (const char*)(woT + (size_t)u.pm * 256 * 2048 + h * 512); }
    __device__ const char* b_ptr(const Unit& u) const { const int b = u.pn >> 2, h = u.pn & 3; return (const char*)(kv + (size_t)b * 256 * 4096 + 2048 + h * 512); }
    __device__ const int* idx_ptr(const Unit&) const { return nullptr; }
};
template <bool G1> struct ProbMoe {
    static constexpr bool GATHER = G1, FP8 = true;
    const unsigned char* A; const unsigned char* W; const int* slot_tok; const LAS int* blkexp; int K, lda, ldb; StaticOrder S;
    __device__ bool next(int i, Unit& u) const { if (!S.next(i, u.pm, u.pn)) return false; u.orow = u.pm * BM; u.ocol = u.pn * (G1 ? 128 : 256); u.aux = __builtin_amdgcn_readfirstlane(blkexp[u.pm]); return true; }
    __device__ const char* a_ptr(const Unit& u) const { return G1 ? (const char*)A : (const char*)(A + (size_t)u.pm * BM * lda); }
    __device__ const char* b_ptr(const Unit& u) const { return (const char*)(W + ((size_t)u.aux * (G1 ? 4096 : 2048) + (size_t)u.pn * BM) * 2048); }
    __device__ const int* idx_ptr(const Unit& u) const { return slot_tok + u.pm * BM; }
};
}

#define XB_TMO      128
#define XB_XCNT(j)  (256  + 64 * (j))
#define XB_XSUB(j)  (1280 + 64 * (j))
#define XB_XGEN(j)  (2304 + 64 * (j))
#define XB_TOP      3328
#define XB_TOPGEN   3392
#define XCD_BAR_WORDS 3456
#define XB_SPIN_CAP (1u << 18)
__device__ __forceinline__ unsigned xb_ld(unsigned* p)              { return __hip_atomic_load(p, __ATOMIC_RELAXED, __HIP_MEMORY_SCOPE_AGENT); }
__device__ __forceinline__ unsigned xb_add(unsigned* p, unsigned v) { return __hip_atomic_fetch_add(p, v, __ATOMIC_RELAXED, __HIP_MEMORY_SCOPE_AGENT); }
__device__ __forceinline__ unsigned xb_xcc_id() { return (unsigned)__builtin_amdgcn_s_getreg((3 << 11) | 20) & 0xFu; }
#define XB_SPIN(cond, bar) do { unsigned _sp = 0; while (cond) { __builtin_amdgcn_s_sleep(1); \
    if ((++_sp & 255u) == 0u) { if (xb_ld(&(bar)[XB_TMO])) break; if (_sp > XB_SPIN_CAP) { atomicAdd(&(bar)[XB_TMO], 1u); break; } } } } while (0)
struct XcdBarrier { unsigned* bar; unsigned x; volatile LAS unsigned* st; };
__device__ __forceinline__ XcdBarrier xcd_barrier_post(unsigned* bar, volatile LAS unsigned* st) {
    XcdBarrier b; b.bar = bar; b.x = xb_xcc_id(); b.st = st;
    if (threadIdx.x == 0) (void)xb_add(&bar[XB_XCNT(b.x)], 1u);
    return b;
}
__device__ __forceinline__ void xcd_barrier_complete(unsigned* bar, unsigned x, unsigned& nloc, unsigned& nx) {
    const unsigned G = gridDim.x * gridDim.y * gridDim.z;
    unsigned sum, cnt, mine, sp = 0u;
    for (;;) {
        sum = 0u; cnt = 0u; mine = 0u;
#pragma unroll
        for (unsigned j = 0; j < 16; ++j) { const unsigned c = xb_ld(&bar[XB_XCNT(j)]); sum += c; cnt += (c > 0u) ? 1u : 0u; mine = (j == x) ? c : mine; }
        if (sum == G) break;
        __builtin_amdgcn_s_sleep(1);
        if ((++sp & 255u) == 0u) { if (xb_ld(&bar[XB_TMO])) break; if (sp > XB_SPIN_CAP) { atomicAdd(&bar[XB_TMO], 1u); break; } }
    }
    nloc = mine > 0u ? mine : 1u; nx = cnt > 0u ? cnt : 1u;
}
__device__ __forceinline__ void xcd_barrier(const XcdBarrier& b) {
    asm volatile("s_waitcnt vmcnt(0)" ::: "memory");
    __syncthreads();
    if (threadIdx.x == 0) {
        unsigned* bar = b.bar;
        __builtin_amdgcn_s_waitcnt(0);
        unsigned nloc = b.st[0], nx = b.st[1];
        if (nloc == 0u) { xcd_barrier_complete(bar, b.x, nloc, nx); b.st[0] = nloc; b.st[1] = nx; }
        const unsigned old = xb_add(&bar[XB_XSUB(b.x)], 1u);
        const unsigned gen = old / nloc;
        if (old + 1u == (gen + 1u) * nloc) {
            __builtin_amdgcn_fence(__ATOMIC_RELEASE, "agent");
            asm volatile("s_waitcnt vmcnt(0)" ::: "memory");
            const unsigned og = xb_add(&bar[XB_TOP], 1u);
            const unsigned tg = og / nx;
            if (og + 1u == (tg + 1u) * nx) xb_add(&bar[XB_TOPGEN], 1u);
            else XB_SPIN(xb_ld(&bar[XB_TOPGEN]) == tg, bar);
            __builtin_amdgcn_fence(__ATOMIC_ACQUIRE, "agent");
            xb_add(&bar[XB_XGEN(b.x)], 1u);
            asm volatile("s_waitcnt vmcnt(0)" ::: "memory");
        } else {
            XB_SPIN(xb_ld(&bar[XB_XGEN(b.x)]) == gen, bar);
            __builtin_amdgcn_fence(__ATOMIC_ACQUIRE, "agent");
            asm volatile("s_waitcnt vmcnt(0)" ::: "memory");
        }
    }
    __syncthreads();
}

struct Args {
    const float* in[22]; float* out; unsigned char* ws; int ph_lo, ph_hi;
};
struct Frame {
    LAS unsigned char* lds; int tid, lane, wave, G, bid;
    unsigned char* ws;
};
#define LDS_WAIT() asm volatile("s_waitcnt lgkmcnt(0)" ::: "memory")
#define VM_WAIT() asm volatile("s_waitcnt vmcnt(0)" ::: "memory")

__device__ __forceinline__ void p0_transpose_item(const float* W, int Kdim, int N, bf16_t* WT, int dst_row0, int k0, int n0, LAS float* scr, int lane) {
#pragma unroll 8
    for (int i = 0; i < 32; ++i) { const int kk = 2 * i + (lane >> 5); scr[kk * 33 + (lane & 31)] = W[(size_t)(k0 + kk) * N + n0 + (lane & 31)]; }
    LDS_WAIT(); asm volatile("" ::: "memory");
    const int c = lane & 7;
#pragma unroll
    for (int j = 0; j < 4; ++j) { const int n = (lane >> 3) + 8 * j; const LAS float* s = scr + (8 * c) * 33 + n;
        u32x4 o; o.x = pk2(s[0 * 33], s[1 * 33]); o.y = pk2(s[2 * 33], s[3 * 33]); o.z = pk2(s[4 * 33], s[5 * 33]); o.w = pk2(s[6 * 33], s[7 * 33]);
        *(u32x4*)(WT + (size_t)(dst_row0 + n) * Kdim + k0 + 8 * c) = o; }
    LDS_WAIT(); asm volatile("" ::: "memory");
}
__device__ __forceinline__ void p0_transpose_item8(const float* W, int Kdim, int N, unsigned char* WT, int dst_row0, int k0, int n0, LAS float* scr, int lane) {
#pragma unroll 16
    for (int i = 0; i < 64; ++i) { const int kk = 2 * i + (lane >> 5); scr[kk * 33 + (lane & 31)] = W[(size_t)(k0 + kk) * N + n0 + (lane & 31)]; }
    LDS_WAIT(); asm volatile("" ::: "memory");
#pragma unroll
    for (int j = 0; j < 4; ++j) { const int id = lane + 64 * j, n = id >> 3, c = id & 7; const LAS float* s = scr + (16 * c) * 33 + n;
        int w[4];
#pragma unroll
        for (int q = 0; q < 4; ++q) { int t = __builtin_amdgcn_cvt_pk_fp8_f32(s[(4 * q) * 33] * W8_MUL, s[(4 * q + 1) * 33] * W8_MUL, 0, false); w[q] = __builtin_amdgcn_cvt_pk_fp8_f32(s[(4 * q + 2) * 33] * W8_MUL, s[(4 * q + 3) * 33] * W8_MUL, t, true); }
        *(u32x4*)(WT + (size_t)(dst_row0 + n) * Kdim + k0 + 16 * c) = (u32x4){(unsigned)w[0], (unsigned)w[1], (unsigned)w[2], (unsigned)w[3]}; }
    LDS_WAIT(); asm volatile("" ::: "memory");
}
__device__ __forceinline__ void p0_convert(const float* src, bf16_t* dst, size_t n8, size_t i0, size_t stride) {
    for (size_t i = i0; i < n8; i += stride) { const f32x4 a = ((const f32x4*)src)[2 * i], b = ((const f32x4*)src)[2 * i + 1];
        u32x4 o; o.x = pk2(a[0], a[1]); o.y = pk2(a[2], a[3]); o.z = pk2(b[0], b[1]); o.w = pk2(b[2], b[3]); ((u32x4*)dst)[i] = o; }
}
__device__ __forceinline__ void phase_prep(const Frame& F, const Args& a) {
    LAS float* scr = (LAS float*)(F.lds + F.wave * 17408);
    const int gw = F.bid * NWAVES + F.wave, NGW = F.G * NWAVES;
    const float *w_in = a.in[2], *w_mix = a.in[6], *w_q = a.in[9], *w_kv = a.in[10], *w_o = a.in[11], *w_r = a.in[14], *w_gu = a.in[16], *w_d = a.in[18];
    bf16_t *WIN = (bf16_t*)(F.ws + WS_WIN), *WMIX = (bf16_t*)(F.ws + WS_WMIX), *WQN = (bf16_t*)(F.ws + WS_WQN), *WKV = (bf16_t*)(F.ws + WS_WKV), *WO = (bf16_t*)(F.ws + WS_WO),
           *WR = (bf16_t*)(F.ws + WS_WR); unsigned char *WGU = F.ws + WS_WGU, *WD = F.ws + WS_WD;
    constexpr int I_IN = 32 * (DIN / 32), I_MIX = 32 * 64, I_KV = 32 * 128, I_O = 32 * 64, I_R = 32, I_GU = 16 * 128, I_D = 16 * 64;
    constexpr int NITEMS = I_IN + I_MIX + I_KV + I_O + I_R + NEXP * I_GU + NEXP * I_D;
    for (int it = gw; it < NITEMS; it += NGW) {
        int r = it;
        if (r < I_IN) { const int nblk = DIN / 32, kb = r / nblk, nb = r % nblk; p0_transpose_item(w_in, 2048, DIN, WIN, nb * 32, kb * 64, nb * 32, scr, F.lane); continue; } r -= I_IN;
        if (r < I_MIX) { const int kb = r / 64, nb = r % 64; p0_transpose_item(w_mix, 2048, 2048, WMIX, nb * 32, kb * 64, nb * 32, scr, F.lane); continue; } r -= I_MIX;
        if (r < I_KV) { const int kb = r / 128, nb = r % 128; p0_transpose_item(w_kv, 2048, 4096, WKV, nb * 32, kb * 64, nb * 32, scr, F.lane); continue; } r -= I_KV;
        if (r < I_O) { const int kb = r / 64, nb = r % 64; p0_transpose_item(w_o, 2048, 2048, WO, nb * 32, kb * 64, nb * 32, scr, F.lane); continue; } r -= I_O;
        if (r < I_R) { p0_transpose_item(w_r, 2048, 32, WR, 0, r * 64, 0, scr, F.lane); continue; } r -= I_R;
        if (r < NEXP * I_GU) { const int e = r / I_GU, q = r % I_GU, kb = q / 128, nb = q % 128, n0 = nb * 32;
            const int dst = (n0 < 2048) ? ((n0 >> 7) * 256 + (n0 & 127)) : (((n0 - 2048) >> 7) * 256 + 128 + ((n0 - 2048) & 127));
            p0_transpose_item8(w_gu + (size_t)e * 2048 * 4096, 2048, 4096, WGU + (size_t)e * 4096 * 2048, dst, kb * 128, n0, scr, F.lane); continue; } r -= NEXP * I_GU;
        { const int e = r / I_D, q = r % I_D, kb = q / 64, nb = q % 64; p0_transpose_item8(w_d + (size_t)e * 2048 * 2048, 2048, 2048, WD + (size_t)e * 2048 * 2048, nb * 32, kb * 128, nb * 32, scr, F.lane); }
    }
    const size_t gt = (size_t)F.bid * NTHR + F.tid, NGT = (size_t)F.G * NTHR;
    p0_convert(w_q, WQN, (size_t)2048 * 2048 / 8, gt, NGT);
    p0_convert(a.in[0], (bf16_t*)(F.ws + WS_XB), (size_t)T * D / 8, gt, NGT);
    p0_convert(a.in[1], (bf16_t*)(F.ws + WS_MEMB), (size_t)512 * 2048 / 8, gt, NGT);
    for (size_t i = gt; i < (size_t)224 * 2048 / 8; i += NGT) ((u32x4*)(WR + 32 * 2048))[i] = (u32x4){0u, 0u, 0u, 0u};
}

constexpr int SWA_KRS = 144;
constexpr int SWA_PRS = 336;
constexpr int SWA_K_OFF = 0, SWA_V_OFF = 256 * SWA_KRS, SWA_P_OFF = 2 * 256 * SWA_KRS, SWA_SSQ_OFF = SWA_P_OFF + 8 * 16 * SWA_PRS;
static_assert(SWA_SSQ_OFF + 512 <= RING_BYTES, "swa lds");
__device__ __forceinline__ void swa_item(const Frame& F, const bf16_t* proj, bf16_t* y, const float* sinks, const float* normw, int b, int n) {
    LAS unsigned char* Kl = F.lds + SWA_K_OFF; LAS unsigned char* Vl = F.lds + SWA_V_OFF; LAS unsigned char* Pl = F.lds + SWA_P_OFF + F.wave * 16 * SWA_PRS;
    LAS float* ssq = (LAS float*)(F.lds + SWA_SSQ_OFF);
    const int lane = F.lane, fr = lane & 15, g = lane >> 4, q4 = (lane & 15) >> 2, p4 = lane & 3;
    const size_t tok0 = (size_t)b * SEQ + (size_t)n * 128;
    if (F.tid < 128) ssq[F.tid] = 0.f;
    for (int h = 0; h < 2; ++h) {
        __syncthreads();
#pragma unroll
        for (int i = 0; i < 4; ++i) { const int id = F.tid + 512 * i, key = id >> 3, c = id & 7;
            u32x4 kv = (u32x4){0u, 0u, 0u, 0u}, vv = kv;
            if (n > 0 || key >= 128) { const bf16_t* src = proj + (tok0 - 128 + key) * DIN + h * 64 + c * 8; kv = *(const u32x4*)(src + OFF_KA); vv = *(const u32x4*)(src + OFF_VA); }
            *(LAS u32x4*)(Kl + key * SWA_KRS + c * 16) = kv; *(LAS u32x4*)(Vl + key * SWA_KRS + c * 16) = vv; }
        __syncthreads();
        const int hq = h * 8 + F.wave;
        const float slope = exp2f(-0.5f * (float)(hq + 1)), sink = sinks[hq];
        for (int rt = 0; rt < 8; ++rt) {
            const int i0 = rt * 16, kt0 = rt < 6 ? rt : 6;
            bf16x8 qf[2];
#pragma unroll
            for (int ks = 0; ks < 2; ++ks) qf[ks] = *(const bf16x8*)(proj + (tok0 + i0 + fr) * DIN + OFF_QA + hq * 64 + ks * 32 + 8 * g);
            f32x4 s[10];
#pragma unroll
            for (int tt = 0; tt < 10; ++tt) { f32x4 acc = (f32x4){0.f, 0.f, 0.f, 0.f};
#pragma unroll
                for (int ks = 0; ks < 2; ++ks) { const bf16x8 kf = *(const LAS bf16x8*)(Kl + ((kt0 + tt) * 16 + fr) * SWA_KRS + (ks * 32 + 8 * g) * 2); acc = mfma16(qf[ks], kf, acc); }
                s[tt] = acc; }
            float mx[4] = {-1e30f, -1e30f, -1e30f, -1e30f};
#pragma unroll
            for (int tt = 0; tt < 10; ++tt)
#pragma unroll
                for (int r = 0; r < 4; ++r) { const int i = i0 + 4 * g + r, j = (kt0 + tt) * 16 + fr, dist = i + 128 - j;
                    const bool valid = dist >= 0 && dist < 128 && (n > 0 || j >= 128);
                    const float v = valid ? s[tt][r] * 0.125f - slope * (float)dist : -1e30f; s[tt][r] = v; mx[r] = fmaxf(mx[r], v); }
            float l[4];
#pragma unroll
            for (int r = 0; r < 4; ++r) { mx[r] = fmaxf(grp16_max(mx[r]), sink); l[r] = 0.f; }
#pragma unroll
            for (int tt = 0; tt < 10; ++tt)
#pragma unroll
                for (int r = 0; r < 4; ++r) { const float p = __expf(s[tt][r] - mx[r]); l[r] += p; *(LAS bf16_t*)(Pl + (4 * g + r) * SWA_PRS + (tt * 16 + fr) * 2) = (bf16_t)f2bf(p); }
#pragma unroll
            for (int r = 0; r < 4; ++r) l[r] = grp16_sum(l[r]) + __expf(sink - mx[r]);
            f32x4 o[4];
#pragma unroll
            for (int dt = 0; dt < 4; ++dt) o[dt] = (f32x4){0.f, 0.f, 0.f, 0.f};
#pragma unroll
            for (int kk = 0; kk < 5; ++kk) { const bf16x8 pf = *(const LAS bf16x8*)(Pl + fr * SWA_PRS + (kk * 32 + 8 * g) * 2);
#pragma unroll
                for (int dt = 0; dt < 4; ++dt) { const bf16x8 vf = tr_frag(Vl + (kt0 * 16 + kk * 32 + 8 * g + q4) * SWA_KRS + (dt * 16 + 4 * p4) * 2, 4 * SWA_KRS); o[dt] = mfma16(pf, vf, o[dt]); } }
            float sq[4] = {0.f, 0.f, 0.f, 0.f};
#pragma unroll
            for (int r = 0; r < 4; ++r) { const float il = 1.0f / l[r];
#pragma unroll
                for (int dt = 0; dt < 4; ++dt) { const float v = o[dt][r] * il; sq[r] += v * v; y[(tok0 + i0 + 4 * g + r) * 2048 + hq * 64 + dt * 16 + fr] = (bf16_t)f2bf(v); } }
#pragma unroll
            for (int r = 0; r < 4; ++r) { const float t = grp16_sum(sq[r]); if (fr == 0) atomicAdd((float*)&ssq[i0 + 4 * g + r], t); }
        }
    }
    VM_WAIT(); __syncthreads();
    for (int id = F.tid; id < 128 * 128; id += NTHR) { const int tk = id >> 7, c = id & 127; const float rs = 1.0f / sqrtf(ssq[tk] * (1.0f / 1024.0f) + LN_EPS);
        bf16_t* p = y + (tok0 + tk) * 2048 + c * 8; const u32x4 v = *(const u32x4*)p; const f32x4 w0 = *(const f32x4*)(normw + c * 8), w1 = *(const f32x4*)(normw + c * 8 + 4);
        u32x4 o; o.x = pk2(bf2f(v.x & 0xffffu) * rs * w0[0], bf2f(v.x >> 16) * rs * w0[1]); o.y = pk2(bf2f(v.y & 0xffffu) * rs * w0[2], bf2f(v.y >> 16) * rs * w0[3]);
        o.z = pk2(bf2f(v.z & 0xffffu) * rs * w1[0], bf2f(v.z >> 16) * rs * w1[1]); o.w = pk2(bf2f(v.w & 0xffffu) * rs * w1[2], bf2f(v.w >> 16) * rs * w1[3]);
        *(u32x4*)p = o; }
    __syncthreads();
}

constexpr int RET_RS = 272;
constexpr int RET_TILE = 128 * RET_RS;
__device__ __forceinline__ float ret_log2g(int h) { return log2f(1.0f - exp2f(-5.0f - (float)h)); }
__device__ __forceinline__ void ret_u_item(const Frame& F, const bf16_t* proj, float* Ut, int b, int c, int h) {
    LAS unsigned char* Kl = F.lds; LAS unsigned char* Vl = F.lds + RET_TILE;
    const int lane = F.lane, fr = lane & 15, g = lane >> 4, q4 = (lane & 15) >> 2, p4 = lane & 3, w = F.wave;
    const size_t tok0 = (size_t)b * SEQ + (size_t)c * 128; const float l2g = ret_log2g(h);
    __syncthreads();
#pragma unroll
    for (int i = 0; i < 4; ++i) { const int id = F.tid + 512 * i, key = id >> 4, ch = id & 15;
        const bf16_t* src = proj + (tok0 + key) * DIN + h * 128 + ch * 8; const u32x4 kv = *(const u32x4*)(src + OFF_KR), vv = *(const u32x4*)(src + OFF_VR);
        const float wk = exp2f(l2g * (float)(127 - key)) * 0.08838834764831845f;
        u32x4 ks; ks.x = pk2(bf2f(kv.x & 0xffffu) * wk, bf2f(kv.x >> 16) * wk); ks.y = pk2(bf2f(kv.y & 0xffffu) * wk, bf2f(kv.y >> 16) * wk);
        ks.z = pk2(bf2f(kv.z & 0xffffu) * wk, bf2f(kv.z >> 16) * wk); ks.w = pk2(bf2f(kv.w & 0xffffu) * wk, bf2f(kv.w >> 16) * wk);
        *(LAS u32x4*)(Kl + key * RET_RS + ch * 16) = ks; *(LAS u32x4*)(Vl + key * RET_RS + ch * 16) = vv; }
    __syncthreads();
    f32x4 acc[8];
#pragma unroll
    for (int et = 0; et < 8; ++et) acc[et] = (f32x4){0.f, 0.f, 0.f, 0.f};
#pragma unroll
    for (int kk = 0; kk < 4; ++kk) { const bf16x8 af = tr_frag(Kl + (kk * 32 + 8 * g + q4) * RET_RS + (w * 16 + 4 * p4) * 2, 4 * RET_RS);
#pragma unroll
        for (int et = 0; et < 8; ++et) { const bf16x8 bf = tr_frag(Vl + (kk * 32 + 8 * g + q4) * RET_RS + (et * 16 + 4 * p4) * 2, 4 * RET_RS); acc[et] = mfma16(af, bf, acc[et]); } }
    float* dst = Ut + (((size_t)b * NCH + c) * 8 + h) * 16384;
#pragma unroll
    for (int et = 0; et < 8; ++et) *(f32x4*)(dst + (et * 16 + fr) * 128 + w * 16 + 4 * g) = acc[et];
}
__device__ __forceinline__ void phase_scan(const Frame& F, const float* Ut, bf16_t* Rt) {
    const int gt = F.bid * NTHR + F.tid;
    for (int e2 = gt; e2 < 2 * 8 * 8192; e2 += F.G * NTHR) {
        const int b = e2 >> 16, h = (e2 >> 13) & 7, ed = (e2 & 8191) * 2;
        const float gC = exp2f(ret_log2g(h) * 128.0f);
        const float* up = Ut + ((size_t)b * NCH * 8 + h) * 16384 + ed; bf16_t* rp = Rt + ((size_t)b * NCH * 8 + h) * 16384 + ed;
        f32x2 st = (f32x2){0.f, 0.f};
        for (int c0 = 0; c0 < NCH; c0 += 8) {
            f32x2 u[8];
#pragma unroll
            for (int j = 0; j < 8; ++j) u[j] = *(const f32x2*)(up + (size_t)(c0 + j) * 8 * 16384);
#pragma unroll
            for (int j = 0; j < 8; ++j) { *(unsigned*)(rp + (size_t)(c0 + j) * 8 * 16384) = pk2(st.x, st.y); st = st * gC + u[j]; }
        }
    }
}
__device__ __forceinline__ void ret_o_item(const Frame& F, const bf16_t* proj, const bf16_t* Rt, bf16_t* y, const float* normw, int b, int c, int h) {
    LAS unsigned char* Kl = F.lds; LAS unsigned char* Vl = F.lds + RET_TILE; LAS unsigned char* Rl = F.lds + 2 * RET_TILE; LAS unsigned char* Sl = F.lds + 3 * RET_TILE + F.wave * 16 * RET_RS;
    const int lane = F.lane, fr = lane & 15, g = lane >> 4, q4 = (lane & 15) >> 2, p4 = lane & 3, w = F.wave;
    const size_t tok0 = (size_t)b * SEQ + (size_t)c * 128; const float l2g = ret_log2g(h);
    const bf16_t* rsrc = Rt + (((size_t)b * NCH + c) * 8 + h) * 16384;
    __syncthreads();
#pragma unroll
    for (int i = 0; i < 4; ++i) { const int id = F.tid + 512 * i, key = id >> 4, ch = id & 15;
        const bf16_t* src = proj + (tok0 + key) * DIN + h * 128 + ch * 8;
        *(LAS u32x4*)(Kl + key * RET_RS + ch * 16) = *(const u32x4*)(src + OFF_KR); *(LAS u32x4*)(Vl + key * RET_RS + ch * 16) = *(const u32x4*)(src + OFF_VR);
        *(LAS u32x4*)(Rl + key * RET_RS + ch * 16) = *(const u32x4*)(rsrc + key * 128 + ch * 8); }
    bf16x8 qf[4];
#pragma unroll
    for (int kk = 0; kk < 4; ++kk) qf[kk] = *(const bf16x8*)(proj + (tok0 + w * 16 + fr) * DIN + OFF_QR + h * 128 + kk * 32 + 8 * g);
    __syncthreads();
#pragma unroll
    for (int kt = 0; kt < 8; ++kt) {
        f32x4 acc = (f32x4){0.f, 0.f, 0.f, 0.f};
        if (kt <= w) {
#pragma unroll
            for (int kk = 0; kk < 4; ++kk) { const bf16x8 kf = *(const LAS bf16x8*)(Kl + (kt * 16 + fr) * RET_RS + (kk * 32 + 8 * g) * 2); acc = mfma16(qf[kk], kf, acc); }
        }
#pragma unroll
        for (int r = 0; r < 4; ++r) { const int qi = w * 16 + 4 * g + r, kj = kt * 16 + fr, df = qi - kj;
            const float v = df >= 0 ? acc[r] * 0.08838834764831845f * exp2f(l2g * (float)df) : 0.f;
            *(LAS bf16_t*)(Sl + (4 * g + r) * RET_RS + kj * 2) = (bf16_t)f2bf(v); }
    }
    f32x4 oi[8], oc[8];
#pragma unroll
    for (int et = 0; et < 8; ++et) { oi[et] = (f32x4){0.f, 0.f, 0.f, 0.f}; oc[et] = (f32x4){0.f, 0.f, 0.f, 0.f}; }
#pragma unroll
    for (int kk = 0; kk < 4; ++kk) {
        if (2 * kk <= w) { const bf16x8 sf = *(const LAS bf16x8*)(Sl + fr * RET_RS + (kk * 32 + 8 * g) * 2);
#pragma unroll
            for (int et = 0; et < 8; ++et) { const bf16x8 vf = tr_frag(Vl + (kk * 32 + 8 * g + q4) * RET_RS + (et * 16 + 4 * p4) * 2, 4 * RET_RS); oi[et] = mfma16(sf, vf, oi[et]); } }
#pragma unroll
        for (int et = 0; et < 8; ++et) { const bf16x8 rf = *(const LAS bf16x8*)(Rl + (et * 16 + fr) * RET_RS + (kk * 32 + 8 * g) * 2); oc[et] = mfma16(qf[kk], rf, oc[et]); }
    }
#pragma unroll
    for (int r = 0; r < 4; ++r) { const int qi = w * 16 + 4 * g + r; const float wq = exp2f(l2g * (float)(qi + 1));
        float v[8], s = 0.f;
#pragma unroll
        for (int et = 0; et < 8; ++et) { v[et] = oi[et][r] + wq * oc[et][r]; s += v[et]; }
        const float mu = grp16_sum(s) * (1.0f / 128.0f); float qv = 0.f;
#pragma unroll
        for (int et = 0; et < 8; ++et) { v[et] -= mu; qv += v[et] * v[et]; }
        const float rstd = 1.0f / sqrtf(grp16_sum(qv) * (1.0f / 128.0f) + LN_EPS);
        const bf16_t* gp = proj + (tok0 + qi) * DIN + OFF_GR + h * 128; bf16_t* yp = y + (tok0 + qi) * 2048 + 1024 + h * 128;
#pragma unroll
        for (int et = 0; et < 8; ++et) { const int e = et * 16 + fr; const float gt = bf2f(gp[e]); const float sw = gt * __builtin_amdgcn_rcpf(1.0f + __expf(-gt));
            yp[e] = (bf16_t)f2bf(v[et] * rstd * normw[h * 128 + e] * sw); }
    }
}

__device__ __forceinline__ void phase_ln(const Frame& F, const float* z, const float* w, const float* bb, float* xo, bf16_t* xb, unsigned char* xq) {
    const int gw = F.bid * NWAVES + F.wave, NGW = F.G * NWAVES;
    for (int m = gw; m < T; m += NGW) {
        const f32x4* zr = (const f32x4*)(z + (size_t)m * D) + F.lane; f32x4 v[8]; float s = 0.f;
#pragma unroll
        for (int j = 0; j < 8; ++j) { v[j] = zr[64 * j]; s += (v[j][0] + v[j][1]) + (v[j][2] + v[j][3]); }
        const float mean = wave_sum(s) * (1.0f / D); float q = 0.f;
#pragma unroll
        for (int j = 0; j < 8; ++j) { v[j] = v[j] - mean; q += (v[j][0] * v[j][0] + v[j][1] * v[j][1]) + (v[j][2] * v[j][2] + v[j][3] * v[j][3]); }
        const float rstd = 1.0f / sqrtf(wave_sum(q) * (1.0f / D) + LN_EPS);
#pragma unroll
        for (int j = 0; j < 8; ++j) { const f32x4 ww = ((const f32x4*)w)[F.lane + 64 * j], b4 = ((const f32x4*)bb)[F.lane + 64 * j]; const f32x4 o = v[j] * rstd * ww + b4;
            ((f32x4*)(xo + (size_t)m * D))[F.lane + 64 * j] = o; u32x2 p; p.x = pk2(o[0], o[1]); p.y = pk2(o[2], o[3]); ((u32x2*)(xb + (size_t)m * D))[F.lane + 64 * j] = p;
            if (xq) { int t = __builtin_amdgcn_cvt_pk_fp8_f32(o[0], o[1], 0, false); t = __builtin_amdgcn_cvt_pk_fp8_f32(o[2], o[3], t, true); ((int*)(xq + (size_t)m * D))[F.lane + 64 * j] = t; } }
    }
}
__device__ __forceinline__ void phase_softmax(const Frame& F, bf16_t* sp) {
    const int gw = F.bid * NWAVES + F.wave, NGW = F.G * NWAVES;
    for (int m = gw; m < T; m += NGW) {
#pragma unroll
        for (int h = 0; h < 4; ++h) { u32x2* p = (u32x2*)(sp + (size_t)m * 1024 + h * 256) + F.lane; const u32x2 v = *p;
            float a0 = bf2f(v.x & 0xffffu), a1 = bf2f(v.x >> 16), a2 = bf2f(v.y & 0xffffu), a3 = bf2f(v.y >> 16);
            const float mx = wave_max(fmaxf(fmaxf(a0, a1), fmaxf(a2, a3)));
            a0 = __expf(a0 - mx); a1 = __expf(a1 - mx); a2 = __expf(a2 - mx); a3 = __expf(a3 - mx);
            const float il = 1.0f / wave_sum((a0 + a1) + (a2 + a3));
            u32x2 o; o.x = pk2(a0 * il, a1 * il); o.y = pk2(a2 * il, a3 * il); *p = o; }
    }
}
__device__ __forceinline__ void phase_route1(const Frame& F, const float* logits, int* tok_e, int* tok_p, float* gates, int* slot_tok, unsigned* gcnt) {
    LAS float* lg = (LAS float*)F.lds;
    LAS int* lcnt = (LAS int*)(F.lds + 128 * 33 * 4); LAS int* lbase = lcnt + 32;
    for (int i = F.bid * NTHR + F.tid; i < NSLOT; i += F.G * NTHR) slot_tok[i] = 0;
    for (int t0 = F.bid * 128; t0 < T; t0 += F.G * 128) {
        __syncthreads();
        for (int i = F.tid; i < 128 * 32; i += NTHR) lg[(i >> 5) * 33 + (i & 31)] = logits[(size_t)t0 * 32 + i];
        if (F.tid < 32) lcnt[F.tid] = 0;
        __syncthreads();
        int id[4] = {0, 0, 0, 0}, lp[4] = {0, 0, 0, 0}; float v[4] = {0.f, 0.f, 0.f, 0.f};
        if (F.tid < 128) {
            unsigned used = 0u;
#pragma unroll
            for (int k = 0; k < 4; ++k) { float best = -3.0e38f; int bi = 0;
                for (int e = 0; e < 32; ++e) { const float x = lg[F.tid * 33 + e]; if (!((used >> e) & 1u) && x > best) { best = x; bi = e; } }
                used |= 1u << bi; v[k] = best; id[k] = bi; }
            float ex[4], sum = 0.f;
#pragma unroll
            for (int k = 0; k < 4; ++k) { ex[k] = __expf(v[k] - v[0]); sum += ex[k]; }
#pragma unroll
            for (int k = 0; k < 4; ++k) { gates[(size_t)(t0 + F.tid) * 4 + k] = ex[k] / sum; lp[k] = atomicAdd((int*)&lcnt[id[k]], 1); }
        }
        __syncthreads();
        if (F.tid < 32) lbase[F.tid] = (int)__hip_atomic_fetch_add(gcnt + F.tid, (unsigned)lcnt[F.tid], __ATOMIC_RELAXED, __HIP_MEMORY_SCOPE_AGENT);
        __syncthreads();
        if (F.tid < 128) {
#pragma unroll
            for (int k = 0; k < 4; ++k) { tok_e[(size_t)(t0 + F.tid) * 4 + k] = id[k]; tok_p[(size_t)(t0 + F.tid) * 4 + k] = lbase[id[k]] + lp[k]; }
        }
    }
}
__device__ __forceinline__ void moe_tables(const Frame& F, unsigned* gcnt, LAS int* pstart, LAS int* blkexp) {
    __syncthreads();
    if (F.tid == 0) { int acc = 0; for (int e = 0; e < 32; ++e) { pstart[e] = acc; const int cnt = (int)__hip_atomic_load(gcnt + e, __ATOMIC_RELAXED, __HIP_MEMORY_SCOPE_AGENT); acc += ((cnt + 255) >> 8) << 8; } pstart[32] = acc; }
    __syncthreads();
    for (int j = F.tid; j < NBLK_MAX; j += NTHR) { int e = 0; for (int k = 1; k < 32; ++k) if (pstart[k] <= j * 256) e = k; blkexp[j] = e; }
    __syncthreads();
}
__device__ __forceinline__ void phase_route2(const Frame& F, const int* tok_e, const int* tok_p, int* inv, int* slot_tok, unsigned* gcnt) {
    LAS int* pstart = (LAS int*)(F.lds + TAB_OFF); LAS int* blkexp = pstart + 64;
    moe_tables(F, gcnt, pstart, blkexp);
    for (int i = F.bid * NTHR + F.tid; i < T * 4; i += F.G * NTHR) { const int e = tok_e[i], dest = pstart[e] + tok_p[i]; inv[i] = dest; slot_tok[dest] = i >> 2; }
}
__device__ __forceinline__ void phase_final(const Frame& F, const float* x2, const bf16_t* ys, const int* inv, const float* gates, const float* w, const float* bb, float* out) {
    const int gw = F.bid * NWAVES + F.wave, NGW = F.G * NWAVES;
    for (int m = gw; m < T; m += NGW) {
        const f32x4* xr = (const f32x4*)(x2 + (size_t)m * D) + F.lane; f32x4 v[8];
#pragma unroll
        for (int j = 0; j < 8; ++j) v[j] = xr[64 * j] * DN_ALPHA;
#pragma unroll
        for (int k = 0; k < 4; ++k) { const int s = inv[(size_t)m * 4 + k]; const float gk = gates[(size_t)m * 4 + k]; const u32x2* yr = (const u32x2*)(ys + (size_t)s * D) + F.lane;
#pragma unroll
            for (int j = 0; j < 8; ++j) { const u32x2 p = yr[64 * j]; v[j][0] += gk * bf2f(p.x & 0xffffu); v[j][1] += gk * bf2f(p.x >> 16); v[j][2] += gk * bf2f(p.y & 0xffffu); v[j][3] += gk * bf2f(p.y >> 16); } }
        float s = 0.f;
#pragma unroll
        for (int j = 0; j < 8; ++j) s += (v[j][0] + v[j][1]) + (v[j][2] + v[j][3]);
        const float mean = wave_sum(s) * (1.0f / D); float q = 0.f;
#pragma unroll
        for (int j = 0; j < 8; ++j) { v[j] = v[j] - mean; q += (v[j][0] * v[j][0] + v[j][1] * v[j][1]) + (v[j][2] * v[j][2] + v[j][3] * v[j][3]); }
        const float rstd = 1.0f / sqrtf(wave_sum(q) * (1.0f / D) + LN_EPS);
#pragma unroll
        for (int j = 0; j < 8; ++j) { const f32x4 ww = ((const f32x4*)w)[F.lane + 64 * j], b4 = ((const f32x4*)bb)[F.lane + 64 * j]; ((f32x4*)(out + (size_t)m * D))[F.lane + 64 * j] = v[j] * rstd * ww + b4; }
    }
}

constexpr int NPHASE = 17;
__global__ void __launch_bounds__(NTHR, 2) fwd_kernel(Args args) {
    extern __shared__ __attribute__((aligned(16))) unsigned char lds_raw[];
    Frame F; F.lds = (LAS unsigned char*)lds_raw; F.tid = threadIdx.x; F.lane = F.tid & 63; F.wave = __builtin_amdgcn_readfirstlane(F.tid >> 6); F.G = gridDim.x; F.bid = blockIdx.x; F.ws = args.ws;
    unsigned* ctl = (unsigned*)(args.ws + WS_CTL);
    volatile LAS unsigned* MISC = (volatile LAS unsigned*)(F.lds + MISC_OFF);
    if (F.tid < 32) MISC[F.tid] = 0u;
    __syncthreads();
    XcdBarrier bar; bar.bar = ctl + CW_BAR; bar.x = 0; bar.st = MISC + 8;
    if (MK_FUSED) bar = xcd_barrier_post(ctl + CW_BAR, MISC + 8);
    const int lo = args.ph_lo, hi = args.ph_hi;
#define IN(k) (lo <= (k) && (k) < hi)
#define DUPK(k) ((DUP_MASK >> (k)) & 1)
#define SEAM(k) do { if (IN(k) && IN((k) + 1)) xcd_barrier(bar); } while (0)
    unsigned char* ws = args.ws;
    bf16_t* xb = (bf16_t*)(ws + WS_XB); bf16_t* proj = (bf16_t*)(ws + WS_PROJ); bf16_t* y = (bf16_t*)(ws + WS_Y); float* z = (float*)(ws + WS_Z);
    float* x1 = (float*)(ws + WS_X1); bf16_t* x1b = (bf16_t*)(ws + WS_X1B); float* x2 = (float*)(ws + WS_X2); bf16_t* x2b = (bf16_t*)(ws + WS_X2B);
    bf16_t* kv = (bf16_t*)(ws + WS_KV); bf16_t* wqk = (bf16_t*)(ws + WS_WQK); bf16_t* wvo = (bf16_t*)(ws + WS_WVO); bf16_t* sp = (bf16_t*)(ws + WS_SP);
    float* Ut = (float*)(ws + WS_U); bf16_t* Rt = (bf16_t*)(ws + WS_RT);
    float* logits = (float*)(ws + WS_SMALL + SM_LOGITS); int* tok_e = (int*)(ws + WS_SMALL + SM_TOKE); int* tok_p = (int*)(ws + WS_SMALL + SM_TOKP);
    float* gates = (float*)(ws + WS_SMALL + SM_GATE); int* inv = (int*)(ws + WS_SMALL + SM_INV); int* slot_tok = (int*)(ws + WS_SMALL + SM_SLOT);
    unsigned char* act = ws + WS_ACT; bf16_t* ysl = (bf16_t*)(ws + WS_YS); unsigned char* x2q = ws + WS_X2Q;
    unsigned* gcnt = ctl + CW_CNT;
    LAS unsigned char* idxtab = F.lds + IDX_OFF;

    if (IN(0)) { phase_prep(F, args); if (DUPK(0)) { __syncthreads(); phase_prep(F, args); } } SEAM(0);
    if (IN(1)) {
        { pg8::ProbStd P; P.init(xb, (const bf16_t*)(ws + WS_WIN), T, DIN, 2048, 2048, 2048, F.G, F.bid); pg8::EpiBf16 E{proj, DIN, nullptr, 0, 1.0f}; pg8::gemm_phase(F.lds, idxtab, P, E); }
        { pg8::ProbStd P; P.init((const bf16_t*)(ws + WS_MEMB), (const bf16_t*)(ws + WS_WKV), 512, 4096, 2048, 2048, 2048, F.G, F.bid); pg8::EpiBf16 E{kv, 4096, nullptr, 0, 1.0f}; pg8::gemm_phase(F.lds, idxtab, P, E); }
    } SEAM(1);
#define P2_BODY \
        for (int it = F.bid; it < BATCH * NCH; it += F.G) swa_item(F, proj, y, args.in[3], args.in[4], it / NCH, it % NCH); \
        for (int it = F.bid; it < BATCH * NCH * 8; it += F.G) ret_u_item(F, proj, Ut, it / (NCH * 8), (it >> 3) % NCH, it & 7); \
        __syncthreads(); \
        { pg8::ProbFoldA P{kv, (const bf16_t*)(ws + WS_WQN), 512, 4096, 2048, F.G, F.bid}; pg8::EpiBf16 E{wqk, 2048, nullptr, 0, 0.04419417382415922f}; pg8::gemm_phase(F.lds, idxtab, P, E); } \
        { pg8::ProbFoldB P{(const bf16_t*)(ws + WS_WO), kv, 512, 2048, 4096, F.G, F.bid}; pg8::EpiBf16 E{wvo, 1024, nullptr, 0, 1.0f}; pg8::gemm_phase(F.lds, idxtab, P, E); }
    if (IN(2)) { P2_BODY if (DUPK(2)) { __syncthreads(); P2_BODY }
    } SEAM(2);
    if (IN(3)) { phase_scan(F, Ut, Rt); if (DUPK(3)) phase_scan(F, Ut, Rt); } SEAM(3);
    #define P4_BODY { for (int it = F.bid; it < BATCH * NCH * 8; it += F.G) ret_o_item(F, proj, Rt, y, args.in[5], it / (NCH * 8), (it >> 3) % NCH, it & 7); __syncthreads(); }
    if (IN(4)) { P4_BODY if (DUPK(4)) P4_BODY } SEAM(4);
    if (IN(5)) { pg8::ProbStd P; P.init(y, (const bf16_t*)(ws + WS_WMIX), T, 2048, 2048, 2048, 2048, F.G, F.bid); pg8::EpiResF32 E{args.in[0], z, 2048, DN_ALPHA}; pg8::gemm_phase(F.lds, idxtab, P, E); } SEAM(5);
    if (IN(6)) { phase_ln(F, z, args.in[7], args.in[8], x1, x1b, nullptr); if (DUPK(6)) phase_ln(F, z, args.in[7], args.in[8], x1, x1b, nullptr); } SEAM(6);
    if (IN(7)) { pg8::ProbStd P; P.init(x1b, wqk, T, 1024, 2048, 2048, 2048, F.G, F.bid); P.split_pm = 64; P.b_split_stride = (size_t)1024 * 2048; pg8::EpiBf16 E{sp, 1024, nullptr, 0, 1.0f}; pg8::gemm_phase(F.lds, idxtab, P, E); } SEAM(7);
    if (IN(8)) { phase_softmax(F, sp); } SEAM(8);
    if (IN(9)) { pg8::ProbStd P; P.init(sp, wvo, T, 2048, 1024, 1024, 1024, F.G, F.bid); P.split_pm = 64; P.b_split_stride = (size_t)2048 * 1024; pg8::EpiResF32 E{x1, z, 2048, DN_ALPHA}; pg8::gemm_phase(F.lds, idxtab, P, E); } SEAM(9);
    if (IN(10)) { phase_ln(F, z, args.in[12], args.in[13], x2, x2b, x2q); if (DUPK(10)) phase_ln(F, z, args.in[12], args.in[13], x2, x2b, x2q); } SEAM(10);
    if (IN(11)) { pg8::ProbStd P; P.init(x2b, (const bf16_t*)(ws + WS_WR), T, 256, 2048, 2048, 2048, F.G, F.bid); pg8::EpiRouter E{logits, args.in[15]}; pg8::gemm_phase(F.lds, idxtab, P, E); } SEAM(11);
    if (IN(12)) { phase_route1(F, logits, tok_e, tok_p, gates, slot_tok, gcnt); } SEAM(12);
    if (IN(13)) { phase_route2(F, tok_e, tok_p, inv, slot_tok, gcnt); } SEAM(13);
    if (IN(14)) {
        LAS int* pstart = (LAS int*)(F.lds + TAB_OFF); LAS int* blkexp = pstart + 64; moe_tables(F, gcnt, pstart, blkexp);
        pg8::ProbMoe<true> P; P.A = x2q; P.W = ws + WS_WGU; P.slot_tok = slot_tok; P.blkexp = blkexp; P.K = 2048; P.lda = 2048; P.ldb = 2048; P.S.init(pstart[32] >> 8, 16, F.G, F.bid);
        pg8::EpiSwiglu E{act, args.in[17]}; pg8::gemm_phase(F.lds, idxtab, P, E);
    } SEAM(14);
    if (IN(15)) {
        LAS int* pstart = (LAS int*)(F.lds + TAB_OFF); LAS int* blkexp = pstart + 64; moe_tables(F, gcnt, pstart, blkexp);
        pg8::ProbMoe<false> P; P.A = act; P.W = ws + WS_WD; P.slot_tok = slot_tok; P.blkexp = blkexp; P.K = 2048; P.lda = 2048; P.ldb = 2048; P.S.init(pstart[32] >> 8, 8, F.G, F.bid);
        pg8::EpiBf16 E{ysl, 2048, args.in[19], 2048, 1.0f}; pg8::gemm_phase(F.lds, idxtab, P, E);
    } SEAM(15);
    if (IN(16)) { phase_final(F, x2, ysl, inv, gates, args.in[20], args.in[21], args.out); if (DUPK(16)) phase_final(F, x2, ysl, inv, gates, args.in[20], args.in[21], args.out); }
#undef IN
#undef SEAM
}

extern "C" void kernel_launch(void* const* d_in, const int* in_sizes, int n_in, void* d_out, int out_size, void* d_ws, size_t ws_size, hipStream_t stream) {
    static int grid = 0;
    if (grid == 0) {
        if (n_in != 22 || out_size != T * D || ws_size < WS_END) { fprintf(stderr, "kernel_launch: unexpected shapes (n_in %d out %d ws %zu need %zu)\n", n_in, out_size, ws_size, (size_t)WS_END); grid = -1; return; }
        int dev = 0, cus = 0, per_cu = 0;
        if (hipGetDevice(&dev) != hipSuccess || hipDeviceGetAttribute(&cus, hipDeviceAttributeMultiprocessorCount, dev) != hipSuccess) { grid = -1; return; }
        if (hipFuncSetAttribute((const void*)fwd_kernel, hipFuncAttributeMaxDynamicSharedMemorySize, LDS_BYTES) != hipSuccess) { fprintf(stderr, "kernel_launch: hipFuncSetAttribute failed\n"); grid = -1; return; }
        if (hipOccupancyMaxActiveBlocksPerMultiprocessor(&per_cu, (const void*)fwd_kernel, NTHR, LDS_BYTES) != hipSuccess || per_cu < 1) fprintf(stderr, "kernel_launch: occupancy query reports %d\n", per_cu);
        (void)hipGetLastError();
        grid = cus;
    }
    if (grid < 0) return;
    (void)hipMemsetAsync((char*)d_ws + WS_CTL, 0, CTL_ZERO_BYTES, stream);
    Args a{};
    for (int i = 0; i < 22; ++i) a.in[i] = (const float*)d_in[i];
    a.out = (float*)d_out; a.ws = (unsigned char*)d_ws;
#if MK_FUSED
    a.ph_lo = 0; a.ph_hi = NPHASE;
    hipLaunchKernelGGL(fwd_kernel, dim3(grid), dim3(NTHR), LDS_BYTES, stream, a);
#else
    for (int p = 0; p < NPHASE; ++p) { a.ph_lo = p; a.ph_hi = p + 1; hipLaunchKernelGGL(fwd_kernel, dim3(grid), dim3(NTHR), LDS_BYTES, stream, a); }
#endif
}
```

```cpp
#include <hip/hip_runtime.h>
#include <cstdio>
#include <cstdint>

#ifndef MK_FUSED
#define MK_FUSED 1
#endif

#ifndef DUP_MASK
#define DUP_MASK 0
#endif
#define LAS __attribute__((address_space(3)))
#define GAS __attribute__((address_space(1)))
typedef unsigned short bf16_t;
typedef short bf16x8 __attribute__((ext_vector_type(8)));
typedef short bf16x4 __attribute__((ext_vector_type(4)));
typedef float f32x4 __attribute__((ext_vector_type(4)));
typedef float f32x2 __attribute__((ext_vector_type(2)));
typedef unsigned u32x4 __attribute__((ext_vector_type(4)));
typedef unsigned u32x2 __attribute__((ext_vector_type(2)));
typedef int i32x8 __attribute__((ext_vector_type(8)));
typedef int i32x4 __attribute__((ext_vector_type(4)));
constexpr int W8_SCALE_BYTE = 0x78787878;
constexpr float W8_MUL = 128.0f;

constexpr int BATCH = 2, SEQ = 16384, T = BATCH * SEQ, D = 2048;
constexpr int DIN = 5376;
constexpr int OFF_QA = 0, OFF_KA = 1024, OFF_VA = 1152, OFF_QR = 1280, OFF_KR = 2304, OFF_VR = 3328, OFF_GR = 4352;
constexpr int NCH = SEQ / 128;
constexpr int NEXP = 32, NBLK_MAX = 544, NSLOT = NBLK_MAX * 256;
constexpr float LN_EPS = 1e-5f;
constexpr float DN_ALPHA = 1.18920711500272f;
constexpr int NWAVES = 8, NTHR = 512;

constexpr size_t MiB = (size_t)1 << 20;
constexpr size_t WS_CTL = 0, CTL_ZERO_BYTES = 1 * MiB;
constexpr size_t WS_WIN = 1 * MiB;
constexpr size_t WS_WMIX = WS_WIN + 21 * MiB;
constexpr size_t WS_WQN = WS_WMIX + 8 * MiB;
constexpr size_t WS_WKV = WS_WQN + 8 * MiB;
constexpr size_t WS_WO = WS_WKV + 16 * MiB;
constexpr size_t WS_WR = WS_WO + 8 * MiB;
constexpr size_t WS_WGU = WS_WR + 1 * MiB;
constexpr size_t WS_X2Q = WS_WGU + 256 * MiB;
constexpr size_t WS_WD = WS_WGU + 512 * MiB;
constexpr size_t WS_MEMB = WS_WD + 256 * MiB;
constexpr size_t WS_KV = WS_MEMB + 2 * MiB;
constexpr size_t WS_WQK = WS_KV + 4 * MiB;
constexpr size_t WS_WVO = WS_WQK + 8 * MiB;
constexpr size_t WS_SMALL = WS_WVO + 8 * MiB;
constexpr size_t WS_RT = WS_SMALL + 16 * MiB;
constexpr size_t WS_SP = WS_RT + 64 * MiB;
constexpr size_t WS_X1B = WS_SP + 64 * MiB;
constexpr size_t WS_X2B = WS_X1B + 128 * MiB;
constexpr size_t WS_X2 = WS_X2B + 128 * MiB;
constexpr size_t WS_R1 = WS_X2 + 256 * MiB;
constexpr size_t WS_XB = WS_R1;
constexpr size_t WS_PROJ = WS_XB + 128 * MiB;
constexpr size_t WS_U = WS_PROJ + 336 * MiB;
constexpr size_t WS_ACT = WS_R1;
constexpr size_t WS_R2 = WS_R1 + 592 * MiB;
constexpr size_t WS_Y = WS_R2;
constexpr size_t WS_Z = WS_Y + 128 * MiB;
constexpr size_t WS_X1 = WS_Z + 256 * MiB;
constexpr size_t WS_YS = WS_R2;
constexpr size_t WS_END = WS_R2 + 640 * MiB;
static_assert((size_t)NSLOT * 2048 * 2 <= 592 * MiB && (size_t)NSLOT * 2048 * 2 <= 640 * MiB, "overlay sizes");
constexpr size_t SM_LOGITS = 0;
constexpr size_t SM_TOKE = 4 * MiB;
constexpr size_t SM_TOKP = 5 * MiB;
constexpr size_t SM_GATE = 6 * MiB;
constexpr size_t SM_INV = 7 * MiB;
constexpr size_t SM_SLOT = 8 * MiB;
constexpr int CW_BAR = 4096, CW_CNT = 8192;

constexpr int RING_BYTES = 139264;
constexpr int IDX_OFF = RING_BYTES;
constexpr int TAB_OFF = RING_BYTES + 1024;
constexpr int MISC_OFF = RING_BYTES + 1024 + 4096;
constexpr int LDS_BYTES = 147456;
static_assert(MISC_OFF + 256 <= LDS_BYTES, "lds map");

__device__ __forceinline__ unsigned f2bf(float f) { unsigned u = __float_as_uint(f); return (u + 0x7fffu + ((u >> 16) & 1u)) >> 16; }
__device__ __forceinline__ unsigned pk2(float lo, float hi) { return f2bf(lo) | (f2bf(hi) << 16); }
__device__ __forceinline__ float bf2f(unsigned b) { return __uint_as_float(b << 16); }
__device__ __forceinline__ unsigned cvt_pk_bf16(float lo, float hi) { unsigned r; asm volatile("v_cvt_pk_bf16_f32 %0, %1, %2" : "=v"(r) : "v"(lo), "v"(hi)); return r; }
__device__ __forceinline__ f32x4 mfma16(bf16x8 a, bf16x8 b, f32x4 c) { return __builtin_amdgcn_mfma_f32_16x16x32_bf16(a, b, c, 0, 0, 0); }
__device__ __forceinline__ float wave_sum(float v) {
#pragma unroll
    for (int o = 1; o < 64; o <<= 1) v += __shfl_xor(v, o);
    return v;
}
__device__ __forceinline__ float wave_max(float v) {
#pragma unroll
    for (int o = 1; o < 64; o <<= 1) v = fmaxf(v, __shfl_xor(v, o));
    return v;
}
__device__ __forceinline__ float grp16_sum(float v) { v += __shfl_xor(v, 1); v += __shfl_xor(v, 2); v += __shfl_xor(v, 4); v += __shfl_xor(v, 8); return v; }
__device__ __forceinline__ float grp16_max(float v) { v = fmaxf(v, __shfl_xor(v, 1)); v = fmaxf(v, __shfl_xor(v, 2)); v = fmaxf(v, __shfl_xor(v, 4)); v = fmaxf(v, __shfl_xor(v, 8)); return v; }
__device__ __forceinline__ bf16x8 tr_frag(const LAS unsigned char* p, int rs4) {
    const bf16x4 lo = __builtin_amdgcn_ds_read_tr16_b64_v4i16((LAS bf16x4*)p);
    const bf16x4 hi = __builtin_amdgcn_ds_read_tr16_b64_v4i16((LAS bf16x4*)(p + rs4));
    return (bf16x8){lo[0], lo[1], lo[2], lo[3], hi[0], hi[1], hi[2], hi[3]};
}

namespace pg8 {
constexpr int BM = 256, BK = 64, HALF = 128, HTB = HALF * BK * 2, STAGE_BYTES = 8 * HTB, NXCD = 8, WGM = 8;
__host__ __device__ __forceinline__ int lds_byte(int r, int c) { const int st = (r >> 4) * 2 + (c >> 5), rr = r & 15, cc = c & 31, ob = rr * 64 + cc * 2; return st * 1024 + (ob ^ (((ob >> 9) & 1) << 5)); }
__host__ __device__ __forceinline__ void stage_rc(int b, int& R, int& C) { const int st = b / 1024, sb = b % 1024, swz = sb ^ (((sb >> 9) & 1) << 5); R = (st >> 1) * 16 + swz / 64; C = (st & 1) * 32 + (swz % 64) / 2; }
__host__ __device__ __forceinline__ int perm32(int rho) { const int n = rho >> 4, i = rho & 15; return 8 * (i >> 2) + 4 * n + (i & 3); }

struct Unit { int pm, pn, orow, ocol, aux; };

struct StaticOrder {
    int nM, nN, nwg, G, c;
    __device__ void init(int nM_, int nN_, int G_, int c_) { nM = nM_; nN = nN_; nwg = nM * nN; G = G_; c = c_; }
    __device__ bool next(int i, int& pm, int& pn) const {
        const long L = (long)i * G + c; if (L >= nwg) return false;
        int wgid = (int)L; { const int q = nwg / NXCD, r = nwg % NXCD, xcd = wgid % NXCD, off = wgid / NXCD; wgid = (xcd < r ? xcd * (q + 1) : r * (q + 1) + (xcd - r) * q) + off; }
        const int nig = WGM * nN, gid = wgid / nig, fm = gid * WGM, gsz = (nM - fm) < WGM ? (nM - fm) : WGM;
        pm = fm + ((wgid % nig) % gsz); pn = (wgid % nig) / gsz; return true;
    }
};

template <class Epi, class Prob>
__device__ __forceinline__ void gemm_phase(LAS unsigned char* lds, LAS unsigned char* idxtab, const Prob& P, const Epi& E) {
    const int tid = threadIdx.x, wid = __builtin_amdgcn_readfirstlane(tid >> 6), lane = tid & 63, wr = wid >> 2, wc = wid & 3, fr = lane & 15, fq = lane >> 4;
    const int K = P.K, nt = Prob::FP8 ? K / 128 : K / BK;
    constexpr bool GATHER = Prob::GATHER; constexpr bool FP8 = Prob::FP8; constexpr unsigned ES = FP8 ? 1u : 2u;
    const unsigned lda2 = (unsigned)P.lda * ES, ldb2 = (unsigned)P.ldb * ES;
    unsigned voffB, oc[2][2], on[2][2]; int rA[2]; unsigned cA2;
    { int R, C; stage_rc(tid * 16, R, C); const int Rb = Epi::PERM ? ((R & ~31) + perm32(R & 31)) : R;
        voffB = (unsigned)Rb * ldb2 + (unsigned)C * 2u; rA[0] = R; rA[1] = R + 64; cA2 = (unsigned)C * 2u;
#pragma unroll
        for (int i = 0; i < 2; ++i)
#pragma unroll
            for (int h = 0; h < 2; ++h) { oc[h][i] = (unsigned)R * lda2 + cA2; on[h][i] = oc[h][i]; } }
    const size_t pstepA = (size_t)64 * lda2, pstepB = (size_t)64 * ldb2, hstepA = (size_t)HALF * lda2;
    const size_t kstep = (size_t)(BK * 2);
    const size_t hstepB = (size_t)HALF * ldb2;
    const unsigned ldsw = (unsigned)wid * 1024u, ldsbase = (unsigned)(size_t)lds;
    const int aoff = lds_byte(wr * 64 + fr, fq * 8), boff = lds_byte(wc * 32 + fr, fq * 8);
#define PG8_SA(b, h) (((b) * 2 + (h)) * HTB)
#define PG8_SB(b, h) ((4 + (b) * 2 + (h)) * HTB)
#define PG8_GLDS(ldsdst, gptr, voff32) do { unsigned keep_; asm volatile("s_mov_b32 %0, m0\n\ts_mov_b32 m0, %2\n\ts_nop 0\n\tglobal_load_lds_dwordx4 %1, %3\n\ts_mov_b32 m0, %0" \
        : "=&s"(keep_) : "v"(voff32), "s"(ldsdst), "s"(gptr) : "memory"); } while (0)
#define PG8_STAGE_B(bufoff, gbase) do { PG8_GLDS(ldsbase + (unsigned)(bufoff) + ldsw, (const char*)(gbase), voffB); PG8_GLDS(ldsbase + (unsigned)(bufoff) + ldsw + 8192u, (const char*)(gbase) + pstepB, voffB); } while (0)
#define PG8_STAGE_A(bufoff, gbase, o, h) do { if constexpr (GATHER) { PG8_GLDS(ldsbase + (unsigned)(bufoff) + ldsw, (const char*)(gbase), (o)[h][0]); PG8_GLDS(ldsbase + (unsigned)(bufoff) + ldsw + 8192u, (const char*)(gbase), (o)[h][1]); } \
        else { PG8_GLDS(ldsbase + (unsigned)(bufoff) + ldsw, (const char*)(gbase) + (h) * hstepA, oc[0][0]); PG8_GLDS(ldsbase + (unsigned)(bufoff) + ldsw + 8192u, (const char*)(gbase) + (h) * hstepA + pstepA, oc[0][0]); } } while (0)
#define PG8_LDA(dst, b, h) do { _Pragma("unroll") for (int m = 0; m < 4; ++m) { \
        if constexpr (FP8) { const i32x4 lo_ = *(const LAS i32x4*)(lds + PG8_SA(b, h) + aoff + m * 2048), hi_ = *(const LAS i32x4*)(lds + PG8_SA(b, h) + aoff + m * 2048 + 1024); \
            dst##8[m] = (i32x8){lo_.x, lo_.y, lo_.z, lo_.w, hi_.x, hi_.y, hi_.z, hi_.w}; } \
        else { _Pragma("unroll") for (int k = 0; k < 2; ++k) dst[m][k] = *(const LAS bf16x8*)(lds + PG8_SA(b, h) + aoff + m * 2048 + k * 1024); } } } while (0)
#define PG8_LDB(dst, b, h) do { _Pragma("unroll") for (int n = 0; n < 2; ++n) { \
        if constexpr (FP8) { const i32x4 lo_ = *(const LAS i32x4*)(lds + PG8_SB(b, h) + boff + n * 2048), hi_ = *(const LAS i32x4*)(lds + PG8_SB(b, h) + boff + n * 2048 + 1024); \
            dst##8[n] = (i32x8){lo_.x, lo_.y, lo_.z, lo_.w, hi_.x, hi_.y, hi_.z, hi_.w}; } \
        else { _Pragma("unroll") for (int k = 0; k < 2; ++k) dst[n][k] = *(const LAS bf16x8*)(lds + PG8_SB(b, h) + boff + n * 2048 + k * 1024); } } } while (0)
#define PG8_MMA(ai, bj, At, Bt) do { __builtin_amdgcn_s_setprio(1); _Pragma("unroll") for (int m = 0; m < 4; ++m) _Pragma("unroll") for (int n = 0; n < 2; ++n) { \
        if constexpr (FP8) asm volatile("s_nop 1\n\tv_mfma_scale_f32_16x16x128_f8f6f4 %0, %1, %2, %0, %3, %4 op_sel_hi:[0,0,0]" : "+v"(acc[ai][bj][m][n]) : "v"(Bt##8[n]), "v"(At##8[m]), "v"(sclW), "v"(sclA)); \
        else { _Pragma("unroll") for (int k = 0; k < 2; ++k) acc[ai][bj][m][n] = __builtin_amdgcn_mfma_f32_16x16x32_bf16(Bt[n][k], At[m][k], acc[ai][bj][m][n], 0, 0, 0); } } \
        __builtin_amdgcn_s_setprio(0); } while (0)
#define PG8_WAIT_V(n) asm volatile("s_waitcnt vmcnt(" #n ")" ::: "memory")
#define PG8_WAIT_L(n) asm volatile("s_waitcnt lgkmcnt(" #n ")" ::: "memory")
#define PG8_BAR __builtin_amdgcn_s_barrier()
#define PG8_SCHED __builtin_amdgcn_sched_barrier(0)
    Unit cur, nxt; int ui = 0;
    if (!P.next(0, cur)) return;
    f32x4 acc[2][2][4][2];
#pragma unroll
    for (int a = 0; a < 2; ++a)
#pragma unroll
        for (int b = 0; b < 2; ++b)
#pragma unroll
            for (int m = 0; m < 4; ++m)
#pragma unroll
                for (int n = 0; n < 2; ++n) acc[a][b][m][n] = (f32x4){0.f, 0.f, 0.f, 0.f};
    bf16x8 At[4][2], B0[2][2], B1[2][2]; i32x8 At8[4], B08[2], B18[2]; const int sclW = W8_SCALE_BYTE, sclA = 0x7f7f7f7f;
    const char* cA = P.a_ptr(cur); const char* cB = P.b_ptr(cur);
    if constexpr (GATHER) {
        if (wid < 4) __builtin_amdgcn_global_load_lds((const unsigned*)(P.idx_ptr(cur) + wid * 64 + lane), (LAS unsigned*)(idxtab + wid * 256), 4, 0, 0);
        PG8_WAIT_V(0); PG8_BAR;
#pragma unroll
        for (int i = 0; i < 2; ++i)
#pragma unroll
            for (int h = 0; h < 2; ++h) oc[h][i] = ((const LAS unsigned*)idxtab)[h * HALF + rA[i]] * lda2 + cA2;
        PG8_WAIT_L(0); PG8_BAR;
    }
    PG8_STAGE_B(PG8_SB(0, 0), cB); PG8_STAGE_B(PG8_SB(0, 1), cB + hstepB); PG8_STAGE_A(PG8_SA(0, 0), cA, oc, 0); PG8_STAGE_A(PG8_SA(0, 1), cA, oc, 1);
    if (wr == 1) PG8_BAR;
    PG8_WAIT_V(2); PG8_BAR;
    PG8_STAGE_B(PG8_SB(1, 0), cB + kstep); PG8_STAGE_A(PG8_SA(1, 0), cA + kstep, oc, 0); PG8_STAGE_B(PG8_SB(1, 1), cB + hstepB + kstep);
    PG8_WAIT_V(6); PG8_BAR;
    for (;;) {
        const bool has_next = P.next(ui + 1, nxt);
        const char* nA = has_next ? P.a_ptr(nxt) : cA; const char* nB = has_next ? P.b_ptr(nxt) : cB;
        if constexpr (GATHER) { if (has_next && wid < 4) __builtin_amdgcn_global_load_lds((const unsigned*)(P.idx_ptr(nxt) + wid * 64 + lane), (LAS unsigned*)(idxtab + wid * 256), 4, 0, 0); }
        for (int t = 0; t < nt; t += 2) {
            const bool last = (t == nt - 2);
            const char* a1 = cA + (size_t)(t + 1) * kstep;
            const char* a2 = last ? nA : cA + (size_t)(t + 2) * kstep; const char* b2 = last ? nB : cB + (size_t)(t + 2) * kstep;
            const char* a3 = a2 + kstep; const char* b3 = b2 + kstep;
            unsigned os[2][2];
            if constexpr (GATHER) {
                if (last && has_next) {
#pragma unroll
                    for (int i = 0; i < 2; ++i)
#pragma unroll
                        for (int h = 0; h < 2; ++h) on[h][i] = ((const LAS unsigned*)idxtab)[h * HALF + rA[i]] * lda2 + cA2;
                }
#pragma unroll
                for (int i = 0; i < 2; ++i)
#pragma unroll
                    for (int h = 0; h < 2; ++h) os[h][i] = last ? on[h][i] : oc[h][i];
            } else {
#pragma unroll
                for (int i = 0; i < 2; ++i)
#pragma unroll
                    for (int h = 0; h < 2; ++h) os[h][i] = oc[h][i];
            }
            PG8_LDB(B0, 0, 0); PG8_LDB(B1, 0, 1); PG8_SCHED; PG8_LDA(At, 0, 0); PG8_STAGE_A(PG8_SA(1, 1), a1, oc, 1);
            PG8_WAIT_V(8); PG8_WAIT_L(0); PG8_BAR; PG8_MMA(0, 0, At, B0); PG8_MMA(0, 1, At, B1); PG8_BAR; PG8_SCHED;
            PG8_LDA(At, 0, 1); PG8_STAGE_B(PG8_SB(0, 0), b2); PG8_STAGE_B(PG8_SB(0, 1), b2 + hstepB); PG8_STAGE_A(PG8_SA(0, 0), a2, os, 0);
            PG8_WAIT_V(8); PG8_WAIT_L(0); PG8_BAR; PG8_MMA(1, 0, At, B0); PG8_MMA(1, 1, At, B1); PG8_BAR; PG8_SCHED;
            PG8_LDB(B0, 1, 0); PG8_LDB(B1, 1, 1); PG8_SCHED; PG8_LDA(At, 1, 0); PG8_STAGE_A(PG8_SA(0, 1), a2, os, 1);
            PG8_WAIT_V(8); PG8_WAIT_L(0); PG8_BAR; PG8_MMA(0, 0, At, B0); PG8_MMA(0, 1, At, B1); PG8_BAR; PG8_SCHED;
            PG8_LDA(At, 1, 1); PG8_STAGE_B(PG8_SB(1, 0), b3); PG8_STAGE_B(PG8_SB(1, 1), b3 + hstepB); PG8_STAGE_A(PG8_SA(1, 0), a3, os, 0);
            PG8_WAIT_V(8); PG8_WAIT_L(0); PG8_BAR; PG8_MMA(1, 0, At, B0); PG8_MMA(1, 1, At, B1); PG8_BAR; PG8_SCHED;
        }
        if constexpr (FP8) { asm volatile("s_nop 15\n\ts_nop 15\n\ts_nop 7" ::: "memory"); PG8_SCHED; }
        if (wr == 0) PG8_BAR;
        E(acc, cur, wr, wc, fr, fq);
        if (!has_next) break;
#pragma unroll
        for (int a = 0; a < 2; ++a)
#pragma unroll
            for (int b = 0; b < 2; ++b)
#pragma unroll
                for (int m = 0; m < 4; ++m)
#pragma unroll
                    for (int n = 0; n < 2; ++n) acc[a][b][m][n] = (f32x4){0.f, 0.f, 0.f, 0.f};
        cur = nxt; cA = nA; cB = nB; ++ui;
        if constexpr (GATHER) {
#pragma unroll
            for (int i = 0; i < 2; ++i)
#pragma unroll
                for (int h = 0; h < 2; ++h) oc[h][i] = on[h][i];
        }
        if (wr == 1) PG8_BAR;
    }
    PG8_WAIT_V(0);
    PG8_BAR;
#undef PG8_SA
#undef PG8_SB
#undef PG8_STAGE_A
#undef PG8_STAGE_B
#undef PG8_GLDS
#undef PG8_LDA
#undef PG8_LDB
#undef PG8_MMA
#undef PG8_WAIT_V
#undef PG8_WAIT_L
#undef PG8_BAR
#undef PG8_SCHED
}

struct EpiBf16 {
    static constexpr bool PERM = true;
    bf16_t* O; int ldc; const float* bias; int bias_stride; float scale;
    __device__ __forceinline__ void operator()(const f32x4 (&acc)[2][2][4][2], const Unit& u, int wr, int wc, int fr, int fq) const {
        const int row0 = u.orow + wr * 64 + fr, col0 = u.ocol + wc * 32 + 8 * fq;
        f32x4 bv[2][2];
#pragma unroll
        for (int bj = 0; bj < 2; ++bj)
#pragma unroll
            for (int n = 0; n < 2; ++n) bv[bj][n] = bias ? *(const f32x4*)(bias + (size_t)u.aux * bias_stride + col0 + bj * HALF + 4 * n) : (f32x4){0.f, 0.f, 0.f, 0.f};
#pragma unroll
        for (int ai = 0; ai < 2; ++ai)
#pragma unroll
            for (int m = 0; m < 4; ++m) { bf16_t* rowp = O + (size_t)(row0 + ai * HALF + m * 16) * ldc + col0;
#pragma unroll
                for (int bj = 0; bj < 2; ++bj) { f32x4 v0 = (acc[ai][bj][m][0] + bv[bj][0]) * scale, v1 = (acc[ai][bj][m][1] + bv[bj][1]) * scale;
                    u32x4 w; w.x = cvt_pk_bf16(v0[0], v0[1]); w.y = cvt_pk_bf16(v0[2], v0[3]); w.z = cvt_pk_bf16(v1[0], v1[1]); w.w = cvt_pk_bf16(v1[2], v1[3]);
                    *(u32x4*)(rowp + bj * HALF) = w; } }
    }
};
struct EpiResBf16 {
    static constexpr bool PERM = true;
    const bf16_t* res; bf16_t* out; int ldc; float alpha;
    __device__ __forceinline__ void operator()(const f32x4 (&acc)[2][2][4][2], const Unit& u, int wr, int wc, int fr, int fq) const {
        const int row0 = u.orow + wr * 64 + fr, col0 = u.ocol + wc * 32 + 8 * fq;
#pragma unroll
        for (int ai = 0; ai < 2; ++ai)
#pragma unroll
            for (int m = 0; m < 4; ++m) { const size_t off = (size_t)(row0 + ai * HALF + m * 16) * ldc + col0;
#pragma unroll
                for (int bj = 0; bj < 2; ++bj) { const u32x4 r = *(const u32x4*)(res + off + bj * HALF); const f32x4 a0 = acc[ai][bj][m][0], a1 = acc[ai][bj][m][1];
                    u32x4 w; w.x = cvt_pk_bf16(bf2f(r.x & 0xffffu) * alpha + a0[0], bf2f(r.x >> 16) * alpha + a0[1]); w.y = cvt_pk_bf16(bf2f(r.y & 0xffffu) * alpha + a0[2], bf2f(r.y >> 16) * alpha + a0[3]);
                    w.z = cvt_pk_bf16(bf2f(r.z & 0xffffu) * alpha + a1[0], bf2f(r.z >> 16) * alpha + a1[1]); w.w = cvt_pk_bf16(bf2f(r.w & 0xffffu) * alpha + a1[2], bf2f(r.w >> 16) * alpha + a1[3]);
                    *(u32x4*)(out + off + bj * HALF) = w; }
                if (m & 1) asm volatile("" ::: "memory"); }
    }
};
struct EpiRouter {
    static constexpr bool PERM = false;
    float* out; const float* bias;
    __device__ __forceinline__ void operator()(const f32x4 (&acc)[2][2][4][2], const Unit& u, int wr, int wc, int fr, int fq) const {
        if (wc != 0) return;
        const int row0 = u.orow + wr * 64 + fr;
#pragma unroll
        for (int ai = 0; ai < 2; ++ai)
#pragma unroll
            for (int m = 0; m < 4; ++m)
#pragma unroll
                for (int n = 0; n < 2; ++n) { const int c = 16 * n + 4 * fq; const f32x4 b = *(const f32x4*)(bias + c);
                    *(f32x4*)(out + (size_t)(row0 + ai * HALF + m * 16) * 32 + c) = acc[ai][0][m][n] + b; }
    }
};
struct EpiSwiglu {
    static constexpr bool PERM = true;
    unsigned char* O; const float* bias;
    __device__ __forceinline__ void operator()(const f32x4 (&acc)[2][2][4][2], const Unit& u, int wr, int wc, int fr, int fq) const {
        const int row0 = u.orow + wr * 64 + fr, col0 = u.ocol + wc * 32 + 8 * fq;
        const float* bg = bias + (size_t)u.aux * 4096 + col0; const float* bu = bg + 2048;
        const f32x4 g0 = *(const f32x4*)bg, g1 = *(const f32x4*)(bg + 4), u0 = *(const f32x4*)bu, u1 = *(const f32x4*)(bu + 4);
#pragma unroll
        for (int ai = 0; ai < 2; ++ai)
#pragma unroll
            for (int m = 0; m < 4; ++m) {
                f32x4 gl0 = acc[ai][0][m][0] + g0, gl1 = acc[ai][0][m][1] + g1, up0 = acc[ai][1][m][0] + u0, up1 = acc[ai][1][m][1] + u1;
                float r[8];
#pragma unroll
                for (int j = 0; j < 4; ++j) {
                    { const float g = fminf(gl0[j], 7.0f), uu = fminf(fmaxf(up0[j], -7.0f), 7.0f); const float sg = __builtin_amdgcn_rcpf(1.0f + __expf(-1.702f * g)); r[j] = (uu + 1.0f) * (g * sg); }
                    { const float g = fminf(gl1[j], 7.0f), uu = fminf(fmaxf(up1[j], -7.0f), 7.0f); const float sg = __builtin_amdgcn_rcpf(1.0f + __expf(-1.702f * g)); r[4 + j] = (uu + 1.0f) * (g * sg); }
                }
                int w0 = __builtin_amdgcn_cvt_pk_fp8_f32(r[0], r[1], 0, false); w0 = __builtin_amdgcn_cvt_pk_fp8_f32(r[2], r[3], w0, true);
                int w1 = __builtin_amdgcn_cvt_pk_fp8_f32(r[4], r[5], 0, false); w1 = __builtin_amdgcn_cvt_pk_fp8_f32(r[6], r[7], w1, true);
                *(u32x2*)(O + (size_t)(row0 + ai * HALF + m * 16) * 2048 + col0) = (u32x2){(unsigned)w0, (unsigned)w1}; }
    }
};

struct ProbStd {
    static constexpr bool GATHER = false, FP8 = false;
    const bf16_t* A; const bf16_t* Bt; int K, lda, ldb; StaticOrder S; int split_pm; size_t b_split_stride; int orow_extra;
    __device__ void init(const bf16_t* A_, const bf16_t* Bt_, int M, int N, int K_, int lda_, int ldb_, int G, int c) { A = A_; Bt = Bt_; K = K_; lda = lda_; ldb = ldb_; S.init(M / BM, N / BM, G, c); split_pm = 1 << 30; b_split_stride = 0; orow_extra = 0; }
    __device__ bool next(int i, Unit& u) const { if (!S.next(i, u.pm, u.pn)) return false; u.orow = u.pm * BM; u.ocol = u.pn * BM; u.aux = 0; return true; }
    __device__ const char* a_ptr(const Unit& u) const { return (const char*)(A + (size_t)u.pm * BM * lda); }
    __device__ const char* b_ptr(const Unit& u) const { return (const char*)(Bt + (size_t)u.pn * BM * ldb + (u.pm >= split_pm ? b_split_stride : 0)); }
    __device__ const int* idx_ptr(const Unit&) const { return nullptr; }
};
struct ProbFoldA {
    static constexpr bool GATHER = false, FP8 = false;
    const bf16_t* kv; const bf16_t* wq; int K, lda, ldb, G, c;
    __device__ bool next(int i, Unit& u) const { const int L = i * G + c; if (L >= 64) return false; const int bh = L >> 3; u.pm = bh; u.pn = L & 7; u.orow = (bh >> 2) * 1024 + (bh & 3) * 256; u.ocol = u.pn * 256; u.aux = 0; return true; }
    __device__ const char* a_ptr(const Unit& u) const { const int b = u.pm >> 2, h = u.pm & 3; return (const char*)(kv + (size_t)b * 256 * 4096 + h * 512); }
    __device__ const char* b_ptr(const Unit& u) const { const int h = u.pm & 3; return (const char*)(wq + (size_t)u.pn * 256 * 2048 + h * 512); }
    __device__ const int* idx_ptr(const Unit&) const { return nullptr; }
};
struct ProbFoldB {
    static constexpr bool GATHER = false, FP8 = false;
    const bf16_t* woT; const bf16_t* kv; int K, lda, ldb, G, c;
    __device__ bool next(int i, Unit& u) const { const int L = i * G + c; if (L >= 64) return false; const int bh = L >> 3; u.pm = L & 7; u.pn = bh; u.orow = (bh >> 2) * 2048 + u.pm * 256; u.ocol = (bh & 3) * 256; u.aux = 0; return true; }
    __device__ const char* a_ptr(const Unit& u) const { const int h = u.pn & 3; return (const char*)(woT + (size_t)u.pm * 256 * 2048 + h * 512); }
    __device__ const char* b_ptr(const Unit& u) const { const int b = u.pn >> 2, h = u.pn & 3; return (const char*)(kv + (size_t)b * 256 * 4096 + 2048 + h * 512); }
    __device__ const int* idx_ptr(const Unit&) const { return nullptr; }
};
template <bool G1> struct ProbMoe {
    static constexpr bool GATHER = G1, FP8 = true;
    const unsigned char* A; const unsigned char* W; const int* slot_tok; const LAS int* blkexp; int K, lda, ldb; StaticOrder S;
    __device__ bool next(int i, Unit& u) const { if (!S.next(i, u.pm, u.pn)) return false; u.orow = u.pm * BM; u.ocol = u.pn * (G1 ? 128 : 256); u.aux = __builtin_amdgcn_readfirstlane(blkexp[u.pm]); return true; }
    __device__ const char* a_ptr(const Unit& u) const { return G1 ? (const char*)A : (const char*)(A + (size_t)u.pm * BM * lda); }
    __device__ const char* b_ptr(const Unit& u) const { return (const char*)(W + ((size_t)u.aux * (G1 ? 4096 : 2048) + (size_t)u.pn * BM) * 2048); }
    __device__ const int* idx_ptr(const Unit& u) const { return slot_tok + u.pm * BM; }
};
}

#define XB_TMO      128
#define XB_XCNT(j)  (256  + 64 * (j))
#define XB_XSUB(j)  (1280 + 64 * (j))
#define XB_XGEN(j)  (2304 + 64 * (j))
#define XB_TOP      3328
#define XB_TOPGEN   3392
#define XCD_BAR_WORDS 3456
#define XB_SPIN_CAP (1u << 18)
__device__ __forceinline__ unsigned xb_ld(unsigned* p)              { return __hip_atomic_load(p, __ATOMIC_RELAXED, __HIP_MEMORY_SCOPE_AGENT); }
__device__ __forceinline__ unsigned xb_add(unsigned* p, unsigned v) { return __hip_atomic_fetch_add(p, v, __ATOMIC_RELAXED, __HIP_MEMORY_SCOPE_AGENT); }
__device__ __forceinline__ unsigned xb_xcc_id() { return (unsigned)__builtin_amdgcn_s_getreg((3 << 11) | 20) & 0xFu; }
#define XB_SPIN(cond, bar) do { unsigned _sp = 0; while (cond) { __builtin_amdgcn_s_sleep(1); \
    if ((++_sp & 255u) == 0u) { if (xb_ld(&(bar)[XB_TMO])) break; if (_sp > XB_SPIN_CAP) { atomicAdd(&(bar)[XB_TMO], 1u); break; } } } } while (0)
struct XcdBarrier { unsigned* bar; unsigned x; volatile LAS unsigned* st; };
__device__ __forceinline__ XcdBarrier xcd_barrier_post(unsigned* bar, volatile LAS unsigned* st) {
    XcdBarrier b; b.bar = bar; b.x = xb_xcc_id(); b.st = st;
    if (threadIdx.x == 0) (void)xb_add(&bar[XB_XCNT(b.x)], 1u);
    return b;
}
__device__ __forceinline__ void xcd_barrier_complete(unsigned* bar, unsigned x, unsigned& nloc, unsigned& nx) {
    const unsigned G = gridDim.x * gridDim.y * gridDim.z;
    unsigned sum, cnt, mine, sp = 0u;
    for (;;) {
        sum = 0u; cnt = 0u; mine = 0u;
#pragma unroll
        for (unsigned j = 0; j < 16; ++j) { const unsigned c = xb_ld(&bar[XB_XCNT(j)]); sum += c; cnt += (c > 0u) ? 1u : 0u; mine = (j == x) ? c : mine; }
        if (sum == G) break;
        __builtin_amdgcn_s_sleep(1);
        if ((++sp & 255u) == 0u) { if (xb_ld(&bar[XB_TMO])) break; if (sp > XB_SPIN_CAP) { atomicAdd(&bar[XB_TMO], 1u); break; } }
    }
    nloc = mine > 0u ? mine : 1u; nx = cnt > 0u ? cnt : 1u;
}
__device__ __forceinline__ void xcd_barrier(const XcdBarrier& b) {
    asm volatile("s_waitcnt vmcnt(0)" ::: "memory");
    __syncthreads();
    if (threadIdx.x == 0) {
        unsigned* bar = b.bar;
        __builtin_amdgcn_s_waitcnt(0);
        unsigned nloc = b.st[0], nx = b.st[1];
        if (nloc == 0u) { xcd_barrier_complete(bar, b.x, nloc, nx); b.st[0] = nloc; b.st[1] = nx; }
        const unsigned old = xb_add(&bar[XB_XSUB(b.x)], 1u);
        const unsigned gen = old / nloc;
        if (old + 1u == (gen + 1u) * nloc) {
            __builtin_amdgcn_fence(__ATOMIC_RELEASE, "agent");
            asm volatile("s_waitcnt vmcnt(0)" ::: "memory");
            const unsigned og = xb_add(&bar[XB_TOP], 1u);
            const unsigned tg = og / nx;
            if (og + 1u == (tg + 1u) * nx) xb_add(&bar[XB_TOPGEN], 1u);
            else XB_SPIN(xb_ld(&bar[XB_TOPGEN]) == tg, bar);
            __builtin_amdgcn_fence(__ATOMIC_ACQUIRE, "agent");
            xb_add(&bar[XB_XGEN(b.x)], 1u);
            asm volatile("s_waitcnt vmcnt(0)" ::: "memory");
        } else {
            XB_SPIN(xb_ld(&bar[XB_XGEN(b.x)]) == gen, bar);
            __builtin_amdgcn_fence(__ATOMIC_ACQUIRE, "agent");
            asm volatile("s_waitcnt vmcnt(0)" ::: "memory");
        }
    }
    __syncthreads();
}

struct Args {
    const float* in[22]; float* out; unsigned char* ws; int ph_lo, ph_hi;
};
struct Frame {
    LAS unsigned char* lds; int tid, lane, wave, G, bid;
    unsigned char* ws;
};
#define LDS_WAIT() asm volatile("s_waitcnt lgkmcnt(0)" ::: "memory")
#define VM_WAIT() asm volatile("s_waitcnt vmcnt(0)" ::: "memory")

__device__ __forceinline__ void p0_transpose_item(const float* W, int Kdim, int N, bf16_t* WT, int dst_row0, int k0, int n0, LAS float* scr, int lane) {
#pragma unroll 8
    for (int i = 0; i < 32; ++i) { const int kk = 2 * i + (lane >> 5); scr[kk * 33 + (lane & 31)] = W[(size_t)(k0 + kk) * N + n0 + (lane & 31)]; }
    LDS_WAIT(); asm volatile("" ::: "memory");
    const int c = lane & 7;
#pragma unroll
    for (int j = 0; j < 4; ++j) { const int n = (lane >> 3) + 8 * j; const LAS float* s = scr + (8 * c) * 33 + n;
        u32x4 o; o.x = pk2(s[0 * 33], s[1 * 33]); o.y = pk2(s[2 * 33], s[3 * 33]); o.z = pk2(s[4 * 33], s[5 * 33]); o.w = pk2(s[6 * 33], s[7 * 33]);
        *(u32x4*)(WT + (size_t)(dst_row0 + n) * Kdim + k0 + 8 * c) = o; }
    LDS_WAIT(); asm volatile("" ::: "memory");
}
__device__ __forceinline__ void p0_transpose_item8(const float* W, int Kdim, int N, unsigned char* WT, int dst_row0, int k0, int n0, LAS float* scr, int lane) {
#pragma unroll 16
    for (int i = 0; i < 64; ++i) { const int kk = 2 * i + (lane >> 5); scr[kk * 33 + (lane & 31)] = W[(size_t)(k0 + kk) * N + n0 + (lane & 31)]; }
    LDS_WAIT(); asm volatile("" ::: "memory");
#pragma unroll
    for (int j = 0; j < 4; ++j) { const int id = lane + 64 * j, n = id >> 3, c = id & 7; const LAS float* s = scr + (16 * c) * 33 + n;
        int w[4];
#pragma unroll
        for (int q = 0; q < 4; ++q) { int t = __builtin_amdgcn_cvt_pk_fp8_f32(s[(4 * q) * 33] * W8_MUL, s[(4 * q + 1) * 33] * W8_MUL, 0, false); w[q] = __builtin_amdgcn_cvt_pk_fp8_f32(s[(4 * q + 2) * 33] * W8_MUL, s[(4 * q + 3) * 33] * W8_MUL, t, true); }
        *(u32x4*)(WT + (size_t)(dst_row0 + n) * Kdim + k0 + 16 * c) = (u32x4){(unsigned)w[0], (unsigned)w[1], (unsigned)w[2], (unsigned)w[3]}; }
    LDS_WAIT(); asm volatile("" ::: "memory");
}
__device__ __forceinline__ void p0_convert(const float* src, bf16_t* dst, size_t n8, size_t i0, size_t stride) {
    for (size_t i = i0; i < n8; i += stride) { const f32x4 a = ((const f32x4*)src)[2 * i], b = ((const f32x4*)src)[2 * i + 1];
        u32x4 o; o.x = pk2(a[0], a[1]); o.y = pk2(a[2], a[3]); o.z = pk2(b[0], b[1]); o.w = pk2(b[2], b[3]); ((u32x4*)dst)[i] = o; }
}
__device__ __forceinline__ void phase_prep(const Frame& F, const Args& a) {
    LAS float* scr = (LAS float*)(F.lds + F.wave * 17408);
    const int gw = F.bid * NWAVES + F.wave, NGW = F.G * NWAVES;
    const float *w_in = a.in[2], *w_mix = a.in[6], *w_q = a.in[9], *w_kv = a.in[10], *w_o = a.in[11], *w_r = a.in[14], *w_gu = a.in[16], *w_d = a.in[18];
    bf16_t *WIN = (bf16_t*)(F.ws + WS_WIN), *WMIX = (bf16_t*)(F.ws + WS_WMIX), *WQN = (bf16_t*)(F.ws + WS_WQN), *WKV = (bf16_t*)(F.ws + WS_WKV), *WO = (bf16_t*)(F.ws + WS_WO),
           *WR = (bf16_t*)(F.ws + WS_WR); unsigned char *WGU = F.ws + WS_WGU, *WD = F.ws + WS_WD;
    constexpr int I_IN = 32 * (DIN / 32), I_MIX = 32 * 64, I_KV = 32 * 128, I_O = 32 * 64, I_R = 32, I_GU = 16 * 128, I_D = 16 * 64;
    constexpr int NITEMS = I_IN + I_MIX + I_KV + I_O + I_R + NEXP * I_GU + NEXP * I_D;
    for (int it = gw; it < NITEMS; it += NGW) {
        int r = it;
        if (r < I_IN) { const int nblk = DIN / 32, kb = r / nblk, nb = r % nblk; p0_transpose_item(w_in, 2048, DIN, WIN, nb * 32, kb * 64, nb * 32, scr, F.lane); continue; } r -= I_IN;
        if (r < I_MIX) { const int kb = r / 64, nb = r % 64; p0_transpose_item(w_mix, 2048, 2048, WMIX, nb * 32, kb * 64, nb * 32, scr, F.lane); continue; } r -= I_MIX;
        if (r < I_KV) { const int kb = r / 128, nb = r % 128; p0_transpose_item(w_kv, 2048, 4096, WKV, nb * 32, kb * 64, nb * 32, scr, F.lane); continue; } r -= I_KV;
        if (r < I_O) { const int kb = r / 64, nb = r % 64; p0_transpose_item(w_o, 2048, 2048, WO, nb * 32, kb * 64, nb * 32, scr, F.lane); continue; } r -= I_O;
        if (r < I_R) { p0_transpose_item(w_r, 2048, 32, WR, 0, r * 64, 0, scr, F.lane); continue; } r -= I_R;
        if (r < NEXP * I_GU) { const int e = r / I_GU, q = r % I_GU, kb = q / 128, nb = q % 128, n0 = nb * 32;
            const int dst = (n0 < 2048) ? ((n0 >> 7) * 256 + (n0 & 127)) : (((n0 - 2048) >> 7) * 256 + 128 + ((n0 - 2048) & 127));
            p0_transpose_item8(w_gu + (size_t)e * 2048 * 4096, 2048, 4096, WGU + (size_t)e * 4096 * 2048, dst, kb * 128, n0, scr, F.lane); continue; } r -= NEXP * I_GU;
        { const int e = r / I_D, q = r % I_D, kb = q / 64, nb = q % 64; p0_transpose_item8(w_d + (size_t)e * 2048 * 2048, 2048, 2048, WD + (size_t)e * 2048 * 2048, nb * 32, kb * 128, nb * 32, scr, F.lane); }
    }
    const size_t gt = (size_t)F.bid * NTHR + F.tid, NGT = (size_t)F.G * NTHR;
    p0_convert(w_q, WQN, (size_t)2048 * 2048 / 8, gt, NGT);
    p0_convert(a.in[0], (bf16_t*)(F.ws + WS_XB), (size_t)T * D / 8, gt, NGT);
    p0_convert(a.in[1], (bf16_t*)(F.ws + WS_MEMB), (size_t)512 * 2048 / 8, gt, NGT);
    for (size_t i = gt; i < (size_t)224 * 2048 / 8; i += NGT) ((u32x4*)(WR + 32 * 2048))[i] = (u32x4){0u, 0u, 0u, 0u};
}

constexpr int SWA_KRS = 144;
constexpr int SWA_PRS = 336;
constexpr int SWA_K_OFF = 0, SWA_V_OFF = 256 * SWA_KRS, SWA_P_OFF = 2 * 256 * SWA_KRS, SWA_SSQ_OFF = SWA_P_OFF + 8 * 16 * SWA_PRS;
static_assert(SWA_SSQ_OFF + 512 <= RING_BYTES, "swa lds");
__device__ __forceinline__ void swa_item(const Frame& F, const bf16_t* proj, bf16_t* y, const float* sinks, const float* normw, int b, int n) {
    LAS unsigned char* Kl = F.lds + SWA_K_OFF; LAS unsigned char* Vl = F.lds + SWA_V_OFF; LAS unsigned char* Pl = F.lds + SWA_P_OFF + F.wave * 16 * SWA_PRS;
    LAS float* ssq = (LAS float*)(F.lds + SWA_SSQ_OFF);
    const int lane = F.lane, fr = lane & 15, g = lane >> 4, q4 = (lane & 15) >> 2, p4 = lane & 3;
    const size_t tok0 = (size_t)b * SEQ + (size_t)n * 128;
    if (F.tid < 128) ssq[F.tid] = 0.f;
    for (int h = 0; h < 2; ++h) {
        __syncthreads();
#pragma unroll
        for (int i = 0; i < 4; ++i) { const int id = F.tid + 512 * i, key = id >> 3, c = id & 7;
            u32x4 kv = (u32x4){0u, 0u, 0u, 0u}, vv = kv;
            if (n > 0 || key >= 128) { const bf16_t* src = proj + (tok0 - 128 + key) * DIN + h * 64 + c * 8; kv = *(const u32x4*)(src + OFF_KA); vv = *(const u32x4*)(src + OFF_VA); }
            *(LAS u32x4*)(Kl + key * SWA_KRS + c * 16) = kv; *(LAS u32x4*)(Vl + key * SWA_KRS + c * 16) = vv; }
        __syncthreads();
        const int hq = h * 8 + F.wave;
        const float slope = exp2f(-0.5f * (float)(hq + 1)), sink = sinks[hq];
        for (int rt = 0; rt < 8; ++rt) {
            const int i0 = rt * 16, kt0 = rt < 6 ? rt : 6;
            bf16x8 qf[2];
#pragma unroll
            for (int ks = 0; ks < 2; ++ks) qf[ks] = *(const bf16x8*)(proj + (tok0 + i0 + fr) * DIN + OFF_QA + hq * 64 + ks * 32 + 8 * g);
            f32x4 s[10];
#pragma unroll
            for (int tt = 0; tt < 10; ++tt) { f32x4 acc = (f32x4){0.f, 0.f, 0.f, 0.f};
#pragma unroll
                for (int ks = 0; ks < 2; ++ks) { const bf16x8 kf = *(const LAS bf16x8*)(Kl + ((kt0 + tt) * 16 + fr) * SWA_KRS + (ks * 32 + 8 * g) * 2); acc = mfma16(qf[ks], kf, acc); }
                s[tt] = acc; }
            float mx[4] = {-1e30f, -1e30f, -1e30f, -1e30f};
#pragma unroll
            for (int tt = 0; tt < 10; ++tt)
#pragma unroll
                for (int r = 0; r < 4; ++r) { const int i = i0 + 4 * g + r, j = (kt0 + tt) * 16 + fr, dist = i + 128 - j;
                    const bool valid = dist >= 0 && dist < 128 && (n > 0 || j >= 128);
                    const float v = valid ? s[tt][r] * 0.125f - slope * (float)dist : -1e30f; s[tt][r] = v; mx[r] = fmaxf(mx[r], v); }
            float l[4];
#pragma unroll
            for (int r = 0; r < 4; ++r) { mx[r] = fmaxf(grp16_max(mx[r]), sink); l[r] = 0.f; }
#pragma unroll
            for (int tt = 0; tt < 10; ++tt)
#pragma unroll
                for (int r = 0; r < 4; ++r) { const float p = __expf(s[tt][r] - mx[r]); l[r] += p; *(LAS bf16_t*)(Pl + (4 * g + r) * SWA_PRS + (tt * 16 + fr) * 2) = (bf16_t)f2bf(p); }
#pragma unroll
            for (int r = 0; r < 4; ++r) l[r] = grp16_sum(l[r]) + __expf(sink - mx[r]);
            f32x4 o[4];
#pragma unroll
            for (int dt = 0; dt < 4; ++dt) o[dt] = (f32x4){0.f, 0.f, 0.f, 0.f};
#pragma unroll
            for (int kk = 0; kk < 5; ++kk) { const bf16x8 pf = *(const LAS bf16x8*)(Pl + fr * SWA_PRS + (kk * 32 + 8 * g) * 2);
#pragma unroll
                for (int dt = 0; dt < 4; ++dt) { const bf16x8 vf = tr_frag(Vl + (kt0 * 16 + kk * 32 + 8 * g + q4) * SWA_KRS + (dt * 16 + 4 * p4) * 2, 4 * SWA_KRS); o[dt] = mfma16(pf, vf, o[dt]); } }
            float sq[4] = {0.f, 0.f, 0.f, 0.f};
#pragma unroll
            for (int r = 0; r < 4; ++r) { const float il = 1.0f / l[r];
#pragma unroll
                for (int dt = 0; dt < 4; ++dt) { const float v = o[dt][r] * il; sq[r] += v * v; y[(tok0 + i0 + 4 * g + r) * 2048 + hq * 64 + dt * 16 + fr] = (bf16_t)f2bf(v); } }
#pragma unroll
            for (int r = 0; r < 4; ++r) { const float t = grp16_sum(sq[r]); if (fr == 0) atomicAdd((float*)&ssq[i0 + 4 * g + r], t); }
        }
    }
    VM_WAIT(); __syncthreads();
    for (int id = F.tid; id < 128 * 128; id += NTHR) { const int tk = id >> 7, c = id & 127; const float rs = 1.0f / sqrtf(ssq[tk] * (1.0f / 1024.0f) + LN_EPS);
        bf16_t* p = y + (tok0 + tk) * 2048 + c * 8; const u32x4 v = *(const u32x4*)p; const f32x4 w0 = *(const f32x4*)(normw + c * 8), w1 = *(const f32x4*)(normw + c * 8 + 4);
        u32x4 o; o.x = pk2(bf2f(v.x & 0xffffu) * rs * w0[0], bf2f(v.x >> 16) * rs * w0[1]); o.y = pk2(bf2f(v.y & 0xffffu) * rs * w0[2], bf2f(v.y >> 16) * rs * w0[3]);
        o.z = pk2(bf2f(v.z & 0xffffu) * rs * w1[0], bf2f(v.z >> 16) * rs * w1[1]); o.w = pk2(bf2f(v.w & 0xffffu) * rs * w1[2], bf2f(v.w >> 16) * rs * w1[3]);
        *(u32x4*)p = o; }
    __syncthreads();
}

constexpr int RET_RS = 272;
constexpr int RET_TILE = 128 * RET_RS;
__device__ __forceinline__ float ret_log2g(int h) { return log2f(1.0f - exp2f(-5.0f - (float)h)); }
__device__ __forceinline__ void ret_u_item(const Frame& F, const bf16_t* proj, float* Ut, int b, int c, int h) {
    LAS unsigned char* Kl = F.lds; LAS unsigned char* Vl = F.lds + RET_TILE;
    const int lane = F.lane, fr = lane & 15, g = lane >> 4, q4 = (lane & 15) >> 2, p4 = lane & 3, w = F.wave;
    const size_t tok0 = (size_t)b * SEQ + (size_t)c * 128; const float l2g = ret_log2g(h);
    __syncthreads();
#pragma unroll
    for (int i = 0; i < 4; ++i) { const int id = F.tid + 512 * i, key = id >> 4, ch = id & 15;
        const bf16_t* src = proj + (tok0 + key) * DIN + h * 128 + ch * 8; const u32x4 kv = *(const u32x4*)(src + OFF_KR), vv = *(const u32x4*)(src + OFF_VR);
        const float wk = exp2f(l2g * (float)(127 - key)) * 0.08838834764831845f;
        u32x4 ks; ks.x = pk2(bf2f(kv.x & 0xffffu) * wk, bf2f(kv.x >> 16) * wk); ks.y = pk2(bf2f(kv.y & 0xffffu) * wk, bf2f(kv.y >> 16) * wk);
        ks.z = pk2(bf2f(kv.z & 0xffffu) * wk, bf2f(kv.z >> 16) * wk); ks.w = pk2(bf2f(kv.w & 0xffffu) * wk, bf2f(kv.w >> 16) * wk);
        *(LAS u32x4*)(Kl + key * RET_RS + ch * 16) = ks; *(LAS u32x4*)(Vl + key * RET_RS + ch * 16) = vv; }
    __syncthreads();
    f32x4 acc[8];
#pragma unroll
    for (int et = 0; et < 8; ++et) acc[et] = (f32x4){0.f, 0.f, 0.f, 0.f};
#pragma unroll
    for (int kk = 0; kk < 4; ++kk) { const bf16x8 af = tr_frag(Kl + (kk * 32 + 8 * g + q4) * RET_RS + (w * 16 + 4 * p4) * 2, 4 * RET_RS);
#pragma unroll
        for (int et = 0; et < 8; ++et) { const bf16x8 bf = tr_frag(Vl + (kk * 32 + 8 * g + q4) * RET_RS + (et * 16 + 4 * p4) * 2, 4 * RET_RS); acc[et] = mfma16(af, bf, acc[et]); } }
    float* dst = Ut + (((size_t)b * NCH + c) * 8 + h) * 16384;
#pragma unroll
    for (int et = 0; et < 8; ++et) *(f32x4*)(dst + (et * 16 + fr) * 128 + w * 16 + 4 * g) = acc[et];
}
__device__ __forceinline__ void phase_scan(const Frame& F, const float* Ut, bf16_t* Rt) {
    const int gt = F.bid * NTHR + F.tid;
    for (int e2 = gt; e2 < 2 * 8 * 8192; e2 += F.G * NTHR) {
        const int b = e2 >> 16, h = (e2 >> 13) & 7, ed = (e2 & 8191) * 2;
        const float gC = exp2f(ret_log2g(h) * 128.0f);
        const float* up = Ut + ((size_t)b * NCH * 8 + h) * 16384 + ed; bf16_t* rp = Rt + ((size_t)b * NCH * 8 + h) * 16384 + ed;
        f32x2 st = (f32x2){0.f, 0.f};
        for (int c0 = 0; c0 < NCH; c0 += 8) {
            f32x2 u[8];
#pragma unroll
            for (int j = 0; j < 8; ++j) u[j] = *(const f32x2*)(up + (size_t)(c0 + j) * 8 * 16384);
#pragma unroll
            for (int j = 0; j < 8; ++j) { *(unsigned*)(rp + (size_t)(c0 + j) * 8 * 16384) = pk2(st.x, st.y); st = st * gC + u[j]; }
        }
    }
}
__device__ __forceinline__ void ret_o_item(const Frame& F, const bf16_t* proj, const bf16_t* Rt, bf16_t* y, const float* normw, int b, int c, int h) {
    LAS unsigned char* Kl = F.lds; LAS unsigned char* Vl = F.lds + RET_TILE; LAS unsigned char* Rl = F.lds + 2 * RET_TILE; LAS unsigned char* Sl = F.lds + 3 * RET_TILE + F.wave * 16 * RET_RS;
    const int lane = F.lane, fr = lane & 15, g = lane >> 4, q4 = (lane & 15) >> 2, p4 = lane & 3, w = F.wave;
    const size_t tok0 = (size_t)b * SEQ + (size_t)c * 128; const float l2g = ret_log2g(h);
    const bf16_t* rsrc = Rt + (((size_t)b * NCH + c) * 8 + h) * 16384;
    __syncthreads();
#pragma unroll
    for (int i = 0; i < 4; ++i) { const int id = F.tid + 512 * i, key = id >> 4, ch = id & 15;
        const bf16_t* src = proj + (tok0 + key) * DIN + h * 128 + ch * 8;
        *(LAS u32x4*)(Kl + key * RET_RS + ch * 16) = *(const u32x4*)(src + OFF_KR); *(LAS u32x4*)(Vl + key * RET_RS + ch * 16) = *(const u32x4*)(src + OFF_VR);
        *(LAS u32x4*)(Rl + key * RET_RS + ch * 16) = *(const u32x4*)(rsrc + key * 128 + ch * 8); }
    bf16x8 qf[4];
#pragma unroll
    for (int kk = 0; kk < 4; ++kk) qf[kk] = *(const bf16x8*)(proj + (tok0 + w * 16 + fr) * DIN + OFF_QR + h * 128 + kk * 32 + 8 * g);
    __syncthreads();
#pragma unroll
    for (int kt = 0; kt < 8; ++kt) {
        f32x4 acc = (f32x4){0.f, 0.f, 0.f, 0.f};
        if (kt <= w) {
#pragma unroll
            for (int kk = 0; kk < 4; ++kk) { const bf16x8 kf = *(const LAS bf16x8*)(Kl + (kt * 16 + fr) * RET_RS + (kk * 32 + 8 * g) * 2); acc = mfma16(qf[kk], kf, acc); }
        }
#pragma unroll
        for (int r = 0; r < 4; ++r) { const int qi = w * 16 + 4 * g + r, kj = kt * 16 + fr, df = qi - kj;
            const float v = df >= 0 ? acc[r] * 0.08838834764831845f * exp2f(l2g * (float)df) : 0.f;
            *(LAS bf16_t*)(Sl + (4 * g + r) * RET_RS + kj * 2) = (bf16_t)f2bf(v); }
    }
    f32x4 oi[8], oc[8];
#pragma unroll
    for (int et = 0; et < 8; ++et) { oi[et] = (f32x4){0.f, 0.f, 0.f, 0.f}; oc[et] = (f32x4){0.f, 0.f, 0.f, 0.f}; }
#pragma unroll
    for (int kk = 0; kk < 4; ++kk) {
        if (2 * kk <= w) { const bf16x8 sf = *(const LAS bf16x8*)(Sl + fr * RET_RS + (kk * 32 + 8 * g) * 2);
#pragma unroll
            for (int et = 0; et < 8; ++et) { const bf16x8 vf = tr_frag(Vl + (kk * 32 + 8 * g + q4) * RET_RS + (et * 16 + 4 * p4) * 2, 4 * RET_RS); oi[et] = mfma16(sf, vf, oi[et]); } }
#pragma unroll
        for (int et = 0; et < 8; ++et) { const bf16x8 rf = *(const LAS bf16x8*)(Rl + (et * 16 + fr) * RET_RS + (kk * 32 + 8 * g) * 2); oc[et] = mfma16(qf[kk], rf, oc[et]); }
    }
#pragma unroll
    for (int r = 0; r < 4; ++r) { const int qi = w * 16 + 4 * g + r; const float wq = exp2f(l2g * (float)(qi + 1));
        float v[8], s = 0.f;
#pragma unroll
        for (int et = 0; et < 8; ++et) { v[et] = oi[et][r] + wq * oc[et][r]; s += v[et]; }
        const float mu = grp16_sum(s) * (1.0f / 128.0f); float qv = 0.f;
#pragma unroll
        for (int et = 0; et < 8; ++et) { v[et] -= mu; qv += v[et] * v[et]; }
        const float rstd = 1.0f / sqrtf(grp16_sum(qv) * (1.0f / 128.0f) + LN_EPS);
        const bf16_t* gp = proj + (tok0 + qi) * DIN + OFF_GR + h * 128; bf16_t* yp = y + (tok0 + qi) * 2048 + 1024 + h * 128;
#pragma unroll
        for (int et = 0; et < 8; ++et) { const int e = et * 16 + fr; const float gt = bf2f(gp[e]); const float sw = gt * __builtin_amdgcn_rcpf(1.0f + __expf(-gt));
            yp[e] = (bf16_t)f2bf(v[et] * rstd * normw[h * 128 + e] * sw); }
    }
}

__device__ __forceinline__ void phase_ln(const Frame& F, const bf16_t* z, const float* w, const float* bb, bf16_t* xb, unsigned char* xq) {
    const int gw = F.bid * NWAVES + F.wave, NGW = F.G * NWAVES;
    for (int m = gw; m < T; m += NGW) {
        const u32x4* zr = (const u32x4*)(z + (size_t)m * D) + F.lane; float v[4][8]; float s = 0.f;
#pragma unroll
        for (int j = 0; j < 4; ++j) { const u32x4 p = zr[64 * j]; v[j][0] = bf2f(p.x & 0xffffu); v[j][1] = bf2f(p.x >> 16); v[j][2] = bf2f(p.y & 0xffffu); v[j][3] = bf2f(p.y >> 16);
            v[j][4] = bf2f(p.z & 0xffffu); v[j][5] = bf2f(p.z >> 16); v[j][6] = bf2f(p.w & 0xffffu); v[j][7] = bf2f(p.w >> 16);
#pragma unroll
            for (int i = 0; i < 8; ++i) s += v[j][i]; }
        const float mean = wave_sum(s) * (1.0f / D); float q = 0.f;
#pragma unroll
        for (int j = 0; j < 4; ++j)
#pragma unroll
            for (int i = 0; i < 8; ++i) { v[j][i] -= mean; q += v[j][i] * v[j][i]; }
        const float rstd = 1.0f / sqrtf(wave_sum(q) * (1.0f / D) + LN_EPS);
#pragma unroll
        for (int j = 0; j < 4; ++j) { const int c0 = 8 * (F.lane + 64 * j); const f32x4 w0 = *(const f32x4*)(w + c0), w1 = *(const f32x4*)(w + c0 + 4), b0 = *(const f32x4*)(bb + c0), b1 = *(const f32x4*)(bb + c0 + 4);
            float o[8];
#pragma unroll
            for (int i = 0; i < 4; ++i) { o[i] = v[j][i] * rstd * w0[i] + b0[i]; o[4 + i] = v[j][4 + i] * rstd * w1[i] + b1[i]; }
            u32x4 p; p.x = pk2(o[0], o[1]); p.y = pk2(o[2], o[3]); p.z = pk2(o[4], o[5]); p.w = pk2(o[6], o[7]); ((u32x4*)(xb + (size_t)m * D))[F.lane + 64 * j] = p;
            if (xq) { int t0 = __builtin_amdgcn_cvt_pk_fp8_f32(o[0], o[1], 0, false); t0 = __builtin_amdgcn_cvt_pk_fp8_f32(o[2], o[3], t0, true);
                int t1 = __builtin_amdgcn_cvt_pk_fp8_f32(o[4], o[5], 0, false); t1 = __builtin_amdgcn_cvt_pk_fp8_f32(o[6], o[7], t1, true); ((u32x2*)(xq + (size_t)m * D))[F.lane + 64 * j] = (u32x2){(unsigned)t0, (unsigned)t1}; } }
    }
}
__device__ __forceinline__ void phase_softmax(const Frame& F, bf16_t* sp) {
    const int gw = F.bid * NWAVES + F.wave, NGW = F.G * NWAVES;
    for (int m = gw; m < T; m += NGW) {
#pragma unroll
        for (int h = 0; h < 4; ++h) { u32x2* p = (u32x2*)(sp + (size_t)m * 1024 + h * 256) + F.lane; const u32x2 v = *p;
            float a0 = bf2f(v.x & 0xffffu), a1 = bf2f(v.x >> 16), a2 = bf2f(v.y & 0xffffu), a3 = bf2f(v.y >> 16);
            const float mx = wave_max(fmaxf(fmaxf(a0, a1), fmaxf(a2, a3)));
            a0 = __expf(a0 - mx); a1 = __expf(a1 - mx); a2 = __expf(a2 - mx); a3 = __expf(a3 - mx);
            const float il = 1.0f / wave_sum((a0 + a1) + (a2 + a3));
            u32x2 o; o.x = pk2(a0 * il, a1 * il); o.y = pk2(a2 * il, a3 * il); *p = o; }
    }
}
__device__ __forceinline__ void phase_route1(const Frame& F, const float* logits, int* tok_e, int* tok_p, float* gates, int* slot_tok, unsigned* gcnt) {
    LAS float* lg = (LAS float*)F.lds;
    LAS int* lcnt = (LAS int*)(F.lds + 128 * 33 * 4); LAS int* lbase = lcnt + 32;
    for (int i = F.bid * NTHR + F.tid; i < NSLOT; i += F.G * NTHR) slot_tok[i] = 0;
    for (int t0 = F.bid * 128; t0 < T; t0 += F.G * 128) {
        __syncthreads();
        for (int i = F.tid; i < 128 * 32; i += NTHR) lg[(i >> 5) * 33 + (i & 31)] = logits[(size_t)t0 * 32 + i];
        if (F.tid < 32) lcnt[F.tid] = 0;
        __syncthreads();
        int id[4] = {0, 0, 0, 0}, lp[4] = {0, 0, 0, 0}; float v[4] = {0.f, 0.f, 0.f, 0.f};
        if (F.tid < 128) {
            unsigned used = 0u;
#pragma unroll
            for (int k = 0; k < 4; ++k) { float best = -3.0e38f; int bi = 0;
                for (int e = 0; e < 32; ++e) { const float x = lg[F.tid * 33 + e]; if (!((used >> e) & 1u) && x > best) { best = x; bi = e; } }
                used |= 1u << bi; v[k] = best; id[k] = bi; }
            float ex[4], sum = 0.f;
#pragma unroll
            for (int k = 0; k < 4; ++k) { ex[k] = __expf(v[k] - v[0]); sum += ex[k]; }
#pragma unroll
            for (int k = 0; k < 4; ++k) { gates[(size_t)(t0 + F.tid) * 4 + k] = ex[k] / sum; lp[k] = atomicAdd((int*)&lcnt[id[k]], 1); }
        }
        __syncthreads();
        if (F.tid < 32) lbase[F.tid] = (int)__hip_atomic_fetch_add(gcnt + F.tid, (unsigned)lcnt[F.tid], __ATOMIC_RELAXED, __HIP_MEMORY_SCOPE_AGENT);
        __syncthreads();
        if (F.tid < 128) {
#pragma unroll
            for (int k = 0; k < 4; ++k) { tok_e[(size_t)(t0 + F.tid) * 4 + k] = id[k]; tok_p[(size_t)(t0 + F.tid) * 4 + k] = lbase[id[k]] + lp[k]; }
        }
    }
}
__device__ __forceinline__ void moe_tables(const Frame& F, unsigned* gcnt, LAS int* pstart, LAS int* blkexp) {
    __syncthreads();
    if (F.tid == 0) { int acc = 0; for (int e = 0; e < 32; ++e) { pstart[e] = acc; const int cnt = (int)__hip_atomic_load(gcnt + e, __ATOMIC_RELAXED, __HIP_MEMORY_SCOPE_AGENT); acc += ((cnt + 255) >> 8) << 8; } pstart[32] = acc; }
    __syncthreads();
    for (int j = F.tid; j < NBLK_MAX; j += NTHR) { int e = 0; for (int k = 1; k < 32; ++k) if (pstart[k] <= j * 256) e = k; blkexp[j] = e; }
    __syncthreads();
}
__device__ __forceinline__ void phase_route2(const Frame& F, const int* tok_e, const int* tok_p, int* inv, int* slot_tok, unsigned* gcnt) {
    LAS int* pstart = (LAS int*)(F.lds + TAB_OFF); LAS int* blkexp = pstart + 64;
    moe_tables(F, gcnt, pstart, blkexp);
    for (int i = F.bid * NTHR + F.tid; i < T * 4; i += F.G * NTHR) { const int e = tok_e[i], dest = pstart[e] + tok_p[i]; inv[i] = dest; slot_tok[dest] = i >> 2; }
}
__device__ __forceinline__ void phase_final(const Frame& F, const bf16_t* x2b, const bf16_t* ys, const int* inv, const float* gates, const float* w, const float* bb, float* out) {
    const int gw = F.bid * NWAVES + F.wave, NGW = F.G * NWAVES;
    for (int m = gw; m < T; m += NGW) {
        const u32x2* xr = (const u32x2*)(x2b + (size_t)m * D) + F.lane; f32x4 v[8];
#pragma unroll
        for (int j = 0; j < 8; ++j) { const u32x2 p = xr[64 * j]; v[j] = (f32x4){bf2f(p.x & 0xffffu), bf2f(p.x >> 16), bf2f(p.y & 0xffffu), bf2f(p.y >> 16)} * DN_ALPHA; }
#pragma unroll
        for (int k = 0; k < 4; ++k) { const int s = inv[(size_t)m * 4 + k]; const float gk = gates[(size_t)m * 4 + k]; const u32x2* yr = (const u32x2*)(ys + (size_t)s * D) + F.lane;
#pragma unroll
            for (int j = 0; j < 8; ++j) { const u32x2 p = yr[64 * j]; v[j][0] += gk * bf2f(p.x & 0xffffu); v[j][1] += gk * bf2f(p.x >> 16); v[j][2] += gk * bf2f(p.y & 0xffffu); v[j][3] += gk * bf2f(p.y >> 16); } }
        float s = 0.f;
#pragma unroll
        for (int j = 0; j < 8; ++j) s += (v[j][0] + v[j][1]) + (v[j][2] + v[j][3]);
        const float mean = wave_sum(s) * (1.0f / D); float q = 0.f;
#pragma unroll
        for (int j = 0; j < 8; ++j) { v[j] = v[j] - mean; q += (v[j][0] * v[j][0] + v[j][1] * v[j][1]) + (v[j][2] * v[j][2] + v[j][3] * v[j][3]); }
        const float rstd = 1.0f / sqrtf(wave_sum(q) * (1.0f / D) + LN_EPS);
#pragma unroll
        for (int j = 0; j < 8; ++j) { const f32x4 ww = ((const f32x4*)w)[F.lane + 64 * j], b4 = ((const f32x4*)bb)[F.lane + 64 * j]; ((f32x4*)(out + (size_t)m * D))[F.lane + 64 * j] = v[j] * rstd * ww + b4; }
    }
}

constexpr int NPHASE = 17;
__global__ void __launch_bounds__(NTHR, 2) fwd_kernel(Args args) {
    extern __shared__ __attribute__((aligned(16))) unsigned char lds_raw[];
    Frame F; F.lds = (LAS unsigned char*)lds_raw; F.tid = threadIdx.x; F.lane = F.tid & 63; F.wave = __builtin_amdgcn_readfirstlane(F.tid >> 6); F.G = gridDim.x; F.bid = blockIdx.x; F.ws = args.ws;
    unsigned* ctl = (unsigned*)(args.ws + WS_CTL);
    volatile LAS unsigned* MISC = (volatile LAS unsigned*)(F.lds + MISC_OFF);
    if (F.tid < 32) MISC[F.tid] = 0u;
    __syncthreads();
    XcdBarrier bar; bar.bar = ctl + CW_BAR; bar.x = 0; bar.st = MISC + 8;
    if (MK_FUSED) bar = xcd_barrier_post(ctl + CW_BAR, MISC + 8);
    const int lo = args.ph_lo, hi = args.ph_hi;
#define IN(k) (lo <= (k) && (k) < hi)
#define DUPK(k) ((DUP_MASK >> (k)) & 1)
#define SEAM(k) do { if (IN(k) && IN((k) + 1)) xcd_barrier(bar); } while (0)
    unsigned char* ws = args.ws;
    bf16_t* xb = (bf16_t*)(ws + WS_XB); bf16_t* proj = (bf16_t*)(ws + WS_PROJ); bf16_t* y = (bf16_t*)(ws + WS_Y); bf16_t* z = (bf16_t*)(ws + WS_Z);
    bf16_t* x1b = (bf16_t*)(ws + WS_X1B); bf16_t* x2b = (bf16_t*)(ws + WS_X2B);
    bf16_t* kv = (bf16_t*)(ws + WS_KV); bf16_t* wqk = (bf16_t*)(ws + WS_WQK); bf16_t* wvo = (bf16_t*)(ws + WS_WVO); bf16_t* sp = (bf16_t*)(ws + WS_SP);
    float* Ut = (float*)(ws + WS_U); bf16_t* Rt = (bf16_t*)(ws + WS_RT);
    float* logits = (float*)(ws + WS_SMALL + SM_LOGITS); int* tok_e = (int*)(ws + WS_SMALL + SM_TOKE); int* tok_p = (int*)(ws + WS_SMALL + SM_TOKP);
    float* gates = (float*)(ws + WS_SMALL + SM_GATE); int* inv = (int*)(ws + WS_SMALL + SM_INV); int* slot_tok = (int*)(ws + WS_SMALL + SM_SLOT);
    unsigned char* act = ws + WS_ACT; bf16_t* ysl = (bf16_t*)(ws + WS_YS); unsigned char* x2q = ws + WS_X2Q;
    unsigned* gcnt = ctl + CW_CNT;
    LAS unsigned char* idxtab = F.lds + IDX_OFF;

    if (IN(0)) { phase_prep(F, args); if (DUPK(0)) { __syncthreads(); phase_prep(F, args); } } SEAM(0);
    if (IN(1)) {
        { pg8::ProbStd P; P.init(xb, (const bf16_t*)(ws + WS_WIN), T, DIN, 2048, 2048, 2048, F.G, F.bid); pg8::EpiBf16 E{proj, DIN, nullptr, 0, 1.0f}; pg8::gemm_phase(F.lds, idxtab, P, E); }
        { pg8::ProbStd P; P.init((const bf16_t*)(ws + WS_MEMB), (const bf16_t*)(ws + WS_WKV), 512, 4096, 2048, 2048, 2048, F.G, F.bid); pg8::EpiBf16 E{kv, 4096, nullptr, 0, 1.0f}; pg8::gemm_phase(F.lds, idxtab, P, E); }
    } SEAM(1);
#define P2_BODY \
        for (int it = F.bid; it < BATCH * NCH; it += F.G) swa_item(F, proj, y, args.in[3], args.in[4], it / NCH, it % NCH); \
        for (int it = F.bid; it < BATCH * NCH * 8; it += F.G) ret_u_item(F, proj, Ut, it / (NCH * 8), (it >> 3) % NCH, it & 7); \
        __syncthreads(); \
        { pg8::ProbFoldA P{kv, (const bf16_t*)(ws + WS_WQN), 512, 4096, 2048, F.G, F.bid}; pg8::EpiBf16 E{wqk, 2048, nullptr, 0, 0.04419417382415922f}; pg8::gemm_phase(F.lds, idxtab, P, E); } \
        { pg8::ProbFoldB P{(const bf16_t*)(ws + WS_WO), kv, 512, 2048, 4096, F.G, F.bid}; pg8::EpiBf16 E{wvo, 1024, nullptr, 0, 1.0f}; pg8::gemm_phase(F.lds, idxtab, P, E); }
    if (IN(2)) { P2_BODY if (DUPK(2)) { __syncthreads(); P2_BODY }
    } SEAM(2);
    if (IN(3)) { phase_scan(F, Ut, Rt); if (DUPK(3)) phase_scan(F, Ut, Rt); } SEAM(3);
    #define P4_BODY { for (int it = F.bid; it < BATCH * NCH * 8; it += F.G) ret_o_item(F, proj, Rt, y, args.in[5], it / (NCH * 8), (it >> 3) % NCH, it & 7); __syncthreads(); }
    if (IN(4)) { P4_BODY if (DUPK(4)) P4_BODY } SEAM(4);
    if (IN(5)) { pg8::ProbStd P; P.init(y, (const bf16_t*)(ws + WS_WMIX), T, 2048, 2048, 2048, 2048, F.G, F.bid); pg8::EpiResBf16 E{xb, z, 2048, DN_ALPHA}; pg8::gemm_phase(F.lds, idxtab, P, E); } SEAM(5);
    if (IN(6)) { phase_ln(F, z, args.in[7], args.in[8], x1b, nullptr); if (DUPK(6)) phase_ln(F, z, args.in[7], args.in[8], x1b, nullptr); } SEAM(6);
    if (IN(7)) { pg8::ProbStd P; P.init(x1b, wqk, T, 1024, 2048, 2048, 2048, F.G, F.bid); P.split_pm = 64; P.b_split_stride = (size_t)1024 * 2048; pg8::EpiBf16 E{sp, 1024, nullptr, 0, 1.0f}; pg8::gemm_phase(F.lds, idxtab, P, E); } SEAM(7);
    if (IN(8)) { phase_softmax(F, sp); } SEAM(8);
    if (IN(9)) { pg8::ProbStd P; P.init(sp, wvo, T, 2048, 1024, 1024, 1024, F.G, F.bid); P.split_pm = 64; P.b_split_stride = (size_t)2048 * 1024; pg8::EpiResBf16 E{x1b, z, 2048, DN_ALPHA}; pg8::gemm_phase(F.lds, idxtab, P, E); } SEAM(9);
    if (IN(10)) { phase_ln(F, z, args.in[12], args.in[13], x2b, x2q); if (DUPK(10)) phase_ln(F, z, args.in[12], args.in[13], x2b, x2q); } SEAM(10);
    if (IN(11)) { pg8::ProbStd P; P.init(x2b, (const bf16_t*)(ws + WS_WR), T, 256, 2048, 2048, 2048, F.G, F.bid); pg8::EpiRouter E{logits, args.in[15]}; pg8::gemm_phase(F.lds, idxtab, P, E); } SEAM(11);
    if (IN(12)) { phase_route1(F, logits, tok_e, tok_p, gates, slot_tok, gcnt); } SEAM(12);
    if (IN(13)) { phase_route2(F, tok_e, tok_p, inv, slot_tok, gcnt); } SEAM(13);
    if (IN(14)) {
        LAS int* pstart = (LAS int*)(F.lds + TAB_OFF); LAS int* blkexp = pstart + 64; moe_tables(F, gcnt, pstart, blkexp);
        pg8::ProbMoe<true> P; P.A = x2q; P.W = ws + WS_WGU; P.slot_tok = slot_tok; P.blkexp = blkexp; P.K = 2048; P.lda = 2048; P.ldb = 2048; P.S.init(pstart[32] >> 8, 16, F.G, F.bid);
        pg8::EpiSwiglu E{act, args.in[17]}; pg8::gemm_phase(F.lds, idxtab, P, E);
    } SEAM(14);
    if (IN(15)) {
        LAS int* pstart = (LAS int*)(F.lds + TAB_OFF); LAS int* blkexp = pstart + 64; moe_tables(F, gcnt, pstart, blkexp);
        pg8::ProbMoe<false> P; P.A = act; P.W = ws + WS_WD; P.slot_tok = slot_tok; P.blkexp = blkexp; P.K = 2048; P.lda = 2048; P.ldb = 2048; P.S.init(pstart[32] >> 8, 8, F.G, F.bid);
        pg8::EpiBf16 E{ysl, 2048, args.in[19], 2048, 1.0f}; pg8::gemm_phase(F.lds, idxtab, P, E);
    } SEAM(15);
    if (IN(16)) { phase_final(F, x2b, ysl, inv, gates, args.in[20], args.in[21], args.out); if (DUPK(16)) phase_final(F, x2b, ysl, inv, gates, args.in[20], args.in[21], args.out); }
#undef IN
#undef SEAM
}

extern "C" void kernel_launch(void* const* d_in, const int* in_sizes, int n_in, void* d_out, int out_size, void* d_ws, size_t ws_size, hipStream_t stream) {
    static int grid = 0;
    if (grid == 0) {
        if (n_in != 22 || out_size != T * D || ws_size < WS_END) { fprintf(stderr, "kernel_launch: unexpected shapes (n_in %d out %d ws %zu need %zu)\n", n_in, out_size, ws_size, (size_t)WS_END); grid = -1; return; }
        int dev = 0, cus = 0, per_cu = 0;
        if (hipGetDevice(&dev) != hipSuccess || hipDeviceGetAttribute(&cus, hipDeviceAttributeMultiprocessorCount, dev) != hipSuccess) { grid = -1; return; }
        if (hipFuncSetAttribute((const void*)fwd_kernel, hipFuncAttributeMaxDynamicSharedMemorySize, LDS_BYTES) != hipSuccess) { fprintf(stderr, "kernel_launch: hipFuncSetAttribute failed\n"); grid = -1; return; }
        if (hipOccupancyMaxActiveBlocksPerMultiprocessor(&per_cu, (const void*)fwd_kernel, NTHR, LDS_BYTES) != hipSuccess || per_cu < 1) fprintf(stderr, "kernel_launch: occupancy query reports %d\n", per_cu);
        (void)hipGetLastError();
        grid = cus;
    }
    if (grid < 0) return;
    (void)hipMemsetAsync((char*)d_ws + WS_CTL, 0, CTL_ZERO_BYTES, stream);
    Args a{};
    for (int i = 0; i < 22; ++i) a.in[i] = (const float*)d_in[i];
    a.out = (float*)d_out; a.ws = (unsigned char*)d_ws;
#if MK_FUSED
    a.ph_lo = 0; a.ph_hi = NPHASE;
    hipLaunchKernelGGL(fwd_kernel, dim3(grid), dim3(NTHR), LDS_BYTES, stream, a);
#else
    for (int p = 0; p < NPHASE; ++p) { a.ph_lo = p; a.ph_hi = p + 1; hipLaunchKernelGGL(fwd_kernel, dim3(grid), dim3(NTHR), LDS_BYTES, stream, a); }
#endif
}
```

```cpp
#include <hip/hip_runtime.h>
#include <cstdio>
#include <cstdint>

#ifndef MK_FUSED
#define MK_FUSED 1
#endif

#ifndef DUP_MASK
#define DUP_MASK 0
#endif
#define LAS __attribute__((address_space(3)))
#define GAS __attribute__((address_space(1)))
typedef unsigned short bf16_t;
typedef short bf16x8 __attribute__((ext_vector_type(8)));
typedef short bf16x4 __attribute__((ext_vector_type(4)));
typedef float f32x4 __attribute__((ext_vector_type(4)));
typedef float f32x2 __attribute__((ext_vector_type(2)));
typedef unsigned u32x4 __attribute__((ext_vector_type(4)));
typedef unsigned u32x2 __attribute__((ext_vector_type(2)));
typedef int i32x8 __attribute__((ext_vector_type(8)));
typedef int i32x4 __attribute__((ext_vector_type(4)));
constexpr int W8_SCALE_BYTE = 0x78787878;
constexpr float W8_MUL = 128.0f;

constexpr int BATCH = 2, SEQ = 16384, T = BATCH * SEQ, D = 2048;
constexpr int DIN = 5376;
constexpr int OFF_QA = 0, OFF_KA = 1024, OFF_VA = 1152, OFF_QR = 1280, OFF_KR = 2304, OFF_VR = 3328, OFF_GR = 4352;
constexpr int NCH = SEQ / 128;
constexpr int NEXP = 32, NBLK_MAX = 544, NSLOT = NBLK_MAX * 256;
constexpr float LN_EPS = 1e-5f;
constexpr float DN_ALPHA = 1.18920711500272f;
constexpr int NWAVES = 8, NTHR = 512;

constexpr size_t MiB = (size_t)1 << 20;
constexpr size_t WS_CTL = 0, CTL_ZERO_BYTES = 1 * MiB;
constexpr size_t WS_WIN = 1 * MiB;
constexpr size_t WS_WMIX = WS_WIN + 21 * MiB;
constexpr size_t WS_WQN = WS_WMIX + 8 * MiB;
constexpr size_t WS_WKV = WS_WQN + 8 * MiB;
constexpr size_t WS_WO = WS_WKV + 16 * MiB;
constexpr size_t WS_WR = WS_WO + 8 * MiB;
constexpr size_t WS_WGU = WS_WR + 1 * MiB;
constexpr size_t WS_X2Q = WS_WGU + 256 * MiB;
constexpr size_t WS_WD = WS_WGU + 512 * MiB;
constexpr size_t WS_MEMB = WS_WD + 256 * MiB;
constexpr size_t WS_KV = WS_MEMB + 2 * MiB;
constexpr size_t WS_WQK = WS_KV + 4 * MiB;
constexpr size_t WS_WVO = WS_WQK + 8 * MiB;
constexpr size_t WS_SMALL = WS_WVO + 8 * MiB;
constexpr size_t WS_RT = WS_SMALL + 16 * MiB;
constexpr size_t WS_SP = WS_RT + 64 * MiB;
constexpr size_t WS_X1B = WS_SP + 64 * MiB;
constexpr size_t WS_X2B = WS_X1B + 128 * MiB;
constexpr size_t WS_X2 = WS_X2B + 128 * MiB;
constexpr size_t WS_R1 = WS_X2 + 256 * MiB;
constexpr size_t WS_XB = WS_R1;
constexpr size_t WS_PROJ = WS_XB + 128 * MiB;
constexpr size_t WS_U = WS_PROJ + 336 * MiB;
constexpr size_t WS_ACT = WS_R1;
constexpr size_t WS_R2 = WS_R1 + 592 * MiB;
constexpr size_t WS_Y = WS_R2;
constexpr size_t WS_Z = WS_Y + 128 * MiB;
constexpr size_t WS_X1 = WS_Z + 256 * MiB;
constexpr size_t WS_YS = WS_R2;
constexpr size_t WS_END = WS_R2 + 640 * MiB;
static_assert((size_t)NSLOT * 2048 * 2 <= 592 * MiB && (size_t)NSLOT * 2048 * 2 <= 640 * MiB, "overlay sizes");
constexpr size_t SM_LOGITS = 0;
constexpr size_t SM_TOKE = 8 * MiB;
constexpr size_t SM_TOKP = 9 * MiB;
constexpr size_t SM_GATE = 10 * MiB;
constexpr size_t SM_INV = 11 * MiB;
constexpr size_t SM_SLOT = 12 * MiB;
constexpr int CW_BAR = 4096, CW_CNT = 8192;

constexpr int RING_BYTES = 139264;
constexpr int IDX_OFF = RING_BYTES;
constexpr int TAB_OFF = RING_BYTES + 1024;
constexpr int MISC_OFF = RING_BYTES + 1024 + 4096;
constexpr int LDS_BYTES = 147456;
static_assert(MISC_OFF + 256 <= LDS_BYTES, "lds map");

__device__ __forceinline__ unsigned f2bf(float f) { unsigned u = __float_as_uint(f); return (u + 0x7fffu + ((u >> 16) & 1u)) >> 16; }
__device__ __forceinline__ unsigned pk2(float lo, float hi) { return f2bf(lo) | (f2bf(hi) << 16); }
__device__ __forceinline__ float bf2f(unsigned b) { return __uint_as_float(b << 16); }
__device__ __forceinline__ unsigned cvt_pk_bf16(float lo, float hi) { unsigned r; asm volatile("v_cvt_pk_bf16_f32 %0, %1, %2" : "=v"(r) : "v"(lo), "v"(hi)); return r; }
__device__ __forceinline__ f32x4 mfma16(bf16x8 a, bf16x8 b, f32x4 c) { return __builtin_amdgcn_mfma_f32_16x16x32_bf16(a, b, c, 0, 0, 0); }
__device__ __forceinline__ float wave_sum(float v) {
#pragma unroll
    for (int o = 1; o < 64; o <<= 1) v += __shfl_xor(v, o);
    return v;
}
__device__ __forceinline__ float wave_max(float v) {
#pragma unroll
    for (int o = 1; o < 64; o <<= 1) v = fmaxf(v, __shfl_xor(v, o));
    return v;
}
__device__ __forceinline__ float grp16_sum(float v) { v += __shfl_xor(v, 1); v += __shfl_xor(v, 2); v += __shfl_xor(v, 4); v += __shfl_xor(v, 8); return v; }
__device__ __forceinline__ float grp16_max(float v) { v = fmaxf(v, __shfl_xor(v, 1)); v = fmaxf(v, __shfl_xor(v, 2)); v = fmaxf(v, __shfl_xor(v, 4)); v = fmaxf(v, __shfl_xor(v, 8)); return v; }
__device__ __forceinline__ bf16x8 tr_frag(const LAS unsigned char* p, int rs4) {
    const bf16x4 lo = __builtin_amdgcn_ds_read_tr16_b64_v4i16((LAS bf16x4*)p);
    const bf16x4 hi = __builtin_amdgcn_ds_read_tr16_b64_v4i16((LAS bf16x4*)(p + rs4));
    return (bf16x8){lo[0], lo[1], lo[2], lo[3], hi[0], hi[1], hi[2], hi[3]};
}

namespace pg8 {
constexpr int BM = 256, BK = 64, HALF = 128, HTB = HALF * BK * 2, STAGE_BYTES = 8 * HTB, NXCD = 8, WGM = 8;
__host__ __device__ __forceinline__ int lds_byte(int r, int c) { const int st = (r >> 4) * 2 + (c >> 5), rr = r & 15, cc = c & 31, ob = rr * 64 + cc * 2; return st * 1024 + (ob ^ (((ob >> 9) & 1) << 5)); }
__host__ __device__ __forceinline__ void stage_rc(int b, int& R, int& C) { const int st = b / 1024, sb = b % 1024, swz = sb ^ (((sb >> 9) & 1) << 5); R = (st >> 1) * 16 + swz / 64; C = (st & 1) * 32 + (swz % 64) / 2; }
__host__ __device__ __forceinline__ int perm32(int rho) { const int n = rho >> 4, i = rho & 15; return 8 * (i >> 2) + 4 * n + (i & 3); }

struct Unit { int pm, pn, orow, ocol, aux; };

struct StaticOrder {
    int nM, nN, nwg, G, c;
    __device__ void init(int nM_, int nN_, int G_, int c_) { nM = nM_; nN = nN_; nwg = nM * nN; G = G_; c = c_; }
    __device__ bool next(int i, int& pm, int& pn) const {
        const long L = (long)i * G + c; if (L >= nwg) return false;
        int wgid = (int)L; { const int q = nwg / NXCD, r = nwg % NXCD, xcd = wgid % NXCD, off = wgid / NXCD; wgid = (xcd < r ? xcd * (q + 1) : r * (q + 1) + (xcd - r) * q) + off; }
        const int nig = WGM * nN, gid = wgid / nig, fm = gid * WGM, gsz = (nM - fm) < WGM ? (nM - fm) : WGM;
        pm = fm + ((wgid % nig) % gsz); pn = (wgid % nig) / gsz; return true;
    }
};

template <class Epi, class Prob>
__device__ __forceinline__ void gemm_phase(LAS unsigned char* lds, LAS unsigned char* idxtab, const Prob& P, const Epi& E) {
    const int tid = threadIdx.x, wid = __builtin_amdgcn_readfirstlane(tid >> 6), lane = tid & 63, wr = wid >> 2, wc = wid & 3, fr = lane & 15, fq = lane >> 4;
    const int K = P.K, nt = Prob::FP8 ? K / 128 : K / BK;
    constexpr bool GATHER = Prob::GATHER; constexpr bool FP8 = Prob::FP8; constexpr unsigned ES = FP8 ? 1u : 2u;
    const unsigned lda2 = (unsigned)P.lda * ES, ldb2 = (unsigned)P.ldb * ES;
    unsigned voffB, oc[2][2], on[2][2]; int rA[2]; unsigned cA2;
    { int R, C; stage_rc(tid * 16, R, C); const int Rb = Epi::PERM ? ((R & ~31) + perm32(R & 31)) : R;
        voffB = (unsigned)Rb * ldb2 + (unsigned)C * 2u; rA[0] = R; rA[1] = R + 64; cA2 = (unsigned)C * 2u;
#pragma unroll
        for (int i = 0; i < 2; ++i)
#pragma unroll
            for (int h = 0; h < 2; ++h) { oc[h][i] = (unsigned)R * lda2 + cA2; on[h][i] = oc[h][i]; } }
    const size_t pstepA = (size_t)64 * lda2, pstepB = (size_t)64 * ldb2, hstepA = (size_t)HALF * lda2;
    const size_t kstep = (size_t)(BK * 2);
    const size_t hstepB = (size_t)HALF * ldb2;
    const unsigned ldsw = (unsigned)wid * 1024u, ldsbase = (unsigned)(size_t)lds;
    const int aoff = lds_byte(wr * 64 + fr, fq * 8), boff = lds_byte(wc * 32 + fr, fq * 8);
#define PG8_SA(b, h) (((b) * 2 + (h)) * HTB)
#define PG8_SB(b, h) ((4 + (b) * 2 + (h)) * HTB)
#define PG8_GLDS(ldsdst, gptr, voff32) do { unsigned keep_; asm volatile("s_mov_b32 %0, m0\n\ts_mov_b32 m0, %2\n\ts_nop 0\n\tglobal_load_lds_dwordx4 %1, %3\n\ts_mov_b32 m0, %0" \
        : "=&s"(keep_) : "v"(voff32), "s"(ldsdst), "s"(gptr) : "memory"); } while (0)
#define PG8_STAGE_B(bufoff, gbase) do { PG8_GLDS(ldsbase + (unsigned)(bufoff) + ldsw, (const char*)(gbase), voffB); PG8_GLDS(ldsbase + (unsigned)(bufoff) + ldsw + 8192u, (const char*)(gbase) + pstepB, voffB); } while (0)
#define PG8_STAGE_A(bufoff, gbase, o, h) do { if constexpr (GATHER) { PG8_GLDS(ldsbase + (unsigned)(bufoff) + ldsw, (const char*)(gbase), (o)[h][0]); PG8_GLDS(ldsbase + (unsigned)(bufoff) + ldsw + 8192u, (const char*)(gbase), (o)[h][1]); } \
        else { PG8_GLDS(ldsbase + (unsigned)(bufoff) + ldsw, (const char*)(gbase) + (h) * hstepA, oc[0][0]); PG8_GLDS(ldsbase + (unsigned)(bufoff) + ldsw + 8192u, (const char*)(gbase) + (h) * hstepA + pstepA, oc[0][0]); } } while (0)
#define PG8_LDA(dst, b, h) do { _Pragma("unroll") for (int m = 0; m < 4; ++m) { \
        if constexpr (FP8) { const i32x4 lo_ = *(const LAS i32x4*)(lds + PG8_SA(b, h) + aoff + m * 2048), hi_ = *(const LAS i32x4*)(lds + PG8_SA(b, h) + aoff + m * 2048 + 1024); \
            dst##8[m] = (i32x8){lo_.x, lo_.y, lo_.z, lo_.w, hi_.x, hi_.y, hi_.z, hi_.w}; } \
        else { _Pragma("unroll") for (int k = 0; k < 2; ++k) dst[m][k] = *(const LAS bf16x8*)(lds + PG8_SA(b, h) + aoff + m * 2048 + k * 1024); } } } while (0)
#define PG8_LDB(dst, b, h) do { _Pragma("unroll") for (int n = 0; n < 2; ++n) { \
        if constexpr (FP8) { const i32x4 lo_ = *(const LAS i32x4*)(lds + PG8_SB(b, h) + boff + n * 2048), hi_ = *(const LAS i32x4*)(lds + PG8_SB(b, h) + boff + n * 2048 + 1024); \
            dst##8[n] = (i32x8){lo_.x, lo_.y, lo_.z, lo_.w, hi_.x, hi_.y, hi_.z, hi_.w}; } \
        else { _Pragma("unroll") for (int k = 0; k < 2; ++k) dst[n][k] = *(const LAS bf16x8*)(lds + PG8_SB(b, h) + boff + n * 2048 + k * 1024); } } } while (0)
#define PG8_MMA(ai, bj, At, Bt) do { __builtin_amdgcn_s_setprio(1); _Pragma("unroll") for (int m = 0; m < 4; ++m) _Pragma("unroll") for (int n = 0; n < 2; ++n) { \
        if constexpr (FP8) asm volatile("s_nop 1\n\tv_mfma_scale_f32_16x16x128_f8f6f4 %0, %1, %2, %0, %3, %4 op_sel_hi:[0,0,0]" : "+v"(acc[ai][bj][m][n]) : "v"(Bt##8[n]), "v"(At##8[m]), "v"(sclW), "v"(sclA)); \
        else { _Pragma("unroll") for (int k = 0; k < 2; ++k) acc[ai][bj][m][n] = __builtin_amdgcn_mfma_f32_16x16x32_bf16(Bt[n][k], At[m][k], acc[ai][bj][m][n], 0, 0, 0); } } \
        __builtin_amdgcn_s_setprio(0); } while (0)
#define PG8_WAIT_V(n) asm volatile("s_waitcnt vmcnt(" #n ")" ::: "memory")
#define PG8_WAIT_L(n) asm volatile("s_waitcnt lgkmcnt(" #n ")" ::: "memory")
#define PG8_BAR __builtin_amdgcn_s_barrier()
#define PG8_SCHED __builtin_amdgcn_sched_barrier(0)
    Unit cur, nxt; int ui = 0;
    if (!P.next(0, cur)) return;
    f32x4 acc[2][2][4][2];
#pragma unroll
    for (int a = 0; a < 2; ++a)
#pragma unroll
        for (int b = 0; b < 2; ++b)
#pragma unroll
            for (int m = 0; m < 4; ++m)
#pragma unroll
                for (int n = 0; n < 2; ++n) acc[a][b][m][n] = (f32x4){0.f, 0.f, 0.f, 0.f};
    bf16x8 At[4][2], B0[2][2], B1[2][2]; i32x8 At8[4], B08[2], B18[2]; const int sclW = W8_SCALE_BYTE, sclA = 0x7f7f7f7f;
    const char* cA = P.a_ptr(cur); const char* cB = P.b_ptr(cur);
    if constexpr (GATHER) {
        if (wid < 4) __builtin_amdgcn_global_load_lds((const unsigned*)(P.idx_ptr(cur) + wid * 64 + lane), (LAS unsigned*)(idxtab + wid * 256), 4, 0, 0);
        PG8_WAIT_V(0); PG8_BAR;
#pragma unroll
        for (int i = 0; i < 2; ++i)
#pragma unroll
            for (int h = 0; h < 2; ++h) oc[h][i] = ((const LAS unsigned*)idxtab)[h * HALF + rA[i]] * lda2 + cA2;
        PG8_WAIT_L(0); PG8_BAR;
    }
    PG8_STAGE_B(PG8_SB(0, 0), cB); PG8_STAGE_B(PG8_SB(0, 1), cB + hstepB); PG8_STAGE_A(PG8_SA(0, 0), cA, oc, 0); PG8_STAGE_A(PG8_SA(0, 1), cA, oc, 1);
    if (wr == 1) PG8_BAR;
    PG8_WAIT_V(2); PG8_BAR;
    PG8_STAGE_B(PG8_SB(1, 0), cB + kstep); PG8_STAGE_A(PG8_SA(1, 0), cA + kstep, oc, 0); PG8_STAGE_B(PG8_SB(1, 1), cB + hstepB + kstep);
    PG8_WAIT_V(6); PG8_BAR;
    for (;;) {
        const bool has_next = P.next(ui + 1, nxt);
        const char* nA = has_next ? P.a_ptr(nxt) : cA; const char* nB = has_next ? P.b_ptr(nxt) : cB;
        if constexpr (GATHER) { if (has_next && wid < 4) __builtin_amdgcn_global_load_lds((const unsigned*)(P.idx_ptr(nxt) + wid * 64 + lane), (LAS unsigned*)(idxtab + wid * 256), 4, 0, 0); }
        for (int t = 0; t < nt; t += 2) {
            const bool last = (t == nt - 2);
            const char* a1 = cA + (size_t)(t + 1) * kstep;
            const char* a2 = last ? nA : cA + (size_t)(t + 2) * kstep; const char* b2 = last ? nB : cB + (size_t)(t + 2) * kstep;
            const char* a3 = a2 + kstep; const char* b3 = b2 + kstep;
            unsigned os[2][2];
            if constexpr (GATHER) {
                if (last && has_next) {
#pragma unroll
                    for (int i = 0; i < 2; ++i)
#pragma unroll
                        for (int h = 0; h < 2; ++h) on[h][i] = ((const LAS unsigned*)idxtab)[h * HALF + rA[i]] * lda2 + cA2;
                }
#pragma unroll
                for (int i = 0; i < 2; ++i)
#pragma unroll
                    for (int h = 0; h < 2; ++h) os[h][i] = last ? on[h][i] : oc[h][i];
            } else {
#pragma unroll
                for (int i = 0; i < 2; ++i)
#pragma unroll
                    for (int h = 0; h < 2; ++h) os[h][i] = oc[h][i];
            }
            PG8_LDB(B0, 0, 0); PG8_LDB(B1, 0, 1); PG8_SCHED; PG8_LDA(At, 0, 0); PG8_STAGE_A(PG8_SA(1, 1), a1, oc, 1);
            PG8_WAIT_V(8); PG8_WAIT_L(0); PG8_BAR; PG8_MMA(0, 0, At, B0); PG8_MMA(0, 1, At, B1); PG8_BAR; PG8_SCHED;
            PG8_LDA(At, 0, 1); PG8_STAGE_B(PG8_SB(0, 0), b2); PG8_STAGE_B(PG8_SB(0, 1), b2 + hstepB); PG8_STAGE_A(PG8_SA(0, 0), a2, os, 0);
            PG8_WAIT_V(8); PG8_WAIT_L(0); PG8_BAR; PG8_MMA(1, 0, At, B0); PG8_MMA(1, 1, At, B1); PG8_BAR; PG8_SCHED;
            PG8_LDB(B0, 1, 0); PG8_LDB(B1, 1, 1); PG8_SCHED; PG8_LDA(At, 1, 0); PG8_STAGE_A(PG8_SA(0, 1), a2, os, 1);
            PG8_WAIT_V(8); PG8_WAIT_L(0); PG8_BAR; PG8_MMA(0, 0, At, B0); PG8_MMA(0, 1, At, B1); PG8_BAR; PG8_SCHED;
            PG8_LDA(At, 1, 1); PG8_STAGE_B(PG8_SB(1, 0), b3); PG8_STAGE_B(PG8_SB(1, 1), b3 + hstepB); PG8_STAGE_A(PG8_SA(1, 0), a3, os, 0);
            PG8_WAIT_V(8); PG8_WAIT_L(0); PG8_BAR; PG8_MMA(1, 0, At, B0); PG8_MMA(1, 1, At, B1); PG8_BAR; PG8_SCHED;
        }
        if constexpr (FP8) { asm volatile("s_nop 15\n\ts_nop 15\n\ts_nop 7" ::: "memory"); PG8_SCHED; }
        if (wr == 0) PG8_BAR;
        E(acc, cur, wr, wc, fr, fq);
        if (!has_next) break;
#pragma unroll
        for (int a = 0; a < 2; ++a)
#pragma unroll
            for (int b = 0; b < 2; ++b)
#pragma unroll
                for (int m = 0; m < 4; ++m)
#pragma unroll
                    for (int n = 0; n < 2; ++n) acc[a][b][m][n] = (f32x4){0.f, 0.f, 0.f, 0.f};
        cur = nxt; cA = nA; cB = nB; ++ui;
        if constexpr (GATHER) {
#pragma unroll
            for (int i = 0; i < 2; ++i)
#pragma unroll
                for (int h = 0; h < 2; ++h) oc[h][i] = on[h][i];
        }
        if (wr == 1) PG8_BAR;
    }
    PG8_WAIT_V(0);
    PG8_BAR;
#undef PG8_SA
#undef PG8_SB
#undef PG8_STAGE_A
#undef PG8_STAGE_B
#undef PG8_GLDS
#undef PG8_LDA
#undef PG8_LDB
#undef PG8_MMA
#undef PG8_WAIT_V
#undef PG8_WAIT_L
#undef PG8_BAR
#undef PG8_SCHED
}

struct EpiBf16 {
    static constexpr bool PERM = true;
    bf16_t* O; int ldc; const float* bias; int bias_stride; float scale;
    __device__ __forceinline__ void operator()(const f32x4 (&acc)[2][2][4][2], const Unit& u, int wr, int wc, int fr, int fq) const {
        const int row0 = u.orow + wr * 64 + fr, col0 = u.ocol + wc * 32 + 8 * fq;
        f32x4 bv[2][2];
#pragma unroll
        for (int bj = 0; bj < 2; ++bj)
#pragma unroll
            for (int n = 0; n < 2; ++n) bv[bj][n] = bias ? *(const f32x4*)(bias + (size_t)u.aux * bias_stride + col0 + bj * HALF + 4 * n) : (f32x4){0.f, 0.f, 0.f, 0.f};
#pragma unroll
        for (int ai = 0; ai < 2; ++ai)
#pragma unroll
            for (int m = 0; m < 4; ++m) { bf16_t* rowp = O + (size_t)(row0 + ai * HALF + m * 16) * ldc + col0;
#pragma unroll
                for (int bj = 0; bj < 2; ++bj) { f32x4 v0 = (acc[ai][bj][m][0] + bv[bj][0]) * scale, v1 = (acc[ai][bj][m][1] + bv[bj][1]) * scale;
                    u32x4 w; w.x = cvt_pk_bf16(v0[0], v0[1]); w.y = cvt_pk_bf16(v0[2], v0[3]); w.z = cvt_pk_bf16(v1[0], v1[1]); w.w = cvt_pk_bf16(v1[2], v1[3]);
                    *(u32x4*)(rowp + bj * HALF) = w; } }
    }
};
struct EpiResBf16 {
    static constexpr bool PERM = true;
    const bf16_t* res; bf16_t* out; int ldc; float alpha;
    __device__ __forceinline__ void operator()(const f32x4 (&acc)[2][2][4][2], const Unit& u, int wr, int wc, int fr, int fq) const {
        const int row0 = u.orow + wr * 64 + fr, col0 = u.ocol + wc * 32 + 8 * fq;
#pragma unroll
        for (int ai = 0; ai < 2; ++ai)
#pragma unroll
            for (int m = 0; m < 4; ++m) { const size_t off = (size_t)(row0 + ai * HALF + m * 16) * ldc + col0;
#pragma unroll
                for (int bj = 0; bj < 2; ++bj) { const u32x4 r = *(const u32x4*)(res + off + bj * HALF); const f32x4 a0 = acc[ai][bj][m][0], a1 = acc[ai][bj][m][1];
                    u32x4 w; w.x = cvt_pk_bf16(bf2f(r.x & 0xffffu) * alpha + a0[0], bf2f(r.x >> 16) * alpha + a0[1]); w.y = cvt_pk_bf16(bf2f(r.y & 0xffffu) * alpha + a0[2], bf2f(r.y >> 16) * alpha + a0[3]);
                    w.z = cvt_pk_bf16(bf2f(r.z & 0xffffu) * alpha + a1[0], bf2f(r.z >> 16) * alpha + a1[1]); w.w = cvt_pk_bf16(bf2f(r.w & 0xffffu) * alpha + a1[2], bf2f(r.w >> 16) * alpha + a1[3]);
                    *(u32x4*)(out + off + bj * HALF) = w; }
                if (m & 1) asm volatile("" ::: "memory"); }
    }
};
struct EpiRouter {
    static constexpr bool PERM = false;
    float* out; const float* bias;
    __device__ __forceinline__ void operator()(const f32x4 (&acc)[2][2][4][2], const Unit& u, int wr, int wc, int fr, int fq) const {
        if (wc != 0) return;
        const int row0 = u.orow + wr * 64 + fr;
#pragma unroll
        for (int ai = 0; ai < 2; ++ai)
#pragma unroll
            for (int m = 0; m < 4; ++m)
#pragma unroll
                for (int n = 0; n < 2; ++n) { const int c = 16 * n + 4 * fq; const f32x4 b = *(const f32x4*)(bias + c);
                    *(f32x4*)(out + (size_t)u.aux * T * 32 + (size_t)(row0 + ai * HALF + m * 16) * 32 + c) = u.aux ? acc[ai][0][m][n] : acc[ai][0][m][n] + b; }
    }
};
struct EpiSwiglu {
    static constexpr bool PERM = true;
    unsigned char* O; const float* bias;
    __device__ __forceinline__ void operator()(const f32x4 (&acc)[2][2][4][2], const Unit& u, int wr, int wc, int fr, int fq) const {
        const int row0 = u.orow + wr * 64 + fr, col0 = u.ocol + wc * 32 + 8 * fq;
        const float* bg = bias + (size_t)u.aux * 4096 + col0; const float* bu = bg + 2048;
        const f32x4 g0 = *(const f32x4*)bg, g1 = *(const f32x4*)(bg + 4), u0 = *(const f32x4*)bu, u1 = *(const f32x4*)(bu + 4);
#pragma unroll
        for (int ai = 0; ai < 2; ++ai)
#pragma unroll
            for (int m = 0; m < 4; ++m) {
                f32x4 gl0 = acc[ai][0][m][0] + g0, gl1 = acc[ai][0][m][1] + g1, up0 = acc[ai][1][m][0] + u0, up1 = acc[ai][1][m][1] + u1;
                float r[8];
#pragma unroll
                for (int j = 0; j < 4; ++j) {
                    { const float g = fminf(gl0[j], 7.0f), uu = fminf(fmaxf(up0[j], -7.0f), 7.0f); const float sg = __builtin_amdgcn_rcpf(1.0f + __expf(-1.702f * g)); r[j] = (uu + 1.0f) * (g * sg); }
                    { const float g = fminf(gl1[j], 7.0f), uu = fminf(fmaxf(up1[j], -7.0f), 7.0f); const float sg = __builtin_amdgcn_rcpf(1.0f + __expf(-1.702f * g)); r[4 + j] = (uu + 1.0f) * (g * sg); }
                }
                int w0 = __builtin_amdgcn_cvt_pk_fp8_f32(r[0], r[1], 0, false); w0 = __builtin_amdgcn_cvt_pk_fp8_f32(r[2], r[3], w0, true);
                int w1 = __builtin_amdgcn_cvt_pk_fp8_f32(r[4], r[5], 0, false); w1 = __builtin_amdgcn_cvt_pk_fp8_f32(r[6], r[7], w1, true);
                *(u32x2*)(O + (size_t)(row0 + ai * HALF + m * 16) * 2048 + col0) = (u32x2){(unsigned)w0, (unsigned)w1}; }
    }
};

struct ProbStd {
    static constexpr bool GATHER = false, FP8 = false;
    const bf16_t* A; const bf16_t* Bt; int K, lda, ldb; StaticOrder S; int split_pm; size_t b_split_stride; int orow_extra;
    __device__ void init(const bf16_t* A_, const bf16_t* Bt_, int M, int N, int K_, int lda_, int ldb_, int G, int c) { A = A_; Bt = Bt_; K = K_; lda = lda_; ldb = ldb_; S.init(M / BM, N / BM, G, c); split_pm = 1 << 30; b_split_stride = 0; orow_extra = 0; }
    __device__ bool next(int i, Unit& u) const { if (!S.next(i, u.pm, u.pn)) return false; u.orow = u.pm * BM; u.ocol = u.pn * BM; u.aux = 0; return true; }
    __device__ const char* a_ptr(const Unit& u) const { return (const char*)(A + (size_t)u.pm * BM * lda); }
    __device__ const char* b_ptr(const Unit& u) const { return (const char*)(Bt + (size_t)u.pn * BM * ldb + (u.pm >= split_pm ? b_split_stride : 0)); }
    __device__ const int* idx_ptr(const Unit&) const { return nullptr; }
};
struct ProbRouter {
    static constexpr bool GATHER = false, FP8 = false;
    const bf16_t* A; const bf16_t* Bt; int K, lda, ldb, G, c;
    __device__ bool next(int i, Unit& u) const { const int L = i * G + c; if (L >= 256) return false; u.pm = L >> 1; u.pn = L & 1; u.orow = u.pm * BM; u.ocol = 0; u.aux = u.pn; return true; }
    __device__ const char* a_ptr(const Unit& u) const { return (const char*)(A + (size_t)u.pm * BM * lda + u.pn * 1024); }
    __device__ const char* b_ptr(const Unit& u) const { return (const char*)(Bt + u.pn * 1024); }
    __device__ const int* idx_ptr(const Unit&) const { return nullptr; }
};
struct ProbFoldA {
    static constexpr bool GATHER = false, FP8 = false;
    const bf16_t* kv; const bf16_t* wq; int K, lda, ldb, G, c;
    __device__ bool next(int i, Unit& u) const { const int L = i * G + c; if (L >= 64) return false; const int bh = L >> 3; u.pm = bh; u.pn = L & 7; u.orow = (bh >> 2) * 1024 + (bh & 3) * 256; u.ocol = u.pn * 256; u.aux = 0; return true; }
    __device__ const char* a_ptr(const Unit& u) const { const int b = u.pm >> 2, h = u.pm & 3; return (const char*)(kv + (size_t)b * 256 * 4096 + h * 512); }
    __device__ const char* b_ptr(const Unit& u) const { const int h = u.pm & 3; return (const char*)(wq + (size_t)u.pn * 256 * 2048 + h * 512); }
    __device__ const int* idx_ptr(const Unit&) const { return nullptr; }
};
struct ProbFoldB {
    static constexpr bool GATHER = false, FP8 = false;
    const bf16_t* woT; const bf16_t* kv; int K, lda, ldb, G, c;
    __device__ bool next(int i, Unit& u) const { const int L = i * G + c; if (L >= 64) return false; const int bh = L >> 3; u.pm = L & 7; u.pn = bh; u.orow = (bh >> 2) * 2048 + u.pm * 256; u.ocol = (bh & 3) * 256; u.aux = 0; return true; }
    __device__ const char* a_ptr(const Unit& u) const { const int h = u.pn & 3; return (const char*)(woT + (size_t)u.pm * 256 * 2048 + h * 512); }
    __device__ const char* b_ptr(const Unit& u) const { const int b = u.pn >> 2, h = u.pn & 3; return (const char*)(kv + (size_t)b * 256 * 4096 + 2048 + h * 512); }
    __device__ const int* idx_ptr(const Unit&) const { return nullptr; }
};
template <bool G1> struct ProbMoe {
    static constexpr bool GATHER = G1, FP8 = true;
    const unsigned char* A; const unsigned char* W; const int* slot_tok; const LAS int* blkexp; int K, lda, ldb; StaticOrder S;
    __device__ bool next(int i, Unit& u) const { if (!S.next(i, u.pm, u.pn)) return false; u.orow = u.pm * BM; u.ocol = u.pn * (G1 ? 128 : 256); u.aux = __builtin_amdgcn_readfirstlane(blkexp[u.pm]); return true; }
    __device__ const char* a_ptr(const Unit& u) const { return G1 ? (const char*)A : (const char*)(A + (size_t)u.pm * BM * lda); }
    __device__ const char* b_ptr(const Unit& u) const { return (const char*)(W + ((size_t)u.aux * (G1 ? 4096 : 2048) + (size_t)u.pn * BM) * 2048); }
    __device__ const int* idx_ptr(const Unit& u) const { return slot_tok + u.pm * BM; }
};
}

#define XB_TMO      128
#define XB_XCNT(j)  (256  + 64 * (j))
#define XB_XSUB(j)  (1280 + 64 * (j))
#define XB_XGEN(j)  (2304 + 64 * (j))
#define XB_TOP      3328
#define XB_TOPGEN   3392
#define XCD_BAR_WORDS 3456
#define XB_SPIN_CAP (1u << 18)
__device__ __forceinline__ unsigned xb_ld(unsigned* p)              { return __hip_atomic_load(p, __ATOMIC_RELAXED, __HIP_MEMORY_SCOPE_AGENT); }
__device__ __forceinline__ unsigned xb_add(unsigned* p, unsigned v) { return __hip_atomic_fetch_add(p, v, __ATOMIC_RELAXED, __HIP_MEMORY_SCOPE_AGENT); }
__device__ __forceinline__ unsigned xb_xcc_id() { return (unsigned)__builtin_amdgcn_s_getreg((3 << 11) | 20) & 0xFu; }
#define XB_SPIN(cond, bar) do { unsigned _sp = 0; while (cond) { __builtin_amdgcn_s_sleep(1); \
    if ((++_sp & 255u) == 0u) { if (xb_ld(&(bar)[XB_TMO])) break; if (_sp > XB_SPIN_CAP) { atomicAdd(&(bar)[XB_TMO], 1u); break; } } } } while (0)
struct XcdBarrier { unsigned* bar; unsigned x; volatile LAS unsigned* st; };
__device__ __forceinline__ XcdBarrier xcd_barrier_post(unsigned* bar, volatile LAS unsigned* st) {
    XcdBarrier b; b.bar = bar; b.x = xb_xcc_id(); b.st = st;
    if (threadIdx.x == 0) (void)xb_add(&bar[XB_XCNT(b.x)], 1u);
    return b;
}
__device__ __forceinline__ void xcd_barrier_complete(unsigned* bar, unsigned x, unsigned& nloc, unsigned& nx) {
    const unsigned G = gridDim.x * gridDim.y * gridDim.z;
    unsigned sum, cnt, mine, sp = 0u;
    for (;;) {
        sum = 0u; cnt = 0u; mine = 0u;
#pragma unroll
        for (unsigned j = 0; j < 16; ++j) { const unsigned c = xb_ld(&bar[XB_XCNT(j)]); sum += c; cnt += (c > 0u) ? 1u : 0u; mine = (j == x) ? c : mine; }
        if (sum == G) break;
        __builtin_amdgcn_s_sleep(1);
        if ((++sp & 255u) == 0u) { if (xb_ld(&bar[XB_TMO])) break; if (sp > XB_SPIN_CAP) { atomicAdd(&bar[XB_TMO], 1u); break; } }
    }
    nloc = mine > 0u ? mine : 1u; nx = cnt > 0u ? cnt : 1u;
}
__device__ __forceinline__ void xcd_barrier(const XcdBarrier& b) {
    asm volatile("s_waitcnt vmcnt(0)" ::: "memory");
    __syncthreads();
    if (threadIdx.x == 0) {
        unsigned* bar = b.bar;
        __builtin_amdgcn_s_waitcnt(0);
        unsigned nloc = b.st[0], nx = b.st[1];
        if (nloc == 0u) { xcd_barrier_complete(bar, b.x, nloc, nx); b.st[0] = nloc; b.st[1] = nx; }
        const unsigned old = xb_add(&bar[XB_XSUB(b.x)], 1u);
        const unsigned gen = old / nloc;
        if (old + 1u == (gen + 1u) * nloc) {
            __builtin_amdgcn_fence(__ATOMIC_RELEASE, "agent");
            asm volatile("s_waitcnt vmcnt(0)" ::: "memory");
            const unsigned og = xb_add(&bar[XB_TOP], 1u);
            const unsigned tg = og / nx;
            if (og + 1u == (tg + 1u) * nx) xb_add(&bar[XB_TOPGEN], 1u);
            else XB_SPIN(xb_ld(&bar[XB_TOPGEN]) == tg, bar);
            __builtin_amdgcn_fence(__ATOMIC_ACQUIRE, "agent");
            xb_add(&bar[XB_XGEN(b.x)], 1u);
            asm volatile("s_waitcnt vmcnt(0)" ::: "memory");
        } else {
            XB_SPIN(xb_ld(&bar[XB_XGEN(b.x)]) == gen, bar);
            __builtin_amdgcn_fence(__ATOMIC_ACQUIRE, "agent");
            asm volatile("s_waitcnt vmcnt(0)" ::: "memory");
        }
    }
    __syncthreads();
}

struct Args {
    const float* in[22]; float* out; unsigned char* ws; int ph_lo, ph_hi;
};
struct Frame {
    LAS unsigned char* lds; int tid, lane, wave, G, bid;
    unsigned char* ws;
};
#define LDS_WAIT() asm volatile("s_waitcnt lgkmcnt(0)" ::: "memory")
#define VM_WAIT() asm volatile("s_waitcnt vmcnt(0)" ::: "memory")

__device__ __forceinline__ void p0_transpose_item(const float* W, int Kdim, int N, bf16_t* WT, int dst_row0, int k0, int n0, LAS float* scr, int lane) {
    float tv[32];
#pragma unroll
    for (int i = 0; i < 32; ++i) tv[i] = __builtin_nontemporal_load(W + (size_t)(k0 + 2 * i + (lane >> 5)) * N + n0 + (lane & 31));
#pragma unroll
    for (int i = 0; i < 32; ++i) scr[(2 * i + (lane >> 5)) * 33 + (lane & 31)] = tv[i];
    LDS_WAIT(); asm volatile("" ::: "memory");
    const int c = lane & 7;
#pragma unroll
    for (int j = 0; j < 4; ++j) { const int n = (lane >> 3) + 8 * j; const LAS float* s = scr + (8 * c) * 33 + n;
        u32x4 o; o.x = pk2(s[0 * 33], s[1 * 33]); o.y = pk2(s[2 * 33], s[3 * 33]); o.z = pk2(s[4 * 33], s[5 * 33]); o.w = pk2(s[6 * 33], s[7 * 33]);
        *(u32x4*)(WT + (size_t)(dst_row0 + n) * Kdim + k0 + 8 * c) = o; }
    LDS_WAIT(); asm volatile("" ::: "memory");
}
__device__ __forceinline__ void p0_transpose_item8(const float* W, int Kdim, int N, unsigned char* WT, int dst_row0, int k0, int n0, LAS float* scr, int lane) {
    float tv[64];
#pragma unroll
    for (int i = 0; i < 64; ++i) tv[i] = __builtin_nontemporal_load(W + (size_t)(k0 + 2 * i + (lane >> 5)) * N + n0 + (lane & 31));
#pragma unroll
    for (int i = 0; i < 64; ++i) scr[(2 * i + (lane >> 5)) * 33 + (lane & 31)] = tv[i];
    LDS_WAIT(); asm volatile("" ::: "memory");
#pragma unroll
    for (int j = 0; j < 4; ++j) { const int id = lane + 64 * j, n = id >> 3, c = id & 7; const LAS float* s = scr + (16 * c) * 33 + n;
        int w[4];
#pragma unroll
        for (int q = 0; q < 4; ++q) { int t = __builtin_amdgcn_cvt_pk_fp8_f32(s[(4 * q) * 33] * W8_MUL, s[(4 * q + 1) * 33] * W8_MUL, 0, false); w[q] = __builtin_amdgcn_cvt_pk_fp8_f32(s[(4 * q + 2) * 33] * W8_MUL, s[(4 * q + 3) * 33] * W8_MUL, t, true); }
        *(u32x4*)(WT + (size_t)(dst_row0 + n) * Kdim + k0 + 16 * c) = (u32x4){(unsigned)w[0], (unsigned)w[1], (unsigned)w[2], (unsigned)w[3]}; }
    LDS_WAIT(); asm volatile("" ::: "memory");
}
__device__ __forceinline__ void p0_convert(const float* src, bf16_t* dst, size_t n8, size_t i0, size_t stride) {
    for (size_t i = i0; i < n8; i += 4 * stride) {
        f32x4 a[4], b[4];
#pragma unroll
        for (int j = 0; j < 4; ++j) { const size_t k = i + j * stride; if (k < n8) { a[j] = __builtin_nontemporal_load((const f32x4*)src + 2 * k); b[j] = __builtin_nontemporal_load((const f32x4*)src + 2 * k + 1); } }
#pragma unroll
        for (int j = 0; j < 4; ++j) { const size_t k = i + j * stride; if (k < n8) { u32x4 o; o.x = pk2(a[j][0], a[j][1]); o.y = pk2(a[j][2], a[j][3]); o.z = pk2(b[j][0], b[j][1]); o.w = pk2(b[j][2], b[j][3]); ((u32x4*)dst)[k] = o; } }
    }
}
__device__ __forceinline__ void phase_prep(const Frame& F, const Args& a) {
    LAS float* scr = (LAS float*)(F.lds + F.wave * 17408);
    const int gw = F.bid * NWAVES + F.wave, NGW = F.G * NWAVES;
    const float *w_in = a.in[2], *w_mix = a.in[6], *w_q = a.in[9], *w_kv = a.in[10], *w_o = a.in[11], *w_r = a.in[14], *w_gu = a.in[16], *w_d = a.in[18];
    bf16_t *WIN = (bf16_t*)(F.ws + WS_WIN), *WMIX = (bf16_t*)(F.ws + WS_WMIX), *WQN = (bf16_t*)(F.ws + WS_WQN), *WKV = (bf16_t*)(F.ws + WS_WKV), *WO = (bf16_t*)(F.ws + WS_WO),
           *WR = (bf16_t*)(F.ws + WS_WR); unsigned char *WGU = F.ws + WS_WGU, *WD = F.ws + WS_WD;
    constexpr int I_IN = 32 * (DIN / 32), I_MIX = 32 * 64, I_KV = 32 * 128, I_O = 32 * 64, I_R = 32, I_GU = 16 * 128, I_D = 16 * 64;
    constexpr int NITEMS = I_IN + I_MIX + I_KV + I_O + I_R + NEXP * I_GU + NEXP * I_D;
    for (int it = gw; it < NITEMS; it += NGW) {
        int r = it;
        if (r < I_IN) { const int nblk = DIN / 32, kb = r / nblk, nb = r % nblk; p0_transpose_item(w_in, 2048, DIN, WIN, nb * 32, kb * 64, nb * 32, scr, F.lane); continue; } r -= I_IN;
        if (r < I_MIX) { const int kb = r / 64, nb = r % 64; p0_transpose_item(w_mix, 2048, 2048, WMIX, nb * 32, kb * 64, nb * 32, scr, F.lane); continue; } r -= I_MIX;
        if (r < I_KV) { const int kb = r / 128, nb = r % 128; p0_transpose_item(w_kv, 2048, 4096, WKV, nb * 32, kb * 64, nb * 32, scr, F.lane); continue; } r -= I_KV;
        if (r < I_O) { const int kb = r / 64, nb = r % 64; p0_transpose_item(w_o, 2048, 2048, WO, nb * 32, kb * 64, nb * 32, scr, F.lane); continue; } r -= I_O;
        if (r < I_R) { p0_transpose_item(w_r, 2048, 32, WR, 0, r * 64, 0, scr, F.lane); continue; } r -= I_R;
        if (r < NEXP * I_GU) { const int e = r / I_GU, q = r % I_GU, kb = q / 128, nb = q % 128, n0 = nb * 32;
            const int dst = (n0 < 2048) ? ((n0 >> 7) * 256 + (n0 & 127)) : (((n0 - 2048) >> 7) * 256 + 128 + ((n0 - 2048) & 127));
            p0_transpose_item8(w_gu + (size_t)e * 2048 * 4096, 2048, 4096, WGU + (size_t)e * 4096 * 2048, dst, kb * 128, n0, scr, F.lane); continue; } r -= NEXP * I_GU;
        { const int e = r / I_D, q = r % I_D, kb = q / 64, nb = q % 64; p0_transpose_item8(w_d + (size_t)e * 2048 * 2048, 2048, 2048, WD + (size_t)e * 2048 * 2048, nb * 32, kb * 128, nb * 32, scr, F.lane); }
    }
    const size_t gt = (size_t)F.bid * NTHR + F.tid, NGT = (size_t)F.G * NTHR;
    p0_convert(w_q, WQN, (size_t)2048 * 2048 / 8, gt, NGT);
    p0_convert(a.in[0], (bf16_t*)(F.ws + WS_XB), (size_t)T * D / 8, gt, NGT);
    p0_convert(a.in[1], (bf16_t*)(F.ws + WS_MEMB), (size_t)512 * 2048 / 8, gt, NGT);
    for (size_t i = gt; i < (size_t)224 * 2048 / 8; i += NGT) ((u32x4*)(WR + 32 * 2048))[i] = (u32x4){0u, 0u, 0u, 0u};
}

constexpr int SWA_KRS = 144;
constexpr int SWA_PRS = 336;
constexpr int SWA_K_OFF = 0, SWA_V_OFF = 256 * SWA_KRS, SWA_P_OFF = 2 * 256 * SWA_KRS, SWA_SSQ_OFF = SWA_P_OFF + 8 * 16 * SWA_PRS;
static_assert(SWA_SSQ_OFF + 512 <= RING_BYTES, "swa lds");
__device__ __forceinline__ void swa_item(const Frame& F, const bf16_t* proj, bf16_t* y, const float* sinks, const float* normw, int b, int n) {
    LAS unsigned char* Kl = F.lds + SWA_K_OFF; LAS unsigned char* Vl = F.lds + SWA_V_OFF; LAS unsigned char* Pl = F.lds + SWA_P_OFF + F.wave * 16 * SWA_PRS;
    LAS float* ssq = (LAS float*)(F.lds + SWA_SSQ_OFF);
    const int lane = F.lane, fr = lane & 15, g = lane >> 4, q4 = (lane & 15) >> 2, p4 = lane & 3;
    const size_t tok0 = (size_t)b * SEQ + (size_t)n * 128;
    if (F.tid < 128) ssq[F.tid] = 0.f;
    for (int h = 0; h < 2; ++h) {
        __syncthreads();
#pragma unroll
        for (int i = 0; i < 4; ++i) { const int id = F.tid + 512 * i, key = id >> 3, c = id & 7;
            u32x4 kv = (u32x4){0u, 0u, 0u, 0u}, vv = kv;
            if (n > 0 || key >= 128) { const bf16_t* src = proj + (tok0 - 128 + key) * DIN + h * 64 + c * 8; kv = *(const u32x4*)(src + OFF_KA); vv = *(const u32x4*)(src + OFF_VA); }
            *(LAS u32x4*)(Kl + key * SWA_KRS + c * 16) = kv; *(LAS u32x4*)(Vl + key * SWA_KRS + c * 16) = vv; }
        __syncthreads();
        const int hq = h * 8 + F.wave;
        const float slope = exp2f(-0.5f * (float)(hq + 1)), sink = sinks[hq];
        for (int rt = 0; rt < 8; ++rt) {
            const int i0 = rt * 16, kt0 = rt < 6 ? rt : 6;
            bf16x8 qf[2];
#pragma unroll
            for (int ks = 0; ks < 2; ++ks) qf[ks] = *(const bf16x8*)(proj + (tok0 + i0 + fr) * DIN + OFF_QA + hq * 64 + ks * 32 + 8 * g);
            f32x4 s[10];
#pragma unroll
            for (int tt = 0; tt < 10; ++tt) { f32x4 acc = (f32x4){0.f, 0.f, 0.f, 0.f};
#pragma unroll
                for (int ks = 0; ks < 2; ++ks) { const bf16x8 kf = *(const LAS bf16x8*)(Kl + ((kt0 + tt) * 16 + fr) * SWA_KRS + (ks * 32 + 8 * g) * 2); acc = mfma16(qf[ks], kf, acc); }
                s[tt] = acc; }
            float mx[4] = {-1e30f, -1e30f, -1e30f, -1e30f};
#pragma unroll
            for (int tt = 0; tt < 10; ++tt)
#pragma unroll
                for (int r = 0; r < 4; ++r) { const int i = i0 + 4 * g + r, j = (kt0 + tt) * 16 + fr, dist = i + 128 - j;
                    const bool valid = dist >= 0 && dist < 128 && (n > 0 || j >= 128);
                    const float v = valid ? s[tt][r] * 0.125f - slope * (float)dist : -1e30f; s[tt][r] = v; mx[r] = fmaxf(mx[r], v); }
            float l[4];
#pragma unroll
            for (int r = 0; r < 4; ++r) { mx[r] = fmaxf(grp16_max(mx[r]), sink); l[r] = 0.f; }
#pragma unroll
            for (int tt = 0; tt < 10; ++tt)
#pragma unroll
                for (int r = 0; r < 4; ++r) { const float p = __expf(s[tt][r] - mx[r]); l[r] += p; *(LAS bf16_t*)(Pl + (4 * g + r) * SWA_PRS + (tt * 16 + fr) * 2) = (bf16_t)f2bf(p); }
#pragma unroll
            for (int r = 0; r < 4; ++r) l[r] = grp16_sum(l[r]) + __expf(sink - mx[r]);
            f32x4 o[4];
#pragma unroll
            for (int dt = 0; dt < 4; ++dt) o[dt] = (f32x4){0.f, 0.f, 0.f, 0.f};
#pragma unroll
            for (int kk = 0; kk < 5; ++kk) { const bf16x8 pf = *(const LAS bf16x8*)(Pl + fr * SWA_PRS + (kk * 32 + 8 * g) * 2);
#pragma unroll
                for (int dt = 0; dt < 4; ++dt) { const bf16x8 vf = tr_frag(Vl + (kt0 * 16 + kk * 32 + 8 * g + q4) * SWA_KRS + (dt * 16 + 4 * p4) * 2, 4 * SWA_KRS); o[dt] = mfma16(pf, vf, o[dt]); } }
            float sq[4] = {0.f, 0.f, 0.f, 0.f};
#pragma unroll
            for (int r = 0; r < 4; ++r) { const float il = 1.0f / l[r];
#pragma unroll
                for (int dt = 0; dt < 4; ++dt) { const float v = o[dt][r] * il; sq[r] += v * v; y[(tok0 + i0 + 4 * g + r) * 2048 + hq * 64 + dt * 16 + fr] = (bf16_t)f2bf(v); } }
#pragma unroll
            for (int r = 0; r < 4; ++r) { const float t = grp16_sum(sq[r]); if (fr == 0) atomicAdd((float*)&ssq[i0 + 4 * g + r], t); }
        }
    }
    VM_WAIT(); __syncthreads();
    for (int id = F.tid; id < 128 * 128; id += NTHR) { const int tk = id >> 7, c = id & 127; const float rs = 1.0f / sqrtf(ssq[tk] * (1.0f / 1024.0f) + LN_EPS);
        bf16_t* p = y + (tok0 + tk) * 2048 + c * 8; const u32x4 v = *(const u32x4*)p; const f32x4 w0 = *(const f32x4*)(normw + c * 8), w1 = *(const f32x4*)(normw + c * 8 + 4);
        u32x4 o; o.x = pk2(bf2f(v.x & 0xffffu) * rs * w0[0], bf2f(v.x >> 16) * rs * w0[1]); o.y = pk2(bf2f(v.y & 0xffffu) * rs * w0[2], bf2f(v.y >> 16) * rs * w0[3]);
        o.z = pk2(bf2f(v.z & 0xffffu) * rs * w1[0], bf2f(v.z >> 16) * rs * w1[1]); o.w = pk2(bf2f(v.w & 0xffffu) * rs * w1[2], bf2f(v.w >> 16) * rs * w1[3]);
        *(u32x4*)p = o; }
    __syncthreads();
}

constexpr int RET_RS = 272;
constexpr int RET_TILE = 128 * RET_RS;
__device__ __forceinline__ float ret_log2g(int h) { return log2f(1.0f - exp2f(-5.0f - (float)h)); }
__device__ __forceinline__ void ret_u_item(const Frame& F, const bf16_t* proj, float* Ut, int b, int c, int h) {
    LAS unsigned char* Kl = F.lds; LAS unsigned char* Vl = F.lds + RET_TILE;
    const int lane = F.lane, fr = lane & 15, g = lane >> 4, q4 = (lane & 15) >> 2, p4 = lane & 3, w = F.wave;
    const size_t tok0 = (size_t)b * SEQ + (size_t)c * 128; const float l2g = ret_log2g(h);
    __syncthreads();
#pragma unroll
    for (int i = 0; i < 4; ++i) { const int id = F.tid + 512 * i, key = id >> 4, ch = id & 15;
        const bf16_t* src = proj + (tok0 + key) * DIN + h * 128 + ch * 8; const u32x4 kv = *(const u32x4*)(src + OFF_KR), vv = *(const u32x4*)(src + OFF_VR);
        const float wk = exp2f(l2g * (float)(127 - key)) * 0.08838834764831845f;
        u32x4 ks; ks.x = pk2(bf2f(kv.x & 0xffffu) * wk, bf2f(kv.x >> 16) * wk); ks.y = pk2(bf2f(kv.y & 0xffffu) * wk, bf2f(kv.y >> 16) * wk);
        ks.z = pk2(bf2f(kv.z & 0xffffu) * wk, bf2f(kv.z >> 16) * wk); ks.w = pk2(bf2f(kv.w & 0xffffu) * wk, bf2f(kv.w >> 16) * wk);
        *(LAS u32x4*)(Kl + key * RET_RS + ch * 16) = ks; *(LAS u32x4*)(Vl + key * RET_RS + ch * 16) = vv; }
    __syncthreads();
    f32x4 acc[8];
#pragma unroll
    for (int et = 0; et < 8; ++et) acc[et] = (f32x4){0.f, 0.f, 0.f, 0.f};
#pragma unroll
    for (int kk = 0; kk < 4; ++kk) { const bf16x8 af = tr_frag(Kl + (kk * 32 + 8 * g + q4) * RET_RS + (w * 16 + 4 * p4) * 2, 4 * RET_RS);
#pragma unroll
        for (int et = 0; et < 8; ++et) { const bf16x8 bf = tr_frag(Vl + (kk * 32 + 8 * g + q4) * RET_RS + (et * 16 + 4 * p4) * 2, 4 * RET_RS); acc[et] = mfma16(af, bf, acc[et]); } }
    float* dst = Ut + (((size_t)b * NCH + c) * 8 + h) * 16384;
#pragma unroll
    for (int et = 0; et < 8; ++et) *(f32x4*)(dst + (et * 16 + fr) * 128 + w * 16 + 4 * g) = acc[et];
}
__device__ __forceinline__ void phase_scan(const Frame& F, const float* Ut, bf16_t* Rt) {
    const int gt = F.bid * NTHR + F.tid;
    for (int e2 = gt; e2 < 2 * 8 * 8192; e2 += F.G * NTHR) {
        const int b = e2 >> 16, h = (e2 >> 13) & 7, ed = (e2 & 8191) * 2;
        const float gC = exp2f(ret_log2g(h) * 128.0f);
        const float* up = Ut + ((size_t)b * NCH * 8 + h) * 16384 + ed; bf16_t* rp = Rt + ((size_t)b * NCH * 8 + h) * 16384 + ed;
        f32x2 st = (f32x2){0.f, 0.f};
        for (int c0 = 0; c0 < NCH; c0 += 8) {
            f32x2 u[8];
#pragma unroll
            for (int j = 0; j < 8; ++j) u[j] = *(const f32x2*)(up + (size_t)(c0 + j) * 8 * 16384);
#pragma unroll
            for (int j = 0; j < 8; ++j) { *(unsigned*)(rp + (size_t)(c0 + j) * 8 * 16384) = pk2(st.x, st.y); st = st * gC + u[j]; }
        }
    }
}
__device__ __forceinline__ void ret_o_item(const Frame& F, const bf16_t* proj, const bf16_t* Rt, bf16_t* y, const float* normw, int b, int c, int h) {
    LAS unsigned char* Kl = F.lds; LAS unsigned char* Vl = F.lds + RET_TILE; LAS unsigned char* Rl = F.lds + 2 * RET_TILE; LAS unsigned char* Sl = F.lds + 3 * RET_TILE + F.wave * 16 * RET_RS;
    const int lane = F.lane, fr = lane & 15, g = lane >> 4, q4 = (lane & 15) >> 2, p4 = lane & 3, w = F.wave;
    const size_t tok0 = (size_t)b * SEQ + (size_t)c * 128; const float l2g = ret_log2g(h);
    const bf16_t* rsrc = Rt + (((size_t)b * NCH + c) * 8 + h) * 16384;
    __syncthreads();
#pragma unroll
    for (int i = 0; i < 4; ++i) { const int id = F.tid + 512 * i, key = id >> 4, ch = id & 15;
        const bf16_t* src = proj + (tok0 + key) * DIN + h * 128 + ch * 8;
        *(LAS u32x4*)(Kl + key * RET_RS + ch * 16) = *(const u32x4*)(src + OFF_KR); *(LAS u32x4*)(Vl + key * RET_RS + ch * 16) = *(const u32x4*)(src + OFF_VR);
        *(LAS u32x4*)(Rl + key * RET_RS + ch * 16) = *(const u32x4*)(rsrc + key * 128 + ch * 8); }
    bf16x8 qf[4];
#pragma unroll
    for (int kk = 0; kk < 4; ++kk) qf[kk] = *(const bf16x8*)(proj + (tok0 + w * 16 + fr) * DIN + OFF_QR + h * 128 + kk * 32 + 8 * g);
    __syncthreads();
#pragma unroll
    for (int kt = 0; kt < 8; ++kt) {
        f32x4 acc = (f32x4){0.f, 0.f, 0.f, 0.f};
        if (kt <= w) {
#pragma unroll
            for (int kk = 0; kk < 4; ++kk) { const bf16x8 kf = *(const LAS bf16x8*)(Kl + (kt * 16 + fr) * RET_RS + (kk * 32 + 8 * g) * 2); acc = mfma16(qf[kk], kf, acc); }
        }
#pragma unroll
        for (int r = 0; r < 4; ++r) { const int qi = w * 16 + 4 * g + r, kj = kt * 16 + fr, df = qi - kj;
            const float v = df >= 0 ? acc[r] * 0.08838834764831845f * exp2f(l2g * (float)df) : 0.f;
            *(LAS bf16_t*)(Sl + (4 * g + r) * RET_RS + kj * 2) = (bf16_t)f2bf(v); }
    }
    f32x4 oi[8], oc[8];
#pragma unroll
    for (int et = 0; et < 8; ++et) { oi[et] = (f32x4){0.f, 0.f, 0.f, 0.f}; oc[et] = (f32x4){0.f, 0.f, 0.f, 0.f}; }
#pragma unroll
    for (int kk = 0; kk < 4; ++kk) {
        if (2 * kk <= w) { const bf16x8 sf = *(const LAS bf16x8*)(Sl + fr * RET_RS + (kk * 32 + 8 * g) * 2);
#pragma unroll
            for (int et = 0; et < 8; ++et) { const bf16x8 vf = tr_frag(Vl + (kk * 32 + 8 * g + q4) * RET_RS + (et * 16 + 4 * p4) * 2, 4 * RET_RS); oi[et] = mfma16(sf, vf, oi[et]); } }
#pragma unroll
        for (int et = 0; et < 8; ++et) { const bf16x8 rf = *(const LAS bf16x8*)(Rl + (et * 16 + fr) * RET_RS + (kk * 32 + 8 * g) * 2); oc[et] = mfma16(qf[kk], rf, oc[et]); }
    }
#pragma unroll
    for (int r = 0; r < 4; ++r) { const int qi = w * 16 + 4 * g + r; const float wq = exp2f(l2g * (float)(qi + 1));
        float v[8], s = 0.f;
#pragma unroll
        for (int et = 0; et < 8; ++et) { v[et] = oi[et][r] + wq * oc[et][r]; s += v[et]; }
        const float mu = grp16_sum(s) * (1.0f / 128.0f); float qv = 0.f;
#pragma unroll
        for (int et = 0; et < 8; ++et) { v[et] -= mu; qv += v[et] * v[et]; }
        const float rstd = 1.0f / sqrtf(grp16_sum(qv) * (1.0f / 128.0f) + LN_EPS);
        const bf16_t* gp = proj + (tok0 + qi) * DIN + OFF_GR + h * 128; bf16_t* yp = y + (tok0 + qi) * 2048 + 1024 + h * 128;
#pragma unroll
        for (int et = 0; et < 8; ++et) { const int e = et * 16 + fr; const float gt = bf2f(gp[e]); const float sw = gt * __builtin_amdgcn_rcpf(1.0f + __expf(-gt));
            yp[e] = (bf16_t)f2bf(v[et] * rstd * normw[h * 128 + e] * sw); }
    }
}

__device__ __forceinline__ void phase_ln(const Frame& F, const bf16_t* z, const float* w, const float* bb, bf16_t* xb, unsigned char* xq) {
    const int gw = F.bid * NWAVES + F.wave, NGW = F.G * NWAVES;
    for (int m = gw; m < T; m += NGW) {
        const u32x4* zr = (const u32x4*)(z + (size_t)m * D) + F.lane; float v[4][8]; float s = 0.f;
#pragma unroll
        for (int j = 0; j < 4; ++j) { const u32x4 p = zr[64 * j]; v[j][0] = bf2f(p.x & 0xffffu); v[j][1] = bf2f(p.x >> 16); v[j][2] = bf2f(p.y & 0xffffu); v[j][3] = bf2f(p.y >> 16);
            v[j][4] = bf2f(p.z & 0xffffu); v[j][5] = bf2f(p.z >> 16); v[j][6] = bf2f(p.w & 0xffffu); v[j][7] = bf2f(p.w >> 16);
#pragma unroll
            for (int i = 0; i < 8; ++i) s += v[j][i]; }
        const float mean = wave_sum(s) * (1.0f / D); float q = 0.f;
#pragma unroll
        for (int j = 0; j < 4; ++j)
#pragma unroll
            for (int i = 0; i < 8; ++i) { v[j][i] -= mean; q += v[j][i] * v[j][i]; }
        const float rstd = 1.0f / sqrtf(wave_sum(q) * (1.0f / D) + LN_EPS);
#pragma unroll
        for (int j = 0; j < 4; ++j) { const int c0 = 8 * (F.lane + 64 * j); const f32x4 w0 = *(const f32x4*)(w + c0), w1 = *(const f32x4*)(w + c0 + 4), b0 = *(const f32x4*)(bb + c0), b1 = *(const f32x4*)(bb + c0 + 4);
            float o[8];
#pragma unroll
            for (int i = 0; i < 4; ++i) { o[i] = v[j][i] * rstd * w0[i] + b0[i]; o[4 + i] = v[j][4 + i] * rstd * w1[i] + b1[i]; }
            u32x4 p; p.x = pk2(o[0], o[1]); p.y = pk2(o[2], o[3]); p.z = pk2(o[4], o[5]); p.w = pk2(o[6], o[7]); ((u32x4*)(xb + (size_t)m * D))[F.lane + 64 * j] = p;
            if (xq) { int t0 = __builtin_amdgcn_cvt_pk_fp8_f32(o[0], o[1], 0, false); t0 = __builtin_amdgcn_cvt_pk_fp8_f32(o[2], o[3], t0, true);
                int t1 = __builtin_amdgcn_cvt_pk_fp8_f32(o[4], o[5], 0, false); t1 = __builtin_amdgcn_cvt_pk_fp8_f32(o[6], o[7], t1, true); ((u32x2*)(xq + (size_t)m * D))[F.lane + 64 * j] = (u32x2){(unsigned)t0, (unsigned)t1}; } }
    }
}
__device__ __forceinline__ void phase_softmax(const Frame& F, bf16_t* sp) {
    const int gw = F.bid * NWAVES + F.wave, NGW = F.G * NWAVES;
    for (int m = gw; m < T; m += NGW) {
#pragma unroll
        for (int h = 0; h < 4; ++h) { u32x2* p = (u32x2*)(sp + (size_t)m * 1024 + h * 256) + F.lane; const u32x2 v = *p;
            float a0 = bf2f(v.x & 0xffffu), a1 = bf2f(v.x >> 16), a2 = bf2f(v.y & 0xffffu), a3 = bf2f(v.y >> 16);
            const float mx = wave_max(fmaxf(fmaxf(a0, a1), fmaxf(a2, a3)));
            a0 = __expf(a0 - mx); a1 = __expf(a1 - mx); a2 = __expf(a2 - mx); a3 = __expf(a3 - mx);
            const float il = 1.0f / wave_sum((a0 + a1) + (a2 + a3));
            u32x2 o; o.x = pk2(a0 * il, a1 * il); o.y = pk2(a2 * il, a3 * il); *p = o; }
    }
}
__device__ __forceinline__ void phase_route1(const Frame& F, const float* logits, int* tok_e, int* tok_p, float* gates, int* slot_tok, unsigned* gcnt) {
    LAS float* lg = (LAS float*)F.lds;
    LAS int* lcnt = (LAS int*)(F.lds + 128 * 33 * 4); LAS int* lbase = lcnt + 32;
    for (int i = F.bid * NTHR + F.tid; i < NSLOT; i += F.G * NTHR) slot_tok[i] = 0;
    for (int t0 = F.bid * 128; t0 < T; t0 += F.G * 128) {
        __syncthreads();
        for (int i = F.tid; i < 128 * 32; i += NTHR) lg[(i >> 5) * 33 + (i & 31)] = logits[(size_t)t0 * 32 + i] + logits[(size_t)T * 32 + (size_t)t0 * 32 + i];
        if (F.tid < 32) lcnt[F.tid] = 0;
        __syncthreads();
        int id[4] = {0, 0, 0, 0}, lp[4] = {0, 0, 0, 0}; float v[4] = {0.f, 0.f, 0.f, 0.f};
        if (F.tid < 128) {
            unsigned used = 0u;
#pragma unroll
            for (int k = 0; k < 4; ++k) { float best = -3.0e38f; int bi = 0;
                for (int e = 0; e < 32; ++e) { const float x = lg[F.tid * 33 + e]; if (!((used >> e) & 1u) && x > best) { best = x; bi = e; } }
                used |= 1u << bi; v[k] = best; id[k] = bi; }
            float ex[4], sum = 0.f;
#pragma unroll
            for (int k = 0; k < 4; ++k) { ex[k] = __expf(v[k] - v[0]); sum += ex[k]; }
#pragma unroll
            for (int k = 0; k < 4; ++k) { gates[(size_t)(t0 + F.tid) * 4 + k] = ex[k] / sum; lp[k] = atomicAdd((int*)&lcnt[id[k]], 1); }
        }
        __syncthreads();
        if (F.tid < 32) lbase[F.tid] = (int)__hip_atomic_fetch_add(gcnt + F.tid, (unsigned)lcnt[F.tid], __ATOMIC_RELAXED, __HIP_MEMORY_SCOPE_AGENT);
        __syncthreads();
        if (F.tid < 128) {
#pragma unroll
            for (int k = 0; k < 4; ++k) { tok_e[(size_t)(t0 + F.tid) * 4 + k] = id[k]; tok_p[(size_t)(t0 + F.tid) * 4 + k] = lbase[id[k]] + lp[k]; }
        }
    }
}
__device__ __forceinline__ void moe_tables(const Frame& F, unsigned* gcnt, LAS int* pstart, LAS int* blkexp) {
    __syncthreads();
    if (F.tid == 0) { int acc = 0; for (int e = 0; e < 32; ++e) { pstart[e] = acc; const int cnt = (int)__hip_atomic_load(gcnt + e, __ATOMIC_RELAXED, __HIP_MEMORY_SCOPE_AGENT); acc += ((cnt + 255) >> 8) << 8; } pstart[32] = acc; }
    __syncthreads();
    for (int j = F.tid; j < NBLK_MAX; j += NTHR) { int e = 0; for (int k = 1; k < 32; ++k) if (pstart[k] <= j * 256) e = k; blkexp[j] = e; }
    __syncthreads();
}
__device__ __forceinline__ void phase_route2(const Frame& F, const int* tok_e, const int* tok_p, int* inv, int* slot_tok, unsigned* gcnt) {
    LAS int* pstart = (LAS int*)(F.lds + TAB_OFF); LAS int* blkexp = pstart + 64;
    moe_tables(F, gcnt, pstart, blkexp);
    for (int i = F.bid * NTHR + F.tid; i < T * 4; i += F.G * NTHR) { const int e = tok_e[i], dest = pstart[e] + tok_p[i]; inv[i] = dest; slot_tok[dest] = i >> 2; }
}
__device__ __forceinline__ void phase_final(const Frame& F, const bf16_t* x2b, const bf16_t* ys, const int* inv, const float* gates, const float* w, const float* bb, float* out) {
    const int gw = F.bid * NWAVES + F.wave, NGW = F.G * NWAVES;
    for (int m = gw; m < T; m += NGW) {
        const u32x2* xr = (const u32x2*)(x2b + (size_t)m * D) + F.lane; f32x4 v[8];
#pragma unroll
        for (int j = 0; j < 8; ++j) { const u32x2 p = xr[64 * j]; v[j] = (f32x4){bf2f(p.x & 0xffffu), bf2f(p.x >> 16), bf2f(p.y & 0xffffu), bf2f(p.y >> 16)} * DN_ALPHA; }
#pragma unroll
        for (int k = 0; k < 4; ++k) { const int s = inv[(size_t)m * 4 + k]; const float gk = gates[(size_t)m * 4 + k]; const u32x2* yr = (const u32x2*)(ys + (size_t)s * D) + F.lane;
#pragma unroll
            for (int j = 0; j < 8; ++j) { const u32x2 p = yr[64 * j]; v[j][0] += gk * bf2f(p.x & 0xffffu); v[j][1] += gk * bf2f(p.x >> 16); v[j][2] += gk * bf2f(p.y & 0xffffu); v[j][3] += gk * bf2f(p.y >> 16); } }
        float s = 0.f;
#pragma unroll
        for (int j = 0; j < 8; ++j) s += (v[j][0] + v[j][1]) + (v[j][2] + v[j][3]);
        const float mean = wave_sum(s) * (1.0f / D); float q = 0.f;
#pragma unroll
        for (int j = 0; j < 8; ++j) { v[j] = v[j] - mean; q += (v[j][0] * v[j][0] + v[j][1] * v[j][1]) + (v[j][2] * v[j][2] + v[j][3] * v[j][3]); }
        const float rstd = 1.0f / sqrtf(wave_sum(q) * (1.0f / D) + LN_EPS);
#pragma unroll
        for (int j = 0; j < 8; ++j) { const f32x4 ww = ((const f32x4*)w)[F.lane + 64 * j], b4 = ((const f32x4*)bb)[F.lane + 64 * j]; ((f32x4*)(out + (size_t)m * D))[F.lane + 64 * j] = v[j] * rstd * ww + b4; }
    }
}

constexpr int NPHASE = 17;
__global__ void __launch_bounds__(NTHR, 2) fwd_kernel(Args args) {
    extern __shared__ __attribute__((aligned(16))) unsigned char lds_raw[];
    Frame F; F.lds = (LAS unsigned char*)lds_raw; F.tid = threadIdx.x; F.lane = F.tid & 63; F.wave = __builtin_amdgcn_readfirstlane(F.tid >> 6); F.G = gridDim.x; F.bid = blockIdx.x; F.ws = args.ws;
    unsigned* ctl = (unsigned*)(args.ws + WS_CTL);
    volatile LAS unsigned* MISC = (volatile LAS unsigned*)(F.lds + MISC_OFF);
    if (F.tid < 32) MISC[F.tid] = 0u;
    __syncthreads();
    XcdBarrier bar; bar.bar = ctl + CW_BAR; bar.x = 0; bar.st = MISC + 8;
    if (MK_FUSED) bar = xcd_barrier_post(ctl + CW_BAR, MISC + 8);
    const int lo = args.ph_lo, hi = args.ph_hi;
#define IN(k) (lo <= (k) && (k) < hi)
#define DUPK(k) ((DUP_MASK >> (k)) & 1)
#define SEAM(k) do { if (IN(k) && IN((k) + 1)) xcd_barrier(bar); } while (0)
    unsigned char* ws = args.ws;
    bf16_t* xb = (bf16_t*)(ws + WS_XB); bf16_t* proj = (bf16_t*)(ws + WS_PROJ); bf16_t* y = (bf16_t*)(ws + WS_Y); bf16_t* z = (bf16_t*)(ws + WS_Z);
    bf16_t* x1b = (bf16_t*)(ws + WS_X1B); bf16_t* x2b = (bf16_t*)(ws + WS_X2B);
    bf16_t* kv = (bf16_t*)(ws + WS_KV); bf16_t* wqk = (bf16_t*)(ws + WS_WQK); bf16_t* wvo = (bf16_t*)(ws + WS_WVO); bf16_t* sp = (bf16_t*)(ws + WS_SP);
    float* Ut = (float*)(ws + WS_U); bf16_t* Rt = (bf16_t*)(ws + WS_RT);
    float* logits = (float*)(ws + WS_SMALL + SM_LOGITS); int* tok_e = (int*)(ws + WS_SMALL + SM_TOKE); int* tok_p = (int*)(ws + WS_SMALL + SM_TOKP);
    float* gates = (float*)(ws + WS_SMALL + SM_GATE); int* inv = (int*)(ws + WS_SMALL + SM_INV); int* slot_tok = (int*)(ws + WS_SMALL + SM_SLOT);
    unsigned char* act = ws + WS_ACT; bf16_t* ysl = (bf16_t*)(ws + WS_YS); unsigned char* x2q = ws + WS_X2Q;
    unsigned* gcnt = ctl + CW_CNT;
    LAS unsigned char* idxtab = F.lds + IDX_OFF;

    if (IN(0)) { phase_prep(F, args); if (DUPK(0)) { __syncthreads(); phase_prep(F, args); } } SEAM(0);
    if (IN(1)) {
        { pg8::ProbStd P; P.init((const bf16_t*)(ws + WS_MEMB), (const bf16_t*)(ws + WS_WKV), 512, 4096, 2048, 2048, 2048, F.G, (F.bid + 128) % F.G); pg8::EpiBf16 E{kv, 4096, nullptr, 0, 1.0f}; pg8::gemm_phase(F.lds, idxtab, P, E); }
        { pg8::ProbStd P; P.init(xb, (const bf16_t*)(ws + WS_WIN), T, DIN, 2048, 2048, 2048, F.G, F.bid); pg8::EpiBf16 E{proj, DIN, nullptr, 0, 1.0f}; pg8::gemm_phase(F.lds, idxtab, P, E); }
    } SEAM(1);
#define P2_BODY \
        for (int it = F.bid; it < BATCH * NCH; it += F.G) swa_item(F, proj, y, args.in[3], args.in[4], it / NCH, it % NCH); \
        for (int it = F.bid; it < BATCH * NCH * 8; it += F.G) ret_u_item(F, proj, Ut, it / (NCH * 8), (it >> 3) % NCH, it & 7); \
        __syncthreads(); \
        { pg8::ProbFoldA P{kv, (const bf16_t*)(ws + WS_WQN), 512, 4096, 2048, F.G, F.bid}; pg8::EpiBf16 E{wqk, 2048, nullptr, 0, 0.04419417382415922f}; pg8::gemm_phase(F.lds, idxtab, P, E); } \
        { pg8::ProbFoldB P{(const bf16_t*)(ws + WS_WO), kv, 512, 2048, 4096, F.G, (F.bid + 192) % F.G}; pg8::EpiBf16 E{wvo, 1024, nullptr, 0, 1.0f}; pg8::gemm_phase(F.lds, idxtab, P, E); }
    if (IN(2)) { P2_BODY if (DUPK(2)) { __syncthreads(); P2_BODY }
    } SEAM(2);
    if (IN(3)) { phase_scan(F, Ut, Rt); if (DUPK(3)) phase_scan(F, Ut, Rt); } SEAM(3);
    #define P4_BODY { for (int it = F.bid; it < BATCH * NCH * 8; it += F.G) ret_o_item(F, proj, Rt, y, args.in[5], it / (NCH * 8), (it >> 3) % NCH, it & 7); __syncthreads(); }
    if (IN(4)) { P4_BODY if (DUPK(4)) P4_BODY } SEAM(4);
    if (IN(5)) { pg8::ProbStd P; P.init(y, (const bf16_t*)(ws + WS_WMIX), T, 2048, 2048, 2048, 2048, F.G, F.bid); pg8::EpiResBf16 E{xb, z, 2048, DN_ALPHA}; pg8::gemm_phase(F.lds, idxtab, P, E); } SEAM(5);
    if (IN(6)) { phase_ln(F, z, args.in[7], args.in[8], x1b, nullptr); if (DUPK(6)) phase_ln(F, z, args.in[7], args.in[8], x1b, nullptr); } SEAM(6);
    if (IN(7)) { pg8::ProbStd P; P.init(x1b, wqk, T, 1024, 2048, 2048, 2048, F.G, F.bid); P.split_pm = 64; P.b_split_stride = (size_t)1024 * 2048; pg8::EpiBf16 E{sp, 1024, nullptr, 0, 1.0f}; pg8::gemm_phase(F.lds, idxtab, P, E); } SEAM(7);
    if (IN(8)) { phase_softmax(F, sp); } SEAM(8);
    if (IN(9)) { pg8::ProbStd P; P.init(sp, wvo, T, 2048, 1024, 1024, 1024, F.G, F.bid); P.split_pm = 64; P.b_split_stride = (size_t)2048 * 1024; pg8::EpiResBf16 E{x1b, z, 2048, DN_ALPHA}; pg8::gemm_phase(F.lds, idxtab, P, E); } SEAM(9);
    if (IN(10)) { phase_ln(F, z, args.in[12], args.in[13], x2b, x2q); if (DUPK(10)) phase_ln(F, z, args.in[12], args.in[13], x2b, x2q); } SEAM(10);
    if (IN(11)) { pg8::ProbRouter P{x2b, (const bf16_t*)(ws + WS_WR), 1024, 2048, 2048, F.G, F.bid}; pg8::EpiRouter E{logits, args.in[15]}; pg8::gemm_phase(F.lds, idxtab, P, E); } SEAM(11);
    if (IN(12)) { phase_route1(F, logits, tok_e, tok_p, gates, slot_tok, gcnt); } SEAM(12);
    if (IN(13)) { phase_route2(F, tok_e, tok_p, inv, slot_tok, gcnt); } SEAM(13);
    if (IN(14)) {
        LAS int* pstart = (LAS int*)(F.lds + TAB_OFF); LAS int* blkexp = pstart + 64; moe_tables(F, gcnt, pstart, blkexp);
        pg8::ProbMoe<true> P; P.A = x2q; P.W = ws + WS_WGU; P.slot_tok = slot_tok; P.blkexp = blkexp; P.K = 2048; P.lda = 2048; P.ldb = 2048; P.S.init(pstart[32] >> 8, 16, F.G, F.bid);
        pg8::EpiSwiglu E{act, args.in[17]}; pg8::gemm_phase(F.lds, idxtab, P, E);
    } SEAM(14);
    if (IN(15)) {
        LAS int* pstart = (LAS int*)(F.lds + TAB_OFF); LAS int* blkexp = pstart + 64; moe_tables(F, gcnt, pstart, blkexp);
        pg8::ProbMoe<false> P; P.A = act; P.W = ws + WS_WD; P.slot_tok = slot_tok; P.blkexp = blkexp; P.K = 2048; P.lda = 2048; P.ldb = 2048; P.S.init(pstart[32] >> 8, 8, F.G, F.bid);
        pg8::EpiBf16 E{ysl, 2048, args.in[19], 2048, 1.0f}; pg8::gemm_phase(F.lds, idxtab, P, E);
    } SEAM(15);
    if (IN(16)) { phase_final(F, x2b, ysl, inv, gates, args.in[20], args.in[21], args.out); if (DUPK(16)) phase_final(F, x2b, ysl, inv, gates, args.in[20], args.in[21], args.out); }
#undef IN
#undef SEAM
}

extern "C" void kernel_launch(void* const* d_in, const int* in_sizes, int n_in, void* d_out, int out_size, void* d_ws, size_t ws_size, hipStream_t stream) {
    static int grid = 0;
    if (grid == 0) {
        if (n_in != 22 || out_size != T * D || ws_size < WS_END) { fprintf(stderr, "kernel_launch: unexpected shapes (n_in %d out %d ws %zu need %zu)\n", n_in, out_size, ws_size, (size_t)WS_END); grid = -1; return; }
        int dev = 0, cus = 0, per_cu = 0;
        if (hipGetDevice(&dev) != hipSuccess || hipDeviceGetAttribute(&cus, hipDeviceAttributeMultiprocessorCount, dev) != hipSuccess) { grid = -1; return; }
        if (hipFuncSetAttribute((const void*)fwd_kernel, hipFuncAttributeMaxDynamicSharedMemorySize, LDS_BYTES) != hipSuccess) { fprintf(stderr, "kernel_launch: hipFuncSetAttribute failed\n"); grid = -1; return; }
        if (hipOccupancyMaxActiveBlocksPerMultiprocessor(&per_cu, (const void*)fwd_kernel, NTHR, LDS_BYTES) != hipSuccess || per_cu < 1) fprintf(stderr, "kernel_launch: occupancy query reports %d\n", per_cu);
        (void)hipGetLastError();
        grid = cus;
    }
    if (grid < 0) return;
    (void)hipMemsetAsync((char*)d_ws + WS_CTL, 0, CTL_ZERO_BYTES, stream);
    Args a{};
    for (int i = 0; i < 22; ++i) a.in[i] = (const float*)d_in[i];
    a.out = (float*)d_out; a.ws = (unsigned char*)d_ws;
#if MK_FUSED
    a.ph_lo = 0; a.ph_hi = NPHASE;
    hipLaunchKernelGGL(fwd_kernel, dim3(grid), dim3(NTHR), LDS_BYTES, stream, a);
#else
    for (int p = 0; p < NPHASE; ++p) { a.ph_lo = p; a.ph_hi = p + 1; hipLaunchKernelGGL(fwd_kernel, dim3(grid), dim3(NTHR), LDS_BYTES, stream, a); }
#endif
}
```

```cpp
#include <hip/hip_runtime.h>
#include <cstdio>
#include <cstdint>

#ifndef MK_FUSED
#define MK_FUSED 1
#endif

#ifndef DUP_MASK
#define DUP_MASK 0
#endif
#define LAS __attribute__((address_space(3)))
#define GAS __attribute__((address_space(1)))
typedef unsigned short bf16_t;
typedef short bf16x8 __attribute__((ext_vector_type(8)));
typedef short bf16x4 __attribute__((ext_vector_type(4)));
typedef float f32x4 __attribute__((ext_vector_type(4)));
typedef float f32x2 __attribute__((ext_vector_type(2)));
typedef unsigned u32x4 __attribute__((ext_vector_type(4)));
typedef unsigned u32x2 __attribute__((ext_vector_type(2)));
typedef int i32x8 __attribute__((ext_vector_type(8)));
typedef int i32x4 __attribute__((ext_vector_type(4)));
constexpr int W8_SCALE_BYTE = 0x78787878;
constexpr float W8_MUL = 128.0f;

constexpr int BATCH = 2, SEQ = 16384, T = BATCH * SEQ, D = 2048;
constexpr int DIN = 5376;
constexpr int OFF_QA = 0, OFF_KA = 1024, OFF_VA = 1152, OFF_QR = 1280, OFF_KR = 2304, OFF_VR = 3328, OFF_GR = 4352;
constexpr int NCH = SEQ / 128;
constexpr int NEXP = 32, NBLK_MAX = 544, NSLOT = NBLK_MAX * 256;
constexpr float LN_EPS = 1e-5f;
constexpr float DN_ALPHA = 1.18920711500272f;
constexpr int NWAVES = 8, NTHR = 512;

constexpr size_t MiB = (size_t)1 << 20;
constexpr size_t WS_CTL = 0, CTL_ZERO_BYTES = 1 * MiB;
constexpr size_t WS_WIN = 1 * MiB;
constexpr size_t WS_WMIX = WS_WIN + 21 * MiB;
constexpr size_t WS_WQN = WS_WMIX + 8 * MiB;
constexpr size_t WS_WKV = WS_WQN + 8 * MiB;
constexpr size_t WS_WO = WS_WKV + 16 * MiB;
constexpr size_t WS_WR = WS_WO + 8 * MiB;
constexpr size_t WS_WGU = WS_WR + 1 * MiB;
constexpr size_t WS_X2Q = WS_WGU + 256 * MiB;
constexpr size_t WS_WD = WS_WGU + 512 * MiB;
constexpr size_t WS_MEMB = WS_WD + 256 * MiB;
constexpr size_t WS_KV = WS_MEMB + 2 * MiB;
constexpr size_t WS_WQK = WS_KV + 4 * MiB;
constexpr size_t WS_WVO = WS_WQK + 8 * MiB;
constexpr size_t WS_SMALL = WS_WVO + 8 * MiB;
constexpr size_t WS_RT = WS_SMALL + 16 * MiB;
constexpr size_t WS_SP = WS_RT + 64 * MiB;
constexpr size_t WS_X1B = WS_SP + 96 * MiB;
constexpr size_t WS_X2B = WS_X1B + 128 * MiB;
constexpr size_t WS_X2 = WS_X2B + 128 * MiB;
constexpr size_t WS_R1 = WS_X2 + 256 * MiB;
constexpr size_t WS_XB = WS_R1;
constexpr size_t WS_PROJ = WS_XB + 128 * MiB;
constexpr size_t WS_U = WS_PROJ + 336 * MiB;
constexpr size_t WS_ACT = WS_R1;
constexpr size_t WS_R2 = WS_R1 + 592 * MiB;
constexpr size_t WS_Y = WS_R2;
constexpr size_t WS_Z = WS_Y + 128 * MiB;
constexpr size_t WS_X1 = WS_Z + 256 * MiB;
constexpr size_t WS_YS = WS_R2;
constexpr size_t WS_END = WS_R2 + 640 * MiB;
static_assert((size_t)NSLOT * 2048 * 2 <= 592 * MiB && (size_t)NSLOT * 2048 * 2 <= 640 * MiB, "overlay sizes");
constexpr size_t SM_LOGITS = 0;
constexpr size_t SM_TOKE = 8 * MiB;
constexpr size_t SM_TOKP = 9 * MiB;
constexpr size_t SM_GATE = 10 * MiB;
constexpr size_t SM_INV = 11 * MiB;
constexpr size_t SM_SLOT = 12 * MiB;
constexpr int CW_BAR = 4096, CW_CNT = 8192;

constexpr int RING_BYTES = 139264;
constexpr int IDX_OFF = RING_BYTES;
constexpr int TAB_OFF = RING_BYTES + 1024;
constexpr int MISC_OFF = RING_BYTES + 1024 + 4096;
constexpr int SMX_OFF = 147456;
constexpr int LDS_BYTES = 147456 + 8192;
static_assert(MISC_OFF + 256 <= LDS_BYTES, "lds map");

__device__ __forceinline__ unsigned f2bf(float f) { unsigned u = __float_as_uint(f); return (u + 0x7fffu + ((u >> 16) & 1u)) >> 16; }
__device__ __forceinline__ unsigned pk2(float lo, float hi) { return f2bf(lo) | (f2bf(hi) << 16); }
__device__ __forceinline__ float bf2f(unsigned b) { return __uint_as_float(b << 16); }
__device__ __forceinline__ unsigned cvt_pk_bf16(float lo, float hi) { unsigned r; asm volatile("v_cvt_pk_bf16_f32 %0, %1, %2" : "=v"(r) : "v"(lo), "v"(hi)); return r; }
__device__ __forceinline__ f32x4 mfma16(bf16x8 a, bf16x8 b, f32x4 c) { return __builtin_amdgcn_mfma_f32_16x16x32_bf16(a, b, c, 0, 0, 0); }
__device__ __forceinline__ float wave_sum(float v) {
#pragma unroll
    for (int o = 1; o < 64; o <<= 1) v += __shfl_xor(v, o);
    return v;
}
__device__ __forceinline__ float wave_max(float v) {
#pragma unroll
    for (int o = 1; o < 64; o <<= 1) v = fmaxf(v, __shfl_xor(v, o));
    return v;
}
__device__ __forceinline__ float grp16_sum(float v) { v += __shfl_xor(v, 1); v += __shfl_xor(v, 2); v += __shfl_xor(v, 4); v += __shfl_xor(v, 8); return v; }
__device__ __forceinline__ float grp16_max(float v) { v = fmaxf(v, __shfl_xor(v, 1)); v = fmaxf(v, __shfl_xor(v, 2)); v = fmaxf(v, __shfl_xor(v, 4)); v = fmaxf(v, __shfl_xor(v, 8)); return v; }
__device__ __forceinline__ bf16x8 tr_frag(const LAS unsigned char* p, int rs4) {
    const bf16x4 lo = __builtin_amdgcn_ds_read_tr16_b64_v4i16((LAS bf16x4*)p);
    const bf16x4 hi = __builtin_amdgcn_ds_read_tr16_b64_v4i16((LAS bf16x4*)(p + rs4));
    return (bf16x8){lo[0], lo[1], lo[2], lo[3], hi[0], hi[1], hi[2], hi[3]};
}

namespace pg8 {
constexpr int BM = 256, BK = 64, HALF = 128, HTB = HALF * BK * 2, STAGE_BYTES = 8 * HTB, NXCD = 8, WGM = 8;
__host__ __device__ __forceinline__ int lds_byte(int r, int c) { const int st = (r >> 4) * 2 + (c >> 5), rr = r & 15, cc = c & 31, ob = rr * 64 + cc * 2; return st * 1024 + (ob ^ (((ob >> 9) & 1) << 5)); }
__host__ __device__ __forceinline__ void stage_rc(int b, int& R, int& C) { const int st = b / 1024, sb = b % 1024, swz = sb ^ (((sb >> 9) & 1) << 5); R = (st >> 1) * 16 + swz / 64; C = (st & 1) * 32 + (swz % 64) / 2; }
__host__ __device__ __forceinline__ int perm32(int rho) { const int n = rho >> 4, i = rho & 15; return 8 * (i >> 2) + 4 * n + (i & 3); }

struct Unit { int pm, pn, orow, ocol, aux; };

struct StaticOrder {
    int nM, nN, nwg, G, c;
    __device__ void init(int nM_, int nN_, int G_, int c_) { nM = nM_; nN = nN_; nwg = nM * nN; G = G_; c = c_; }
    __device__ bool next(int i, int& pm, int& pn) const {
        const long L = (long)i * G + c; if (L >= nwg) return false;
        int wgid = (int)L; { const int q = nwg / NXCD, r = nwg % NXCD, xcd = wgid % NXCD, off = wgid / NXCD; wgid = (xcd < r ? xcd * (q + 1) : r * (q + 1) + (xcd - r) * q) + off; }
        const int nig = WGM * nN, gid = wgid / nig, fm = gid * WGM, gsz = (nM - fm) < WGM ? (nM - fm) : WGM;
        pm = fm + ((wgid % nig) % gsz); pn = (wgid % nig) / gsz; return true;
    }
};

template <class Epi, class Prob>
__device__ __forceinline__ void gemm_phase(LAS unsigned char* lds, LAS unsigned char* idxtab, const Prob& P, const Epi& E) {
    const int tid = threadIdx.x, wid = __builtin_amdgcn_readfirstlane(tid >> 6), lane = tid & 63, wr = wid >> 2, wc = wid & 3, fr = lane & 15, fq = lane >> 4;
    const int K = P.K, nt = Prob::FP8 ? K / 128 : K / BK;
    constexpr bool GATHER = Prob::GATHER; constexpr bool FP8 = Prob::FP8; constexpr unsigned ES = FP8 ? 1u : 2u;
    const unsigned lda2 = (unsigned)P.lda * ES, ldb2 = (unsigned)P.ldb * ES;
    unsigned voffB, oc[2][2], on[2][2]; int rA[2]; unsigned cA2;
    { int R, C; stage_rc(tid * 16, R, C); const int Rb = Epi::PERM ? ((R & ~31) + perm32(R & 31)) : R;
        voffB = (unsigned)Rb * ldb2 + (unsigned)C * 2u; rA[0] = R; rA[1] = R + 64; cA2 = (unsigned)C * 2u;
#pragma unroll
        for (int i = 0; i < 2; ++i)
#pragma unroll
            for (int h = 0; h < 2; ++h) { oc[h][i] = (unsigned)R * lda2 + cA2; on[h][i] = oc[h][i]; } }
    const size_t pstepA = (size_t)64 * lda2, pstepB = (size_t)64 * ldb2, hstepA = (size_t)HALF * lda2;
    const size_t kstep = (size_t)(BK * 2);
    const size_t hstepB = (size_t)HALF * ldb2;
    const unsigned ldsw = (unsigned)wid * 1024u, ldsbase = (unsigned)(size_t)lds;
    const int aoff = lds_byte(wr * 64 + fr, fq * 8), boff = lds_byte(wc * 32 + fr, fq * 8);
#define PG8_SA(b, h) (((b) * 2 + (h)) * HTB)
#define PG8_SB(b, h) ((4 + (b) * 2 + (h)) * HTB)
#define PG8_GLDS(ldsdst, gptr, voff32) do { unsigned keep_; asm volatile("s_mov_b32 %0, m0\n\ts_mov_b32 m0, %2\n\ts_nop 0\n\tglobal_load_lds_dwordx4 %1, %3\n\ts_mov_b32 m0, %0" \
        : "=&s"(keep_) : "v"(voff32), "s"(ldsdst), "s"(gptr) : "memory"); } while (0)
#define PG8_STAGE_B(bufoff, gbase) do { PG8_GLDS(ldsbase + (unsigned)(bufoff) + ldsw, (const char*)(gbase), voffB); PG8_GLDS(ldsbase + (unsigned)(bufoff) + ldsw + 8192u, (const char*)(gbase) + pstepB, voffB); } while (0)
#define PG8_STAGE_A(bufoff, gbase, o, h) do { if constexpr (GATHER) { PG8_GLDS(ldsbase + (unsigned)(bufoff) + ldsw, (const char*)(gbase), (o)[h][0]); PG8_GLDS(ldsbase + (unsigned)(bufoff) + ldsw + 8192u, (const char*)(gbase), (o)[h][1]); } \
        else { PG8_GLDS(ldsbase + (unsigned)(bufoff) + ldsw, (const char*)(gbase) + (h) * hstepA, oc[0][0]); PG8_GLDS(ldsbase + (unsigned)(bufoff) + ldsw + 8192u, (const char*)(gbase) + (h) * hstepA + pstepA, oc[0][0]); } } while (0)
#define PG8_LDA(dst, b, h) do { _Pragma("unroll") for (int m = 0; m < 4; ++m) { \
        if constexpr (FP8) { const i32x4 lo_ = *(const LAS i32x4*)(lds + PG8_SA(b, h) + aoff + m * 2048), hi_ = *(const LAS i32x4*)(lds + PG8_SA(b, h) + aoff + m * 2048 + 1024); \
            dst##8[m] = (i32x8){lo_.x, lo_.y, lo_.z, lo_.w, hi_.x, hi_.y, hi_.z, hi_.w}; } \
        else { _Pragma("unroll") for (int k = 0; k < 2; ++k) dst[m][k] = *(const LAS bf16x8*)(lds + PG8_SA(b, h) + aoff + m * 2048 + k * 1024); } } } while (0)
#define PG8_LDB(dst, b, h) do { _Pragma("unroll") for (int n = 0; n < 2; ++n) { \
        if constexpr (FP8) { const i32x4 lo_ = *(const LAS i32x4*)(lds + PG8_SB(b, h) + boff + n * 2048), hi_ = *(const LAS i32x4*)(lds + PG8_SB(b, h) + boff + n * 2048 + 1024); \
            dst##8[n] = (i32x8){lo_.x, lo_.y, lo_.z, lo_.w, hi_.x, hi_.y, hi_.z, hi_.w}; } \
        else { _Pragma("unroll") for (int k = 0; k < 2; ++k) dst[n][k] = *(const LAS bf16x8*)(lds + PG8_SB(b, h) + boff + n * 2048 + k * 1024); } } } while (0)
#define PG8_MMA(ai, bj, At, Bt) do { __builtin_amdgcn_s_setprio(1); _Pragma("unroll") for (int m = 0; m < 4; ++m) _Pragma("unroll") for (int n = 0; n < 2; ++n) { \
        if constexpr (FP8) asm volatile("s_nop 1\n\tv_mfma_scale_f32_16x16x128_f8f6f4 %0, %1, %2, %0, %3, %4 op_sel_hi:[0,0,0]" : "+v"(acc[ai][bj][m][n]) : "v"(Bt##8[n]), "v"(At##8[m]), "v"(sclW), "v"(sclA)); \
        else { _Pragma("unroll") for (int k = 0; k < 2; ++k) acc[ai][bj][m][n] = __builtin_amdgcn_mfma_f32_16x16x32_bf16(Bt[n][k], At[m][k], acc[ai][bj][m][n], 0, 0, 0); } } \
        __builtin_amdgcn_s_setprio(0); } while (0)
#define PG8_WAIT_V(n) asm volatile("s_waitcnt vmcnt(" #n ")" ::: "memory")
#define PG8_WAIT_L(n) asm volatile("s_waitcnt lgkmcnt(" #n ")" ::: "memory")
#define PG8_BAR __builtin_amdgcn_s_barrier()
#define PG8_SCHED __builtin_amdgcn_sched_barrier(0)
    Unit cur, nxt; int ui = 0;
    if (!P.next(0, cur)) return;
    f32x4 acc[2][2][4][2];
#pragma unroll
    for (int a = 0; a < 2; ++a)
#pragma unroll
        for (int b = 0; b < 2; ++b)
#pragma unroll
            for (int m = 0; m < 4; ++m)
#pragma unroll
                for (int n = 0; n < 2; ++n) acc[a][b][m][n] = (f32x4){0.f, 0.f, 0.f, 0.f};
    bf16x8 At[4][2], B0[2][2], B1[2][2]; i32x8 At8[4], B08[2], B18[2]; const int sclW = Prob::SCL_W, sclA = Prob::SCL_A;
    const char* cA = P.a_ptr(cur); const char* cB = P.b_ptr(cur);
    if constexpr (GATHER) {
        if (wid < 4) __builtin_amdgcn_global_load_lds((const unsigned*)(P.idx_ptr(cur) + wid * 64 + lane), (LAS unsigned*)(idxtab + wid * 256), 4, 0, 0);
        PG8_WAIT_V(0); PG8_BAR;
#pragma unroll
        for (int i = 0; i < 2; ++i)
#pragma unroll
            for (int h = 0; h < 2; ++h) oc[h][i] = ((const LAS unsigned*)idxtab)[h * HALF + rA[i]] * lda2 + cA2;
        PG8_WAIT_L(0); PG8_BAR;
    }
    PG8_STAGE_B(PG8_SB(0, 0), cB); PG8_STAGE_B(PG8_SB(0, 1), cB + hstepB); PG8_STAGE_A(PG8_SA(0, 0), cA, oc, 0); PG8_STAGE_A(PG8_SA(0, 1), cA, oc, 1);
    if (wr == 1) PG8_BAR;
    PG8_WAIT_V(2); PG8_BAR;
    PG8_STAGE_B(PG8_SB(1, 0), cB + kstep); PG8_STAGE_A(PG8_SA(1, 0), cA + kstep, oc, 0); PG8_STAGE_B(PG8_SB(1, 1), cB + hstepB + kstep);
    PG8_WAIT_V(6); PG8_BAR;
    for (;;) {
        const bool has_next = P.next(ui + 1, nxt);
        const char* nA = has_next ? P.a_ptr(nxt) : cA; const char* nB = has_next ? P.b_ptr(nxt) : cB;
        if constexpr (GATHER) { if (has_next && wid < 4) __builtin_amdgcn_global_load_lds((const unsigned*)(P.idx_ptr(nxt) + wid * 64 + lane), (LAS unsigned*)(idxtab + wid * 256), 4, 0, 0); }
        for (int t = 0; t < nt; t += 2) {
            const bool last = (t == nt - 2);
            const char* a1 = cA + (size_t)(t + 1) * kstep;
            const char* a2 = last ? nA : cA + (size_t)(t + 2) * kstep; const char* b2 = last ? nB : cB + (size_t)(t + 2) * kstep;
            const char* a3 = a2 + kstep; const char* b3 = b2 + kstep;
            unsigned os[2][2];
            if constexpr (GATHER) {
                if (last && has_next) {
#pragma unroll
                    for (int i = 0; i < 2; ++i)
#pragma unroll
                        for (int h = 0; h < 2; ++h) on[h][i] = ((const LAS unsigned*)idxtab)[h * HALF + rA[i]] * lda2 + cA2;
                }
#pragma unroll
                for (int i = 0; i < 2; ++i)
#pragma unroll
                    for (int h = 0; h < 2; ++h) os[h][i] = last ? on[h][i] : oc[h][i];
            } else {
#pragma unroll
                for (int i = 0; i < 2; ++i)
#pragma unroll
                    for (int h = 0; h < 2; ++h) os[h][i] = oc[h][i];
            }
            PG8_LDB(B0, 0, 0); PG8_LDB(B1, 0, 1); PG8_SCHED; PG8_LDA(At, 0, 0); PG8_STAGE_A(PG8_SA(1, 1), a1, oc, 1);
            PG8_WAIT_V(8); PG8_WAIT_L(0); PG8_BAR; PG8_MMA(0, 0, At, B0); PG8_MMA(0, 1, At, B1); PG8_BAR; PG8_SCHED;
            PG8_LDA(At, 0, 1); PG8_STAGE_B(PG8_SB(0, 0), b2); PG8_STAGE_B(PG8_SB(0, 1), b2 + hstepB); PG8_STAGE_A(PG8_SA(0, 0), a2, os, 0);
            PG8_WAIT_V(8); PG8_WAIT_L(0); PG8_BAR; PG8_MMA(1, 0, At, B0); PG8_MMA(1, 1, At, B1); PG8_BAR; PG8_SCHED;
            PG8_LDB(B0, 1, 0); PG8_LDB(B1, 1, 1); PG8_SCHED; PG8_LDA(At, 1, 0); PG8_STAGE_A(PG8_SA(0, 1), a2, os, 1);
            PG8_WAIT_V(8); PG8_WAIT_L(0); PG8_BAR; PG8_MMA(0, 0, At, B0); PG8_MMA(0, 1, At, B1); PG8_BAR; PG8_SCHED;
            PG8_LDA(At, 1, 1); PG8_STAGE_B(PG8_SB(1, 0), b3); PG8_STAGE_B(PG8_SB(1, 1), b3 + hstepB); PG8_STAGE_A(PG8_SA(1, 0), a3, os, 0);
            PG8_WAIT_V(8); PG8_WAIT_L(0); PG8_BAR; PG8_MMA(1, 0, At, B0); PG8_MMA(1, 1, At, B1); PG8_BAR; PG8_SCHED;
        }
        if constexpr (FP8) { asm volatile("s_nop 15\n\ts_nop 15\n\ts_nop 7" ::: "memory"); PG8_SCHED; }
        if (wr == 0) PG8_BAR;
        E(acc, cur, wr, wc, fr, fq);
        if (!has_next) break;
#pragma unroll
        for (int a = 0; a < 2; ++a)
#pragma unroll
            for (int b = 0; b < 2; ++b)
#pragma unroll
                for (int m = 0; m < 4; ++m)
#pragma unroll
                    for (int n = 0; n < 2; ++n) acc[a][b][m][n] = (f32x4){0.f, 0.f, 0.f, 0.f};
        cur = nxt; cA = nA; cB = nB; ++ui;
        if constexpr (GATHER) {
#pragma unroll
            for (int i = 0; i < 2; ++i)
#pragma unroll
                for (int h = 0; h < 2; ++h) oc[h][i] = on[h][i];
        }
        if (wr == 1) PG8_BAR;
    }
    PG8_WAIT_V(0);
    PG8_BAR;
#undef PG8_SA
#undef PG8_SB
#undef PG8_STAGE_A
#undef PG8_STAGE_B
#undef PG8_GLDS
#undef PG8_LDA
#undef PG8_LDB
#undef PG8_MMA
#undef PG8_WAIT_V
#undef PG8_WAIT_L
#undef PG8_BAR
#undef PG8_SCHED
}

struct EpiBf16 {
    static constexpr bool PERM = true;
    bf16_t* O; int ldc; const float* bias; int bias_stride; float scale;
    __device__ __forceinline__ void operator()(const f32x4 (&acc)[2][2][4][2], const Unit& u, int wr, int wc, int fr, int fq) const {
        const int row0 = u.orow + wr * 64 + fr, col0 = u.ocol + wc * 32 + 8 * fq;
        f32x4 bv[2][2];
#pragma unroll
        for (int bj = 0; bj < 2; ++bj)
#pragma unroll
            for (int n = 0; n < 2; ++n) bv[bj][n] = bias ? *(const f32x4*)(bias + (size_t)u.aux * bias_stride + col0 + bj * HALF + 4 * n) : (f32x4){0.f, 0.f, 0.f, 0.f};
#pragma unroll
        for (int ai = 0; ai < 2; ++ai)
#pragma unroll
            for (int m = 0; m < 4; ++m) { bf16_t* rowp = O + (size_t)(row0 + ai * HALF + m * 16) * ldc + col0;
#pragma unroll
                for (int bj = 0; bj < 2; ++bj) { f32x4 v0 = (acc[ai][bj][m][0] + bv[bj][0]) * scale, v1 = (acc[ai][bj][m][1] + bv[bj][1]) * scale;
                    u32x4 w; w.x = cvt_pk_bf16(v0[0], v0[1]); w.y = cvt_pk_bf16(v0[2], v0[3]); w.z = cvt_pk_bf16(v1[0], v1[1]); w.w = cvt_pk_bf16(v1[2], v1[3]);
                    *(u32x4*)(rowp + bj * HALF) = w; } }
    }
};
struct EpiFp8 {
    static constexpr bool PERM = true;
    unsigned char* O; int ldc; float scale;
    __device__ __forceinline__ void operator()(const f32x4 (&acc)[2][2][4][2], const Unit& u, int wr, int wc, int fr, int fq) const {
        const int row0 = u.orow + wr * 64 + fr, col0 = u.ocol + wc * 32 + 8 * fq;
#pragma unroll
        for (int ai = 0; ai < 2; ++ai)
#pragma unroll
            for (int m = 0; m < 4; ++m)
#pragma unroll
                for (int bj = 0; bj < 2; ++bj) { const f32x4 v0 = acc[ai][bj][m][0] * scale, v1 = acc[ai][bj][m][1] * scale;
                    int w0 = __builtin_amdgcn_cvt_pk_fp8_f32(v0[0], v0[1], 0, false); w0 = __builtin_amdgcn_cvt_pk_fp8_f32(v0[2], v0[3], w0, true);
                    int w1 = __builtin_amdgcn_cvt_pk_fp8_f32(v1[0], v1[1], 0, false); w1 = __builtin_amdgcn_cvt_pk_fp8_f32(v1[2], v1[3], w1, true);
                    *(u32x2*)(O + (size_t)(row0 + ai * HALF + m * 16) * ldc + col0 + bj * HALF) = (u32x2){(unsigned)w0, (unsigned)w1}; }
    }
};
struct EpiSoftmax {
    static constexpr bool PERM = true;
    unsigned char* O; int ldc; LAS float* tab;
    __device__ __forceinline__ void operator()(const f32x4 (&acc)[2][2][4][2], const Unit& u, int wr, int wc, int fr, int fq) const {
        const int row0 = u.orow + wr * 64 + fr, col0 = u.ocol + wc * 32 + 8 * fq;
        LAS float* tM = tab; LAS float* tS = tab + 1024;
#pragma unroll
        for (int ai = 0; ai < 2; ++ai)
#pragma unroll
            for (int m = 0; m < 4; ++m) { float mx = -3.0e38f;
#pragma unroll
                for (int bj = 0; bj < 2; ++bj)
#pragma unroll
                    for (int n = 0; n < 2; ++n) { const f32x4 v = acc[ai][bj][m][n]; mx = fmaxf(mx, fmaxf(fmaxf(v[0], v[1]), fmaxf(v[2], v[3]))); }
                mx = fmaxf(mx, __shfl_xor(mx, 16)); mx = fmaxf(mx, __shfl_xor(mx, 32));
                if (fq == 0) tM[(ai * HALF + wr * 64 + m * 16 + fr) * 4 + wc] = mx; }
        asm volatile("s_waitcnt lgkmcnt(0)" ::: "memory"); __builtin_amdgcn_s_barrier(); asm volatile("" ::: "memory");
        f32x4 e[2][2][4][2];
#pragma unroll
        for (int ai = 0; ai < 2; ++ai)
#pragma unroll
            for (int m = 0; m < 4; ++m) { const int r = ai * HALF + wr * 64 + m * 16 + fr; const f32x4 t = *(const LAS f32x4*)(tM + r * 4);
                const float M = fmaxf(fmaxf(t[0], t[1]), fmaxf(t[2], t[3])); float sm = 0.f;
#pragma unroll
                for (int bj = 0; bj < 2; ++bj)
#pragma unroll
                    for (int n = 0; n < 2; ++n) { f32x4 v = acc[ai][bj][m][n];
#pragma unroll
                        for (int j = 0; j < 4; ++j) { v[j] = __expf(v[j] - M); sm += v[j]; }
                        e[ai][bj][m][n] = v; }
                sm += __shfl_xor(sm, 16); sm += __shfl_xor(sm, 32);
                if (fq == 0) tS[r * 4 + wc] = sm; }
        asm volatile("s_waitcnt lgkmcnt(0)" ::: "memory"); __builtin_amdgcn_s_barrier(); asm volatile("" ::: "memory");
#pragma unroll
        for (int ai = 0; ai < 2; ++ai)
#pragma unroll
            for (int m = 0; m < 4; ++m) { const int r = ai * HALF + wr * 64 + m * 16 + fr; const f32x4 t = *(const LAS f32x4*)(tS + r * 4);
                const float il = 256.0f / ((t[0] + t[1]) + (t[2] + t[3]));
#pragma unroll
                for (int bj = 0; bj < 2; ++bj) { const f32x4 v0 = e[ai][bj][m][0] * il, v1 = e[ai][bj][m][1] * il;
                    int w0 = __builtin_amdgcn_cvt_pk_fp8_f32(v0[0], v0[1], 0, false); w0 = __builtin_amdgcn_cvt_pk_fp8_f32(v0[2], v0[3], w0, true);
                    int w1 = __builtin_amdgcn_cvt_pk_fp8_f32(v1[0], v1[1], 0, false); w1 = __builtin_amdgcn_cvt_pk_fp8_f32(v1[2], v1[3], w1, true);
                    *(u32x2*)(O + (size_t)(row0 + ai * HALF + m * 16) * ldc + col0 + bj * HALF) = (u32x2){(unsigned)w0, (unsigned)w1}; } }
    }
};
struct EpiResBf16 {
    static constexpr bool PERM = true;
    const bf16_t* res; bf16_t* out; int ldc; float alpha;
    __device__ __forceinline__ void operator()(const f32x4 (&acc)[2][2][4][2], const Unit& u, int wr, int wc, int fr, int fq) const {
        const int row0 = u.orow + wr * 64 + fr, col0 = u.ocol + wc * 32 + 8 * fq;
#pragma unroll
        for (int ai = 0; ai < 2; ++ai)
#pragma unroll
            for (int m = 0; m < 4; ++m) { const size_t off = (size_t)(row0 + ai * HALF + m * 16) * ldc + col0;
#pragma unroll
                for (int bj = 0; bj < 2; ++bj) { const u32x4 r = *(const u32x4*)(res + off + bj * HALF); const f32x4 a0 = acc[ai][bj][m][0], a1 = acc[ai][bj][m][1];
                    u32x4 w; w.x = cvt_pk_bf16(bf2f(r.x & 0xffffu) * alpha + a0[0], bf2f(r.x >> 16) * alpha + a0[1]); w.y = cvt_pk_bf16(bf2f(r.y & 0xffffu) * alpha + a0[2], bf2f(r.y >> 16) * alpha + a0[3]);
                    w.z = cvt_pk_bf16(bf2f(r.z & 0xffffu) * alpha + a1[0], bf2f(r.z >> 16) * alpha + a1[1]); w.w = cvt_pk_bf16(bf2f(r.w & 0xffffu) * alpha + a1[2], bf2f(r.w >> 16) * alpha + a1[3]);
                    *(u32x4*)(out + off + bj * HALF) = w; }
                if (m & 1) asm volatile("" ::: "memory"); }
    }
};
struct EpiRouter {
    static constexpr bool PERM = false;
    float* out; const float* bias;
    __device__ __forceinline__ void operator()(const f32x4 (&acc)[2][2][4][2], const Unit& u, int wr, int wc, int fr, int fq) const {
        if (wc != 0) return;
        const int row0 = u.orow + wr * 64 + fr;
#pragma unroll
        for (int ai = 0; ai < 2; ++ai)
#pragma unroll
            for (int m = 0; m < 4; ++m)
#pragma unroll
                for (int n = 0; n < 2; ++n) { const int c = 16 * n + 4 * fq; const f32x4 b = *(const f32x4*)(bias + c);
                    *(f32x4*)(out + (size_t)u.aux * T * 32 + (size_t)(row0 + ai * HALF + m * 16) * 32 + c) = u.aux ? acc[ai][0][m][n] : acc[ai][0][m][n] + b; }
    }
};
struct EpiSwiglu {
    static constexpr bool PERM = true;
    unsigned char* O; const float* bias;
    __device__ __forceinline__ void operator()(const f32x4 (&acc)[2][2][4][2], const Unit& u, int wr, int wc, int fr, int fq) const {
        const int row0 = u.orow + wr * 64 + fr, col0 = u.ocol + wc * 32 + 8 * fq;
        const float* bg = bias + (size_t)u.aux * 4096 + col0; const float* bu = bg + 2048;
        const f32x4 g0 = *(const f32x4*)bg, g1 = *(const f32x4*)(bg + 4), u0 = *(const f32x4*)bu, u1 = *(const f32x4*)(bu + 4);
#pragma unroll
        for (int ai = 0; ai < 2; ++ai)
#pragma unroll
            for (int m = 0; m < 4; ++m) {
                f32x4 gl0 = acc[ai][0][m][0] + g0, gl1 = acc[ai][0][m][1] + g1, up0 = acc[ai][1][m][0] + u0, up1 = acc[ai][1][m][1] + u1;
                float r[8];
#pragma unroll
                for (int j = 0; j < 4; ++j) {
                    { const float g = fminf(gl0[j], 7.0f), uu = fminf(fmaxf(up0[j], -7.0f), 7.0f); const float sg = __builtin_amdgcn_rcpf(1.0f + __expf(-1.702f * g)); r[j] = (uu + 1.0f) * (g * sg); }
                    { const float g = fminf(gl1[j], 7.0f), uu = fminf(fmaxf(up1[j], -7.0f), 7.0f); const float sg = __builtin_amdgcn_rcpf(1.0f + __expf(-1.702f * g)); r[4 + j] = (uu + 1.0f) * (g * sg); }
                }
                int w0 = __builtin_amdgcn_cvt_pk_fp8_f32(r[0], r[1], 0, false); w0 = __builtin_amdgcn_cvt_pk_fp8_f32(r[2], r[3], w0, true);
                int w1 = __builtin_amdgcn_cvt_pk_fp8_f32(r[4], r[5], 0, false); w1 = __builtin_amdgcn_cvt_pk_fp8_f32(r[6], r[7], w1, true);
                *(u32x2*)(O + (size_t)(row0 + ai * HALF + m * 16) * 2048 + col0) = (u32x2){(unsigned)w0, (unsigned)w1}; }
    }
};

template <bool F8 = false, int SA = 0x7f7f7f7f> struct ProbStdT {
    static constexpr bool GATHER = false, FP8 = F8; static constexpr int SCL_W = W8_SCALE_BYTE, SCL_A = SA; static constexpr int ES = F8 ? 1 : 2;
    const char* A; const char* Bt; int K, lda, ldb; StaticOrder S; int split_pm; size_t b_split_stride; int orow_extra;
    __device__ void init(const void* A_, const void* Bt_, int M, int N, int K_, int lda_, int ldb_, int G, int c) { A = (const char*)A_; Bt = (const char*)Bt_; K = K_; lda = lda_; ldb = ldb_; S.init(M / BM, N / BM, G, c); split_pm = 1 << 30; b_split_stride = 0; orow_extra = 0; }
    __device__ bool next(int i, Unit& u) const { if (!S.next(i, u.pm, u.pn)) return false; u.orow = u.pm * BM; u.ocol = u.pn * BM; u.aux = 0; return true; }
    __device__ const char* a_ptr(const Unit& u) const { return A + (size_t)u.pm * BM * lda * ES; }
    __device__ const char* b_ptr(const Unit& u) const { return Bt + ((size_t)u.pn * BM * ldb + (u.pm >= split_pm ? b_split_stride : 0)) * ES; }
    __device__ const int* idx_ptr(const Unit&) const { return nullptr; }
};
typedef ProbStdT<false> ProbStd;
struct ProbRouter {
    static constexpr bool GATHER = false, FP8 = false; static constexpr int SCL_W = 0, SCL_A = 0;
    const bf16_t* A; const bf16_t* Bt; int K, lda, ldb, G, c;
    __device__ bool next(int i, Unit& u) const { const int L = i * G + c; if (L >= 256) return false; u.pm = L >> 1; u.pn = L & 1; u.orow = u.pm * BM; u.ocol = 0; u.aux = u.pn; return true; }
    __device__ const char* a_ptr(const Unit& u) const { return (const char*)(A + (size_t)u.pm * BM * lda + u.pn * 1024); }
    __device__ const char* b_ptr(const Unit& u) const { return (const char*)(Bt + u.pn * 1024); }
    __device__ const int* idx_ptr(const Unit&) const { return nullptr; }
};
struct ProbFoldA {
    static constexpr bool GATHER = false, FP8 = false; static constexpr int SCL_W = 0, SCL_A = 0;
    const bf16_t* kv; const bf16_t* wq; int K, lda, ldb, G, c;
    __device__ bool next(int i, Unit& u) const { const int L = i * G + c; if (L >= 64) return false; const int bh = L >> 3; u.pm = bh; u.pn = L & 7; u.orow = (bh >> 2) * 1024 + (bh & 3) * 256; u.ocol = u.pn * 256; u.aux = 0; return true; }
    __device__ const char* a_ptr(const Unit& u) const { const int b = u.pm >> 2, h = u.pm & 3; return (const char*)(kv + (size_t)b * 256 * 4096 + h * 512); }
    __device__ const char* b_ptr(const Unit& u) const { const int h = u.pm & 3; return (const char*)(wq + (size_t)u.pn * 256 * 2048 + h * 512); }
    __device__ const int* idx_ptr(const Unit&) const { return nullptr; }
};
struct ProbFoldB {
    static constexpr bool GATHER = false, FP8 = false; static constexpr int SCL_W = 0, SCL_A = 0;
    const bf16_t* woT; const bf16_t* kv; int K, lda, ldb, G, c;
    __device__ bool next(int i, Unit& u) const { const int L = i * G + c; if (L >= 64) return false; const int bh = L >> 3; u.pm = L & 7; u.pn = bh; u.orow = (bh >> 2) * 2048 + u.pm * 256; u.ocol = (bh & 3) * 256; u.aux = 0; return true; }
    __device__ const char* a_ptr(const Unit& u) const { const int h = u.pn & 3; return (const char*)(woT + (size_t)u.pm * 256 * 2048 + h * 512); }
    __device__ const char* b_ptr(const Unit& u) const { const int b = u.pn >> 2, h = u.pn & 3; return (const char*)(kv + (size_t)b * 256 * 4096 + 2048 + h * 512); }
    __device__ const int* idx_ptr(const Unit&) const { return nullptr; }
};
template <bool G1> struct ProbMoe {
    static constexpr bool GATHER = G1, FP8 = true; static constexpr int SCL_W = W8_SCALE_BYTE, SCL_A = 0x7f7f7f7f;
    const unsigned char* A; const unsigned char* W; const int* slot_tok; const LAS int* blkexp; int K, lda, ldb; StaticOrder S;
    __device__ bool next(int i, Unit& u) const { if (!S.next(i, u.pm, u.pn)) return false; u.orow = u.pm * BM; u.ocol = u.pn * (G1 ? 128 : 256); u.aux = __builtin_amdgcn_readfirstlane(blkexp[u.pm]); return true; }
    __device__ const char* a_ptr(const Unit& u) const { return G1 ? (const char*)A : (const char*)(A + (size_t)u.pm * BM * lda); }
    __device__ const char* b_ptr(const Unit& u) const { return (const char*)(W + ((size_t)u.aux * (G1 ? 4096 : 2048) + (size_t)u.pn * BM) * 2048); }
    __device__ const int* idx_ptr(const Unit& u) const { return slot_tok + u.pm * BM; }
};
}

#define XB_TMO      128
#define XB_XCNT(j)  (256  + 64 * (j))
#define XB_XSUB(j)  (1280 + 64 * (j))
#define XB_XGEN(j)  (2304 + 64 * (j))
#define XB_TOP      3328
#define XB_TOPGEN   3392
#define XCD_BAR_WORDS 3456
#define XB_SPIN_CAP (1u << 18)
__device__ __forceinline__ unsigned xb_ld(unsigned* p)              { return __hip_atomic_load(p, __ATOMIC_RELAXED, __HIP_MEMORY_SCOPE_AGENT); }
__device__ __forceinline__ unsigned xb_add(unsigned* p, unsigned v) { return __hip_atomic_fetch_add(p, v, __ATOMIC_RELAXED, __HIP_MEMORY_SCOPE_AGENT); }
__device__ __forceinline__ unsigned xb_xcc_id() { return (unsigned)__builtin_amdgcn_s_getreg((3 << 11) | 20) & 0xFu; }
#define XB_SPIN(cond, bar) do { unsigned _sp = 0; while (cond) { __builtin_amdgcn_s_sleep(1); \
    if ((++_sp & 255u) == 0u) { if (xb_ld(&(bar)[XB_TMO])) break; if (_sp > XB_SPIN_CAP) { atomicAdd(&(bar)[XB_TMO], 1u); break; } } } } while (0)
struct XcdBarrier { unsigned* bar; unsigned x; volatile LAS unsigned* st; };
__device__ __forceinline__ XcdBarrier xcd_barrier_post(unsigned* bar, volatile LAS unsigned* st) {
    XcdBarrier b; b.bar = bar; b.x = xb_xcc_id(); b.st = st;
    if (threadIdx.x == 0) (void)xb_add(&bar[XB_XCNT(b.x)], 1u);
    return b;
}
__device__ __forceinline__ void xcd_barrier_complete(unsigned* bar, unsigned x, unsigned& nloc, unsigned& nx) {
    const unsigned G = gridDim.x * gridDim.y * gridDim.z;
    unsigned sum, cnt, mine, sp = 0u;
    for (;;) {
        sum = 0u; cnt = 0u; mine = 0u;
#pragma unroll
        for (unsigned j = 0; j < 16; ++j) { const unsigned c = xb_ld(&bar[XB_XCNT(j)]); sum += c; cnt += (c > 0u) ? 1u : 0u; mine = (j == x) ? c : mine; }
        if (sum == G) break;
        __builtin_amdgcn_s_sleep(1);
        if ((++sp & 255u) == 0u) { if (xb_ld(&bar[XB_TMO])) break; if (sp > XB_SPIN_CAP) { atomicAdd(&bar[XB_TMO], 1u); break; } }
    }
    nloc = mine > 0u ? mine : 1u; nx = cnt > 0u ? cnt : 1u;
}
__device__ __forceinline__ void xcd_barrier(const XcdBarrier& b) {
    asm volatile("s_waitcnt vmcnt(0)" ::: "memory");
    __syncthreads();
    if (threadIdx.x == 0) {
        unsigned* bar = b.bar;
        __builtin_amdgcn_s_waitcnt(0);
        unsigned nloc = b.st[0], nx = b.st[1];
        if (nloc == 0u) { xcd_barrier_complete(bar, b.x, nloc, nx); b.st[0] = nloc; b.st[1] = nx; }
        const unsigned old = xb_add(&bar[XB_XSUB(b.x)], 1u);
        const unsigned gen = old / nloc;
        if (old + 1u == (gen + 1u) * nloc) {
            __builtin_amdgcn_fence(__ATOMIC_RELEASE, "agent");
            asm volatile("s_waitcnt vmcnt(0)" ::: "memory");
            const unsigned og = xb_add(&bar[XB_TOP], 1u);
            const unsigned tg = og / nx;
            if (og + 1u == (tg + 1u) * nx) xb_add(&bar[XB_TOPGEN], 1u);
            else XB_SPIN(xb_ld(&bar[XB_TOPGEN]) == tg, bar);
            __builtin_amdgcn_fence(__ATOMIC_ACQUIRE, "agent");
            xb_add(&bar[XB_XGEN(b.x)], 1u);
            asm volatile("s_waitcnt vmcnt(0)" ::: "memory");
        } else {
            XB_SPIN(xb_ld(&bar[XB_XGEN(b.x)]) == gen, bar);
            __builtin_amdgcn_fence(__ATOMIC_ACQUIRE, "agent");
            asm volatile("s_waitcnt vmcnt(0)" ::: "memory");
        }
    }
    __syncthreads();
}

struct Args {
    const float* in[22]; float* out; unsigned char* ws; int ph_lo, ph_hi;
};
struct Frame {
    LAS unsigned char* lds; int tid, lane, wave, G, bid;
    unsigned char* ws;
};
#define LDS_WAIT() asm volatile("s_waitcnt lgkmcnt(0)" ::: "memory")
#define VM_WAIT() asm volatile("s_waitcnt vmcnt(0)" ::: "memory")

__device__ __forceinline__ void p0_transpose_item(const float* W, int Kdim, int N, bf16_t* WT, int dst_row0, int k0, int n0, LAS float* scr, int lane) {
    float tv[32];
#pragma unroll
    for (int i = 0; i < 32; ++i) tv[i] = __builtin_nontemporal_load(W + (size_t)(k0 + 2 * i + (lane >> 5)) * N + n0 + (lane & 31));
#pragma unroll
    for (int i = 0; i < 32; ++i) scr[(2 * i + (lane >> 5)) * 33 + (lane & 31)] = tv[i];
    LDS_WAIT(); asm volatile("" ::: "memory");
    const int c = lane & 7;
#pragma unroll
    for (int j = 0; j < 4; ++j) { const int n = (lane >> 3) + 8 * j; const LAS float* s = scr + (8 * c) * 33 + n;
        u32x4 o; o.x = pk2(s[0 * 33], s[1 * 33]); o.y = pk2(s[2 * 33], s[3 * 33]); o.z = pk2(s[4 * 33], s[5 * 33]); o.w = pk2(s[6 * 33], s[7 * 33]);
        *(u32x4*)(WT + (size_t)(dst_row0 + n) * Kdim + k0 + 8 * c) = o; }
    LDS_WAIT(); asm volatile("" ::: "memory");
}
__device__ __forceinline__ void p0_transpose_item8(const float* W, int Kdim, int N, unsigned char* WT, int dst_row0, int k0, int n0, LAS float* scr, int lane) {
    float tv[64];
#pragma unroll
    for (int i = 0; i < 64; ++i) tv[i] = __builtin_nontemporal_load(W + (size_t)(k0 + 2 * i + (lane >> 5)) * N + n0 + (lane & 31));
#pragma unroll
    for (int i = 0; i < 64; ++i) scr[(2 * i + (lane >> 5)) * 33 + (lane & 31)] = tv[i];
    LDS_WAIT(); asm volatile("" ::: "memory");
#pragma unroll
    for (int j = 0; j < 4; ++j) { const int id = lane + 64 * j, n = id >> 3, c = id & 7; const LAS float* s = scr + (16 * c) * 33 + n;
        int w[4];
#pragma unroll
        for (int q = 0; q < 4; ++q) { int t = __builtin_amdgcn_cvt_pk_fp8_f32(s[(4 * q) * 33] * W8_MUL, s[(4 * q + 1) * 33] * W8_MUL, 0, false); w[q] = __builtin_amdgcn_cvt_pk_fp8_f32(s[(4 * q + 2) * 33] * W8_MUL, s[(4 * q + 3) * 33] * W8_MUL, t, true); }
        *(u32x4*)(WT + (size_t)(dst_row0 + n) * Kdim + k0 + 16 * c) = (u32x4){(unsigned)w[0], (unsigned)w[1], (unsigned)w[2], (unsigned)w[3]}; }
    LDS_WAIT(); asm volatile("" ::: "memory");
}
__device__ __forceinline__ void p0_convert(const float* src, bf16_t* dst, size_t n8, size_t i0, size_t stride) {
    for (size_t i = i0; i < n8; i += 4 * stride) {
        f32x4 a[4], b[4];
#pragma unroll
        for (int j = 0; j < 4; ++j) { const size_t k = i + j * stride; if (k < n8) { a[j] = __builtin_nontemporal_load((const f32x4*)src + 2 * k); b[j] = __builtin_nontemporal_load((const f32x4*)src + 2 * k + 1); } }
#pragma unroll
        for (int j = 0; j < 4; ++j) { const size_t k = i + j * stride; if (k < n8) { u32x4 o; o.x = pk2(a[j][0], a[j][1]); o.y = pk2(a[j][2], a[j][3]); o.z = pk2(b[j][0], b[j][1]); o.w = pk2(b[j][2], b[j][3]); ((u32x4*)dst)[k] = o; } }
    }
}
__device__ __forceinline__ void phase_prep(const Frame& F, const Args& a) {
    LAS float* scr = (LAS float*)(F.lds + F.wave * 17408);
    const int gw = F.bid * NWAVES + F.wave, NGW = F.G * NWAVES;
    const float *w_in = a.in[2], *w_mix = a.in[6], *w_q = a.in[9], *w_kv = a.in[10], *w_o = a.in[11], *w_r = a.in[14], *w_gu = a.in[16], *w_d = a.in[18];
    bf16_t *WIN = (bf16_t*)(F.ws + WS_WIN), *WMIX = (bf16_t*)(F.ws + WS_WMIX), *WQN = (bf16_t*)(F.ws + WS_WQN), *WKV = (bf16_t*)(F.ws + WS_WKV), *WO = (bf16_t*)(F.ws + WS_WO),
           *WR = (bf16_t*)(F.ws + WS_WR); unsigned char *WGU = F.ws + WS_WGU, *WD = F.ws + WS_WD;
    constexpr int I_IN = 32 * (DIN / 32), I_MIX = 32 * 64, I_KV = 32 * 128, I_O = 32 * 64, I_R = 32, I_GU = 16 * 128, I_D = 16 * 64;
    constexpr int NITEMS = I_IN + I_MIX + I_KV + I_O + I_R + NEXP * I_GU + NEXP * I_D;
    for (int it = gw; it < NITEMS; it += NGW) {
        int r = it;
        if (r < I_IN) { const int nblk = DIN / 32, kb = r / nblk, nb = r % nblk; p0_transpose_item(w_in, 2048, DIN, WIN, nb * 32, kb * 64, nb * 32, scr, F.lane); continue; } r -= I_IN;
        if (r < I_MIX) { const int kb = r / 64, nb = r % 64; p0_transpose_item(w_mix, 2048, 2048, WMIX, nb * 32, kb * 64, nb * 32, scr, F.lane); continue; } r -= I_MIX;
        if (r < I_KV) { const int kb = r / 128, nb = r % 128; p0_transpose_item(w_kv, 2048, 4096, WKV, nb * 32, kb * 64, nb * 32, scr, F.lane); continue; } r -= I_KV;
        if (r < I_O) { const int kb = r / 64, nb = r % 64; p0_transpose_item(w_o, 2048, 2048, WO, nb * 32, kb * 64, nb * 32, scr, F.lane); continue; } r -= I_O;
        if (r < I_R) { p0_transpose_item(w_r, 2048, 32, WR, 0, r * 64, 0, scr, F.lane); continue; } r -= I_R;
        if (r < NEXP * I_GU) { const int e = r / I_GU, q = r % I_GU, kb = q / 128, nb = q % 128, n0 = nb * 32;
            const int dst = (n0 < 2048) ? ((n0 >> 7) * 256 + (n0 & 127)) : (((n0 - 2048) >> 7) * 256 + 128 + ((n0 - 2048) & 127));
            p0_transpose_item8(w_gu + (size_t)e * 2048 * 4096, 2048, 4096, WGU + (size_t)e * 4096 * 2048, dst, kb * 128, n0, scr, F.lane); continue; } r -= NEXP * I_GU;
        { const int e = r / I_D, q = r % I_D, kb = q / 64, nb = q % 64; p0_transpose_item8(w_d + (size_t)e * 2048 * 2048, 2048, 2048, WD + (size_t)e * 2048 * 2048, nb * 32, kb * 128, nb * 32, scr, F.lane); }
    }
    const size_t gt = (size_t)F.bid * NTHR + F.tid, NGT = (size_t)F.G * NTHR;
    p0_convert(w_q, WQN, (size_t)2048 * 2048 / 8, gt, NGT);
    p0_convert(a.in[0], (bf16_t*)(F.ws + WS_XB), (size_t)T * D / 8, gt, NGT);
    p0_convert(a.in[1], (bf16_t*)(F.ws + WS_MEMB), (size_t)512 * 2048 / 8, gt, NGT);
    for (size_t i = gt; i < (size_t)224 * 2048 / 8; i += NGT) ((u32x4*)(WR + 32 * 2048))[i] = (u32x4){0u, 0u, 0u, 0u};
}

constexpr int SWA_KRS = 144;
constexpr int SWA_PRS = 336;
constexpr int SWA_K_OFF = 0, SWA_V_OFF = 256 * SWA_KRS, SWA_P_OFF = 2 * 256 * SWA_KRS, SWA_SSQ_OFF = SWA_P_OFF + 8 * 16 * SWA_PRS;
static_assert(SWA_SSQ_OFF + 512 <= RING_BYTES, "swa lds");
__device__ __forceinline__ void swa_item(const Frame& F, const bf16_t* proj, bf16_t* y, const float* sinks, const float* normw, int b, int n) {
    LAS unsigned char* Kl = F.lds + SWA_K_OFF; LAS unsigned char* Vl = F.lds + SWA_V_OFF; LAS unsigned char* Pl = F.lds + SWA_P_OFF + F.wave * 16 * SWA_PRS;
    LAS float* ssq = (LAS float*)(F.lds + SWA_SSQ_OFF);
    const int lane = F.lane, fr = lane & 15, g = lane >> 4, q4 = (lane & 15) >> 2, p4 = lane & 3;
    const size_t tok0 = (size_t)b * SEQ + (size_t)n * 128;
    if (F.tid < 128) ssq[F.tid] = 0.f;
    for (int h = 0; h < 2; ++h) {
        __syncthreads();
#pragma unroll
        for (int i = 0; i < 4; ++i) { const int id = F.tid + 512 * i, key = id >> 3, c = id & 7;
            u32x4 kv = (u32x4){0u, 0u, 0u, 0u}, vv = kv;
            if (n > 0 || key >= 128) { const bf16_t* src = proj + (tok0 - 128 + key) * DIN + h * 64 + c * 8; kv = *(const u32x4*)(src + OFF_KA); vv = *(const u32x4*)(src + OFF_VA); }
            *(LAS u32x4*)(Kl + key * SWA_KRS + c * 16) = kv; *(LAS u32x4*)(Vl + key * SWA_KRS + c * 16) = vv; }
        __syncthreads();
        const int hq = h * 8 + F.wave;
        const float slope = exp2f(-0.5f * (float)(hq + 1)), sink = sinks[hq];
        for (int rt = 0; rt < 8; ++rt) {
            const int i0 = rt * 16, kt0 = rt < 6 ? rt : 6;
            bf16x8 qf[2];
#pragma unroll
            for (int ks = 0; ks < 2; ++ks) qf[ks] = *(const bf16x8*)(proj + (tok0 + i0 + fr) * DIN + OFF_QA + hq * 64 + ks * 32 + 8 * g);
            f32x4 s[10];
#pragma unroll
            for (int tt = 0; tt < 10; ++tt) { f32x4 acc = (f32x4){0.f, 0.f, 0.f, 0.f};
#pragma unroll
                for (int ks = 0; ks < 2; ++ks) { const bf16x8 kf = *(const LAS bf16x8*)(Kl + ((kt0 + tt) * 16 + fr) * SWA_KRS + (ks * 32 + 8 * g) * 2); acc = mfma16(qf[ks], kf, acc); }
                s[tt] = acc; }
            float mx[4] = {-1e30f, -1e30f, -1e30f, -1e30f};
#pragma unroll
            for (int tt = 0; tt < 10; ++tt)
#pragma unroll
                for (int r = 0; r < 4; ++r) { const int i = i0 + 4 * g + r, j = (kt0 + tt) * 16 + fr, dist = i + 128 - j;
                    const bool valid = dist >= 0 && dist < 128 && (n > 0 || j >= 128);
                    const float v = valid ? s[tt][r] * 0.125f - slope * (float)dist : -1e30f; s[tt][r] = v; mx[r] = fmaxf(mx[r], v); }
            float l[4];
#pragma unroll
            for (int r = 0; r < 4; ++r) { mx[r] = fmaxf(grp16_max(mx[r]), sink); l[r] = 0.f; }
#pragma unroll
            for (int tt = 0; tt < 10; ++tt)
#pragma unroll
                for (int r = 0; r < 4; ++r) { const float p = __expf(s[tt][r] - mx[r]); l[r] += p; *(LAS bf16_t*)(Pl + (4 * g + r) * SWA_PRS + (tt * 16 + fr) * 2) = (bf16_t)f2bf(p); }
#pragma unroll
            for (int r = 0; r < 4; ++r) l[r] = grp16_sum(l[r]) + __expf(sink - mx[r]);
            f32x4 o[4];
#pragma unroll
            for (int dt = 0; dt < 4; ++dt) o[dt] = (f32x4){0.f, 0.f, 0.f, 0.f};
#pragma unroll
            for (int kk = 0; kk < 5; ++kk) { const bf16x8 pf = *(const LAS bf16x8*)(Pl + fr * SWA_PRS + (kk * 32 + 8 * g) * 2);
#pragma unroll
                for (int dt = 0; dt < 4; ++dt) { const bf16x8 vf = tr_frag(Vl + (kt0 * 16 + kk * 32 + 8 * g + q4) * SWA_KRS + (dt * 16 + 4 * p4) * 2, 4 * SWA_KRS); o[dt] = mfma16(pf, vf, o[dt]); } }
            float sq[4] = {0.f, 0.f, 0.f, 0.f};
#pragma unroll
            for (int r = 0; r < 4; ++r) { const float il = 1.0f / l[r];
#pragma unroll
                for (int dt = 0; dt < 4; ++dt) { const float v = o[dt][r] * il; sq[r] += v * v; y[(tok0 + i0 + 4 * g + r) * 2048 + hq * 64 + dt * 16 + fr] = (bf16_t)f2bf(v); } }
#pragma unroll
            for (int r = 0; r < 4; ++r) { const float t = grp16_sum(sq[r]); if (fr == 0) atomicAdd((float*)&ssq[i0 + 4 * g + r], t); }
        }
    }
    VM_WAIT(); __syncthreads();
    for (int id = F.tid; id < 128 * 128; id += NTHR) { const int tk = id >> 7, c = id & 127; const float rs = 1.0f / sqrtf(ssq[tk] * (1.0f / 1024.0f) + LN_EPS);
        bf16_t* p = y + (tok0 + tk) * 2048 + c * 8; const u32x4 v = *(const u32x4*)p; const f32x4 w0 = *(const f32x4*)(normw + c * 8), w1 = *(const f32x4*)(normw + c * 8 + 4);
        u32x4 o; o.x = pk2(bf2f(v.x & 0xffffu) * rs * w0[0], bf2f(v.x >> 16) * rs * w0[1]); o.y = pk2(bf2f(v.y & 0xffffu) * rs * w0[2], bf2f(v.y >> 16) * rs * w0[3]);
        o.z = pk2(bf2f(v.z & 0xffffu) * rs * w1[0], bf2f(v.z >> 16) * rs * w1[1]); o.w = pk2(bf2f(v.w & 0xffffu) * rs * w1[2], bf2f(v.w >> 16) * rs * w1[3]);
        *(u32x4*)p = o; }
    __syncthreads();
}

constexpr int RET_RS = 272;
constexpr int RET_TILE = 128 * RET_RS;
__device__ __forceinline__ float ret_log2g(int h) { return log2f(1.0f - exp2f(-5.0f - (float)h)); }
__device__ __forceinline__ void phase_ret_u(const Frame& F, const bf16_t* proj, float* Ut) {
    LAS unsigned char* Kl = F.lds; LAS unsigned char* Vl = F.lds + RET_TILE;
    const int lane = F.lane, fr = lane & 15, g = lane >> 4, q4 = (lane & 15) >> 2, p4 = lane & 3, w = F.wave;
    constexpr int NIT = BATCH * NCH * 8;
    u32x4 kr[4], vr[4];
    int it = F.bid;
    if (it < NIT) { const size_t tok0 = (size_t)(it / (NCH * 8)) * SEQ + (size_t)((it >> 3) % NCH) * 128; const int h = it & 7;
#pragma unroll
        for (int i = 0; i < 4; ++i) { const int id = F.tid + 512 * i, key = id >> 4, ch = id & 15; const bf16_t* src = proj + (tok0 + key) * DIN + h * 128 + ch * 8; kr[i] = *(const u32x4*)(src + OFF_KR); vr[i] = *(const u32x4*)(src + OFF_VR); } }
    for (; it < NIT; it += F.G) {
        const int b = it / (NCH * 8), c = (it >> 3) % NCH, h = it & 7; const float l2g = ret_log2g(h);
        __syncthreads();
#pragma unroll
        for (int i = 0; i < 4; ++i) { const int id = F.tid + 512 * i, key = id >> 4, ch = id & 15; const u32x4 kv = kr[i];
            const float wk = exp2f(l2g * (float)(127 - key)) * 0.08838834764831845f;
            u32x4 ks; ks.x = pk2(bf2f(kv.x & 0xffffu) * wk, bf2f(kv.x >> 16) * wk); ks.y = pk2(bf2f(kv.y & 0xffffu) * wk, bf2f(kv.y >> 16) * wk);
            ks.z = pk2(bf2f(kv.z & 0xffffu) * wk, bf2f(kv.z >> 16) * wk); ks.w = pk2(bf2f(kv.w & 0xffffu) * wk, bf2f(kv.w >> 16) * wk);
            *(LAS u32x4*)(Kl + key * RET_RS + ch * 16) = ks; *(LAS u32x4*)(Vl + key * RET_RS + ch * 16) = vr[i]; }
        { const int nx = it + F.G; if (nx < NIT) { const size_t tok0 = (size_t)(nx / (NCH * 8)) * SEQ + (size_t)((nx >> 3) % NCH) * 128; const int hn = nx & 7;
#pragma unroll
            for (int i = 0; i < 4; ++i) { const int id = F.tid + 512 * i, key = id >> 4, ch = id & 15; const bf16_t* src = proj + (tok0 + key) * DIN + hn * 128 + ch * 8; kr[i] = *(const u32x4*)(src + OFF_KR); vr[i] = *(const u32x4*)(src + OFF_VR); } } }
        __syncthreads();
        f32x4 acc[8];
#pragma unroll
        for (int et = 0; et < 8; ++et) acc[et] = (f32x4){0.f, 0.f, 0.f, 0.f};
#pragma unroll
        for (int kk = 0; kk < 4; ++kk) { const bf16x8 af = tr_frag(Kl + (kk * 32 + 8 * g + q4) * RET_RS + (w * 16 + 4 * p4) * 2, 4 * RET_RS);
#pragma unroll
            for (int et = 0; et < 8; ++et) { const bf16x8 bf = tr_frag(Vl + (kk * 32 + 8 * g + q4) * RET_RS + (et * 16 + 4 * p4) * 2, 4 * RET_RS); acc[et] = mfma16(af, bf, acc[et]); } }
        float* dst = Ut + (((size_t)b * NCH + c) * 8 + h) * 16384;
#pragma unroll
        for (int et = 0; et < 8; ++et) *(f32x4*)(dst + (et * 16 + fr) * 128 + w * 16 + 4 * g) = acc[et];
    }
    __syncthreads();
}
__device__ __forceinline__ void phase_scan(const Frame& F, const float* Ut, bf16_t* Rt) {
    const int gt = F.bid * NTHR + F.tid;
    for (int e2 = gt; e2 < 2 * 8 * 8192; e2 += F.G * NTHR) {
        const int b = e2 >> 16, h = (e2 >> 13) & 7, ed = (e2 & 8191) * 2;
        const float gC = exp2f(ret_log2g(h) * 128.0f);
        const float* up = Ut + ((size_t)b * NCH * 8 + h) * 16384 + ed; bf16_t* rp = Rt + ((size_t)b * NCH * 8 + h) * 16384 + ed;
        f32x2 st = (f32x2){0.f, 0.f};
        for (int c0 = 0; c0 < NCH; c0 += 8) {
            f32x2 u[8];
#pragma unroll
            for (int j = 0; j < 8; ++j) u[j] = *(const f32x2*)(up + (size_t)(c0 + j) * 8 * 16384);
#pragma unroll
            for (int j = 0; j < 8; ++j) { *(unsigned*)(rp + (size_t)(c0 + j) * 8 * 16384) = pk2(st.x, st.y); st = st * gC + u[j]; }
        }
    }
}
__device__ __forceinline__ void phase_ret_o(const Frame& F, const bf16_t* proj, const bf16_t* Rt, bf16_t* y, const float* normw) {
    LAS unsigned char* Kl = F.lds; LAS unsigned char* Vl = F.lds + RET_TILE; LAS unsigned char* Rl = F.lds + 2 * RET_TILE; LAS unsigned char* Sl = F.lds + 3 * RET_TILE + F.wave * 16 * RET_RS;
    const int lane = F.lane, fr = lane & 15, g = lane >> 4, q4 = (lane & 15) >> 2, p4 = lane & 3, w = F.wave;
    constexpr int NIT = BATCH * NCH * 8;
    u32x4 kr[4], vr[4], rr[4]; bf16x8 qf[4];
#define RETO_ISSUE(item) do { const int b_ = (item) / (NCH * 8), c_ = ((item) >> 3) % NCH, h_ = (item) & 7; const size_t tok0_ = (size_t)b_ * SEQ + (size_t)c_ * 128; const bf16_t* rsrc_ = Rt + (((size_t)b_ * NCH + c_) * 8 + h_) * 16384; \
        _Pragma("unroll") for (int i = 0; i < 4; ++i) { const int id = F.tid + 512 * i, key = id >> 4, ch = id & 15; const bf16_t* src = proj + (tok0_ + key) * DIN + h_ * 128 + ch * 8; \
            kr[i] = *(const u32x4*)(src + OFF_KR); vr[i] = *(const u32x4*)(src + OFF_VR); rr[i] = *(const u32x4*)(rsrc_ + key * 128 + ch * 8); } } while (0)
#define RETO_ISSUE_Q(item) do { const int b_ = (item) / (NCH * 8), c_ = ((item) >> 3) % NCH, h_ = (item) & 7; const size_t tok0_ = (size_t)b_ * SEQ + (size_t)c_ * 128; \
        _Pragma("unroll") for (int kk = 0; kk < 4; ++kk) qf[kk] = *(const bf16x8*)(proj + (tok0_ + w * 16 + fr) * DIN + OFF_QR + h_ * 128 + kk * 32 + 8 * g); } while (0)
    int it = F.bid;
    if (it < NIT) { RETO_ISSUE(it); RETO_ISSUE_Q(it); }
    for (; it < NIT; it += F.G) {
        const int b = it / (NCH * 8), c = (it >> 3) % NCH, h = it & 7; const float l2g = ret_log2g(h);
        const size_t tok0 = (size_t)b * SEQ + (size_t)c * 128;
        __syncthreads();
#pragma unroll
        for (int i = 0; i < 4; ++i) { const int id = F.tid + 512 * i, key = id >> 4, ch = id & 15;
            *(LAS u32x4*)(Kl + key * RET_RS + ch * 16) = kr[i]; *(LAS u32x4*)(Vl + key * RET_RS + ch * 16) = vr[i]; *(LAS u32x4*)(Rl + key * RET_RS + ch * 16) = rr[i]; }
        { const float wqr = exp2f(l2g * (float)(w * 16 + fr + 1));
#pragma unroll
            for (int kk = 0; kk < 4; ++kk) { const u32x4 qv = __builtin_bit_cast(u32x4, qf[kk]); u32x4 o;
                o.x = pk2(bf2f(qv.x & 0xffffu) * wqr, bf2f(qv.x >> 16) * wqr); o.y = pk2(bf2f(qv.y & 0xffffu) * wqr, bf2f(qv.y >> 16) * wqr);
                o.z = pk2(bf2f(qv.z & 0xffffu) * wqr, bf2f(qv.z >> 16) * wqr); o.w = pk2(bf2f(qv.w & 0xffffu) * wqr, bf2f(qv.w >> 16) * wqr); qf[kk] = __builtin_bit_cast(bf16x8, o); } }
        { const int nx = it + F.G; if (nx < NIT) RETO_ISSUE(nx); }
        __syncthreads();
#pragma unroll
        for (int kt = 0; kt < 8; ++kt) {
            f32x4 acc = (f32x4){0.f, 0.f, 0.f, 0.f};
            if (kt <= w) {
#pragma unroll
                for (int kk = 0; kk < 4; ++kk) { const bf16x8 kf = *(const LAS bf16x8*)(Kl + (kt * 16 + fr) * RET_RS + (kk * 32 + 8 * g) * 2); acc = mfma16(qf[kk], kf, acc); }
            }
#pragma unroll
            for (int r = 0; r < 4; ++r) { const int qi = w * 16 + 4 * g + r, kj = kt * 16 + fr, df = qi - kj;
                const float v = df >= 0 ? acc[r] * 0.08838834764831845f * exp2f(-l2g * (float)(kj + 1)) : 0.f;
                *(LAS bf16_t*)(Sl + (4 * g + r) * RET_RS + kj * 2) = (bf16_t)f2bf(v); }
        }
        f32x4 oi[8];
#pragma unroll
        for (int et = 0; et < 8; ++et) oi[et] = (f32x4){0.f, 0.f, 0.f, 0.f};
#pragma unroll
        for (int kk = 0; kk < 4; ++kk) {
            if (2 * kk <= w) { const bf16x8 sf = *(const LAS bf16x8*)(Sl + fr * RET_RS + (kk * 32 + 8 * g) * 2);
#pragma unroll
                for (int et = 0; et < 8; ++et) { const bf16x8 vf = tr_frag(Vl + (kk * 32 + 8 * g + q4) * RET_RS + (et * 16 + 4 * p4) * 2, 4 * RET_RS); oi[et] = mfma16(sf, vf, oi[et]); } }
#pragma unroll
            for (int et = 0; et < 8; ++et) { const bf16x8 rf = *(const LAS bf16x8*)(Rl + (et * 16 + fr) * RET_RS + (kk * 32 + 8 * g) * 2); oi[et] = mfma16(qf[kk], rf, oi[et]); }
        }
        { const int nx = it + F.G; if (nx < NIT) RETO_ISSUE_Q(nx); }
        u32x4 gc[4];
#pragma unroll
        for (int j = 0; j < 4; ++j) { const int id = lane + 64 * j; gc[j] = *(const u32x4*)(proj + (tok0 + w * 16 + (id >> 4)) * DIN + OFF_GR + h * 128 + 8 * (id & 15)); }
#pragma unroll
        for (int r = 0; r < 4; ++r) {
            float v[8], sm = 0.f;
#pragma unroll
            for (int et = 0; et < 8; ++et) { v[et] = oi[et][r]; sm += v[et]; }
            const float mu = grp16_sum(sm) * (1.0f / 128.0f); float qv = 0.f;
#pragma unroll
            for (int et = 0; et < 8; ++et) { v[et] -= mu; qv += v[et] * v[et]; }
            const float rstd = 1.0f / sqrtf(grp16_sum(qv) * (1.0f / 128.0f) + LN_EPS);
#pragma unroll
            for (int et = 0; et < 8; ++et) *(LAS bf16_t*)(Sl + (4 * g + r) * RET_RS + (et * 16 + fr) * 2) = (bf16_t)f2bf(v[et] * rstd); }
#pragma unroll
        for (int j = 0; j < 4; ++j) { const int id = lane + 64 * j, row = id >> 4, e0 = 8 * (id & 15); const u32x4 ov = *(const LAS u32x4*)(Sl + row * RET_RS + e0 * 2); const u32x4 gv = gc[j];
            const f32x4 w0 = *(const f32x4*)(normw + h * 128 + e0), w1 = *(const f32x4*)(normw + h * 128 + e0 + 4);
            const unsigned ow[4] = {ov.x, ov.y, ov.z, ov.w}, gw[4] = {gv.x, gv.y, gv.z, gv.w}; unsigned res[4];
#pragma unroll
            for (int q = 0; q < 4; ++q) { const float g0 = bf2f(gw[q] & 0xffffu), g1 = bf2f(gw[q] >> 16); const float s0 = g0 * __builtin_amdgcn_rcpf(1.0f + __expf(-g0)), s1 = g1 * __builtin_amdgcn_rcpf(1.0f + __expf(-g1));
                const float wa = q < 2 ? w0[2 * q] : w1[2 * q - 4], wb = q < 2 ? w0[2 * q + 1] : w1[2 * q - 3];
                res[q] = pk2(bf2f(ow[q] & 0xffffu) * wa * s0, bf2f(ow[q] >> 16) * wb * s1); }
            *(u32x4*)(y + (tok0 + w * 16 + row) * 2048 + 1024 + h * 128 + e0) = (u32x4){res[0], res[1], res[2], res[3]}; }
    }
#undef RETO_ISSUE
#undef RETO_ISSUE_Q
    __syncthreads();
}

__device__ __forceinline__ void phase_ln(const Frame& F, const bf16_t* z, const float* w, const float* bb, bf16_t* xb, unsigned char* xq) {
    const int gw = F.bid * NWAVES + F.wave, NGW = F.G * NWAVES;
    for (int m = gw; m < T; m += NGW) {
        const u32x4* zr = (const u32x4*)(z + (size_t)m * D) + F.lane; float v[4][8]; float s = 0.f;
#pragma unroll
        for (int j = 0; j < 4; ++j) { const u32x4 p = zr[64 * j]; v[j][0] = bf2f(p.x & 0xffffu); v[j][1] = bf2f(p.x >> 16); v[j][2] = bf2f(p.y & 0xffffu); v[j][3] = bf2f(p.y >> 16);
            v[j][4] = bf2f(p.z & 0xffffu); v[j][5] = bf2f(p.z >> 16); v[j][6] = bf2f(p.w & 0xffffu); v[j][7] = bf2f(p.w >> 16);
#pragma unroll
            for (int i = 0; i < 8; ++i) s += v[j][i]; }
        const float mean = wave_sum(s) * (1.0f / D); float q = 0.f;
#pragma unroll
        for (int j = 0; j < 4; ++j)
#pragma unroll
            for (int i = 0; i < 8; ++i) { v[j][i] -= mean; q += v[j][i] * v[j][i]; }
        const float rstd = 1.0f / sqrtf(wave_sum(q) * (1.0f / D) + LN_EPS);
#pragma unroll
        for (int j = 0; j < 4; ++j) { const int c0 = 8 * (F.lane + 64 * j); const f32x4 w0 = *(const f32x4*)(w + c0), w1 = *(const f32x4*)(w + c0 + 4), b0 = *(const f32x4*)(bb + c0), b1 = *(const f32x4*)(bb + c0 + 4);
            float o[8];
#pragma unroll
            for (int i = 0; i < 4; ++i) { o[i] = v[j][i] * rstd * w0[i] + b0[i]; o[4 + i] = v[j][4 + i] * rstd * w1[i] + b1[i]; }
            u32x4 p; p.x = pk2(o[0], o[1]); p.y = pk2(o[2], o[3]); p.z = pk2(o[4], o[5]); p.w = pk2(o[6], o[7]); ((u32x4*)(xb + (size_t)m * D))[F.lane + 64 * j] = p;
            if (xq) { int t0 = __builtin_amdgcn_cvt_pk_fp8_f32(o[0], o[1], 0, false); t0 = __builtin_amdgcn_cvt_pk_fp8_f32(o[2], o[3], t0, true);
                int t1 = __builtin_amdgcn_cvt_pk_fp8_f32(o[4], o[5], 0, false); t1 = __builtin_amdgcn_cvt_pk_fp8_f32(o[6], o[7], t1, true); ((u32x2*)(xq + (size_t)m * D))[F.lane + 64 * j] = (u32x2){(unsigned)t0, (unsigned)t1}; } }
    }
}
__device__ __forceinline__ void phase_softmax(const Frame& F, bf16_t* sp) {
    const int gw = F.bid * NWAVES + F.wave, NGW = F.G * NWAVES;
    for (int m = gw; m < T; m += NGW) {
#pragma unroll
        for (int h = 0; h < 4; ++h) { u32x2* p = (u32x2*)(sp + (size_t)m * 1024 + h * 256) + F.lane; const u32x2 v = *p;
            float a0 = bf2f(v.x & 0xffffu), a1 = bf2f(v.x >> 16), a2 = bf2f(v.y & 0xffffu), a3 = bf2f(v.y >> 16);
            const float mx = wave_max(fmaxf(fmaxf(a0, a1), fmaxf(a2, a3)));
            a0 = __expf(a0 - mx); a1 = __expf(a1 - mx); a2 = __expf(a2 - mx); a3 = __expf(a3 - mx);
            const float il = 1.0f / wave_sum((a0 + a1) + (a2 + a3));
            u32x2 o; o.x = pk2(a0 * il, a1 * il); o.y = pk2(a2 * il, a3 * il); *p = o; }
    }
}
__device__ __forceinline__ void phase_route1(const Frame& F, const float* logits, int* tok_e, int* tok_p, float* gates, int* slot_tok, unsigned* gcnt) {
    LAS float* lg = (LAS float*)F.lds;
    LAS int* lcnt = (LAS int*)(F.lds + 128 * 33 * 4); LAS int* lbase = lcnt + 32;
    for (int i = F.bid * NTHR + F.tid; i < NSLOT; i += F.G * NTHR) slot_tok[i] = 0;
    for (int t0 = F.bid * 128; t0 < T; t0 += F.G * 128) {
        __syncthreads();
        for (int i = F.tid; i < 128 * 32; i += NTHR) lg[(i >> 5) * 33 + (i & 31)] = logits[(size_t)t0 * 32 + i] + logits[(size_t)T * 32 + (size_t)t0 * 32 + i];
        if (F.tid < 32) lcnt[F.tid] = 0;
        __syncthreads();
        int id[4] = {0, 0, 0, 0}, lp[4] = {0, 0, 0, 0}; float v[4] = {0.f, 0.f, 0.f, 0.f};
        if (F.tid < 128) {
            unsigned used = 0u;
#pragma unroll
            for (int k = 0; k < 4; ++k) { float best = -3.0e38f; int bi = 0;
                for (int e = 0; e < 32; ++e) { const float x = lg[F.tid * 33 + e]; if (!((used >> e) & 1u) && x > best) { best = x; bi = e; } }
                used |= 1u << bi; v[k] = best; id[k] = bi; }
            float ex[4], sum = 0.f;
#pragma unroll
            for (int k = 0; k < 4; ++k) { ex[k] = __expf(v[k] - v[0]); sum += ex[k]; }
#pragma unroll
            for (int k = 0; k < 4; ++k) { gates[(size_t)(t0 + F.tid) * 4 + k] = ex[k] / sum; lp[k] = atomicAdd((int*)&lcnt[id[k]], 1); }
        }
        __syncthreads();
        if (F.tid < 32) lbase[F.tid] = (int)__hip_atomic_fetch_add(gcnt + F.tid, (unsigned)lcnt[F.tid], __ATOMIC_RELAXED, __HIP_MEMORY_SCOPE_AGENT);
        __syncthreads();
        if (F.tid < 128) {
#pragma unroll
            for (int k = 0; k < 4; ++k) { tok_e[(size_t)(t0 + F.tid) * 4 + k] = id[k]; tok_p[(size_t)(t0 + F.tid) * 4 + k] = lbase[id[k]] + lp[k]; }
        }
    }
}
__device__ __forceinline__ void moe_tables(const Frame& F, unsigned* gcnt, LAS int* pstart, LAS int* blkexp) {
    __syncthreads();
    if (F.tid == 0) { int acc = 0; for (int e = 0; e < 32; ++e) { pstart[e] = acc; const int cnt = (int)__hip_atomic_load(gcnt + e, __ATOMIC_RELAXED, __HIP_MEMORY_SCOPE_AGENT); acc += ((cnt + 255) >> 8) << 8; } pstart[32] = acc; }
    __syncthreads();
    for (int j = F.tid; j < NBLK_MAX; j += NTHR) { int e = 0; for (int k = 1; k < 32; ++k) if (pstart[k] <= j * 256) e = k; blkexp[j] = e; }
    __syncthreads();
}
__device__ __forceinline__ void phase_route2(const Frame& F, const int* tok_e, const int* tok_p, int* inv, int* slot_tok, unsigned* gcnt) {
    LAS int* pstart = (LAS int*)(F.lds + TAB_OFF); LAS int* blkexp = pstart + 64;
    moe_tables(F, gcnt, pstart, blkexp);
    for (int i = F.bid * NTHR + F.tid; i < T * 4; i += F.G * NTHR) { const int e = tok_e[i], dest = pstart[e] + tok_p[i]; inv[i] = dest; slot_tok[dest] = i >> 2; }
}
__device__ __forceinline__ void phase_final(const Frame& F, const bf16_t* x2b, const bf16_t* ys, const int* inv, const float* gates, const float* w, const float* bb, float* out) {
    const int gw = F.bid * NWAVES + F.wave, NGW = F.G * NWAVES;
    for (int m = gw; m < T; m += NGW) {
        const u32x2* xr = (const u32x2*)(x2b + (size_t)m * D) + F.lane; f32x4 v[8];
#pragma unroll
        for (int j = 0; j < 8; ++j) { const u32x2 p = xr[64 * j]; v[j] = (f32x4){bf2f(p.x & 0xffffu), bf2f(p.x >> 16), bf2f(p.y & 0xffffu), bf2f(p.y >> 16)} * DN_ALPHA; }
#pragma unroll
        for (int k = 0; k < 4; ++k) { const int s = inv[(size_t)m * 4 + k]; const float gk = gates[(size_t)m * 4 + k]; const u32x2* yr = (const u32x2*)(ys + (size_t)s * D) + F.lane;
#pragma unroll
            for (int j = 0; j < 8; ++j) { const u32x2 p = yr[64 * j]; v[j][0] += gk * bf2f(p.x & 0xffffu); v[j][1] += gk * bf2f(p.x >> 16); v[j][2] += gk * bf2f(p.y & 0xffffu); v[j][3] += gk * bf2f(p.y >> 16); } }
        float s = 0.f;
#pragma unroll
        for (int j = 0; j < 8; ++j) s += (v[j][0] + v[j][1]) + (v[j][2] + v[j][3]);
        const float mean = wave_sum(s) * (1.0f / D); float q = 0.f;
#pragma unroll
        for (int j = 0; j < 8; ++j) { v[j] = v[j] - mean; q += (v[j][0] * v[j][0] + v[j][1] * v[j][1]) + (v[j][2] * v[j][2] + v[j][3] * v[j][3]); }
        const float rstd = 1.0f / sqrtf(wave_sum(q) * (1.0f / D) + LN_EPS);
#pragma unroll
        for (int j = 0; j < 8; ++j) { const f32x4 ww = ((const f32x4*)w)[F.lane + 64 * j], b4 = ((const f32x4*)bb)[F.lane + 64 * j]; ((f32x4*)(out + (size_t)m * D))[F.lane + 64 * j] = v[j] * rstd * ww + b4; }
    }
}

constexpr int NPHASE = 17;
__global__ void __launch_bounds__(NTHR, 2) fwd_kernel(Args args) {
    extern __shared__ __attribute__((aligned(16))) unsigned char lds_raw[];
    Frame F; F.lds = (LAS unsigned char*)lds_raw; F.tid = threadIdx.x; F.lane = F.tid & 63; F.wave = __builtin_amdgcn_readfirstlane(F.tid >> 6); F.G = gridDim.x; F.bid = blockIdx.x; F.ws = args.ws;
    unsigned* ctl = (unsigned*)(args.ws + WS_CTL);
    volatile LAS unsigned* MISC = (volatile LAS unsigned*)(F.lds + MISC_OFF);
    if (F.tid < 32) MISC[F.tid] = 0u;
    __syncthreads();
    XcdBarrier bar; bar.bar = ctl + CW_BAR; bar.x = 0; bar.st = MISC + 8;
    if (MK_FUSED) bar = xcd_barrier_post(ctl + CW_BAR, MISC + 8);
    const int lo = args.ph_lo, hi = args.ph_hi;
#define IN(k) (lo <= (k) && (k) < hi)
#define DUPK(k) ((DUP_MASK >> (k)) & 1)
#define SEAM(k) do { if (IN(k) && IN((k) + 1)) xcd_barrier(bar); } while (0)
    unsigned char* ws = args.ws;
    bf16_t* xb = (bf16_t*)(ws + WS_XB); bf16_t* proj = (bf16_t*)(ws + WS_PROJ); bf16_t* y = (bf16_t*)(ws + WS_Y); bf16_t* z = (bf16_t*)(ws + WS_Z);
    bf16_t* x1b = (bf16_t*)(ws + WS_X1B); bf16_t* x2b = (bf16_t*)(ws + WS_X2B);
    bf16_t* kv = (bf16_t*)(ws + WS_KV); unsigned char* wqk = ws + WS_WQK; unsigned char* wvo = ws + WS_WVO; unsigned char* sp = ws + WS_SP; unsigned char* x1q = ws + WS_SP + 32 * MiB;
    float* Ut = (float*)(ws + WS_U); bf16_t* Rt = (bf16_t*)(ws + WS_RT);
    float* logits = (float*)(ws + WS_SMALL + SM_LOGITS); int* tok_e = (int*)(ws + WS_SMALL + SM_TOKE); int* tok_p = (int*)(ws + WS_SMALL + SM_TOKP);
    float* gates = (float*)(ws + WS_SMALL + SM_GATE); int* inv = (int*)(ws + WS_SMALL + SM_INV); int* slot_tok = (int*)(ws + WS_SMALL + SM_SLOT);
    unsigned char* act = ws + WS_ACT; bf16_t* ysl = (bf16_t*)(ws + WS_YS); unsigned char* x2q = ws + WS_X2Q;
    unsigned* gcnt = ctl + CW_CNT;
    LAS unsigned char* idxtab = F.lds + IDX_OFF;

    if (IN(0)) { phase_prep(F, args); if (DUPK(0)) { __syncthreads(); phase_prep(F, args); } } SEAM(0);
    if (IN(1)) {
        { pg8::ProbStd P; P.init((const bf16_t*)(ws + WS_MEMB), (const bf16_t*)(ws + WS_WKV), 512, 4096, 2048, 2048, 2048, F.G, (F.bid + 128) % F.G); pg8::EpiBf16 E{kv, 4096, nullptr, 0, 1.0f}; pg8::gemm_phase(F.lds, idxtab, P, E); }
        { pg8::ProbStd P; P.init(xb, (const bf16_t*)(ws + WS_WIN), T, DIN, 2048, 2048, 2048, F.G, F.bid); pg8::EpiBf16 E{proj, DIN, nullptr, 0, 1.0f}; pg8::gemm_phase(F.lds, idxtab, P, E); }
    } SEAM(1);
#define P2_BODY \
        for (int it = F.bid; it < BATCH * NCH; it += F.G) swa_item(F, proj, y, args.in[3], args.in[4], it / NCH, it % NCH); \
        phase_ret_u(F, proj, Ut); \
        { pg8::ProbFoldA P{kv, (const bf16_t*)(ws + WS_WQN), 512, 4096, 2048, F.G, F.bid}; pg8::EpiFp8 E{wqk, 2048, 0.04419417382415922f * W8_MUL}; pg8::gemm_phase(F.lds, idxtab, P, E); } \
        { pg8::ProbFoldB P{(const bf16_t*)(ws + WS_WO), kv, 512, 2048, 4096, F.G, (F.bid + 192) % F.G}; pg8::EpiFp8 E{wvo, 1024, W8_MUL}; pg8::gemm_phase(F.lds, idxtab, P, E); }
    if (IN(2)) { P2_BODY if (DUPK(2)) { __syncthreads(); P2_BODY }
    } SEAM(2);
    if (IN(3)) { phase_scan(F, Ut, Rt); if (DUPK(3)) phase_scan(F, Ut, Rt); } SEAM(3);
    #define P4_BODY { phase_ret_o(F, proj, Rt, y, args.in[5]); }
    if (IN(4)) { P4_BODY if (DUPK(4)) P4_BODY } SEAM(4);
    if (IN(5)) { pg8::ProbStd P; P.init(y, (const bf16_t*)(ws + WS_WMIX), T, 2048, 2048, 2048, 2048, F.G, F.bid); pg8::EpiResBf16 E{xb, z, 2048, DN_ALPHA}; pg8::gemm_phase(F.lds, idxtab, P, E); } SEAM(5);
    if (IN(6)) { phase_ln(F, z, args.in[7], args.in[8], x1b, x1q); if (DUPK(6)) phase_ln(F, z, args.in[7], args.in[8], x1b, x1q); } SEAM(6);
    if (IN(7)) { pg8::ProbStdT<true> P; P.init(x1q, wqk, T, 1024, 2048, 2048, 2048, F.G, F.bid); P.split_pm = 64; P.b_split_stride = (size_t)1024 * 2048; pg8::EpiSoftmax E{sp, 1024, (LAS float*)(F.lds + SMX_OFF)}; pg8::gemm_phase(F.lds, idxtab, P, E); } SEAM(7);
    if (IN(9)) { pg8::ProbStdT<true, 0x77777777> P; P.init(sp, wvo, T, 2048, 1024, 1024, 1024, F.G, F.bid); P.split_pm = 64; P.b_split_stride = (size_t)2048 * 1024; pg8::EpiResBf16 E{x1b, z, 2048, DN_ALPHA}; pg8::gemm_phase(F.lds, idxtab, P, E); } SEAM(9);
    if (IN(10)) { phase_ln(F, z, args.in[12], args.in[13], x2b, x2q); if (DUPK(10)) phase_ln(F, z, args.in[12], args.in[13], x2b, x2q); } SEAM(10);
    if (IN(11)) { pg8::ProbRouter P{x2b, (const bf16_t*)(ws + WS_WR), 1024, 2048, 2048, F.G, F.bid}; pg8::EpiRouter E{logits, args.in[15]}; pg8::gemm_phase(F.lds, idxtab, P, E); } SEAM(11);
    if (IN(12)) { phase_route1(F, logits, tok_e, tok_p, gates, slot_tok, gcnt); } SEAM(12);
    if (IN(13)) { phase_route2(F, tok_e, tok_p, inv, slot_tok, gcnt); } SEAM(13);
    if (IN(14)) {
        LAS int* pstart = (LAS int*)(F.lds + TAB_OFF); LAS int* blkexp = pstart + 64; moe_tables(F, gcnt, pstart, blkexp);
        pg8::ProbMoe<true> P; P.A = x2q; P.W = ws + WS_WGU; P.slot_tok = slot_tok; P.blkexp = blkexp; P.K = 2048; P.lda = 2048; P.ldb = 2048; P.S.init(pstart[32] >> 8, 16, F.G, F.bid);
        pg8::EpiSwiglu E{act, args.in[17]}; pg8::gemm_phase(F.lds, idxtab, P, E);
    } SEAM(14);
    if (IN(15)) {
        LAS int* pstart = (LAS int*)(F.lds + TAB_OFF); LAS int* blkexp = pstart + 64; moe_tables(F, gcnt, pstart, blkexp);
        pg8::ProbMoe<false> P; P.A = act; P.W = ws + WS_WD; P.slot_tok = slot_tok; P.blkexp = blkexp; P.K = 2048; P.lda = 2048; P.ldb = 2048; P.S.init(pstart[32] >> 8, 8, F.G, F.bid);
        pg8::EpiBf16 E{ysl, 2048, args.in[19], 2048, 1.0f}; pg8::gemm_phase(F.lds, idxtab, P, E);
    } SEAM(15);
    if (IN(16)) { phase_final(F, x2b, ysl, inv, gates, args.in[20], args.in[21], args.out); if (DUPK(16)) phase_final(F, x2b, ysl, inv, gates, args.in[20], args.in[21], args.out); }
#undef IN
#undef SEAM
}

extern "C" void kernel_launch(void* const* d_in, const int* in_sizes, int n_in, void* d_out, int out_size, void* d_ws, size_t ws_size, hipStream_t stream) {
    static int grid = 0;
    if (grid == 0) {
        if (n_in != 22 || out_size != T * D || ws_size < WS_END) { fprintf(stderr, "kernel_launch: unexpected shapes (n_in %d out %d ws %zu need %zu)\n", n_in, out_size, ws_size, (size_t)WS_END); grid = -1; return; }
        int dev = 0, cus = 0, per_cu = 0;
        if (hipGetDevice(&dev) != hipSuccess || hipDeviceGetAttribute(&cus, hipDeviceAttributeMultiprocessorCount, dev) != hipSuccess) { grid = -1; return; }
        if (hipFuncSetAttribute((const void*)fwd_kernel, hipFuncAttributeMaxDynamicSharedMemorySize, LDS_BYTES) != hipSuccess) { fprintf(stderr, "kernel_launch: hipFuncSetAttribute failed\n"); grid = -1; return; }
        if (hipOccupancyMaxActiveBlocksPerMultiprocessor(&per_cu, (const void*)fwd_kernel, NTHR, LDS_BYTES) != hipSuccess || per_cu < 1) fprintf(stderr, "kernel_launch: occupancy query reports %d\n", per_cu);
        (void)hipGetLastError();
        grid = cus;
    }
    if (grid < 0) return;
    (void)hipMemsetAsync((char*)d_ws + WS_CTL, 0, CTL_ZERO_BYTES, stream);
    Args a{};
    for (int i = 0; i < 22; ++i) a.in[i] = (const float*)d_in[i];
    a.out = (float*)d_out; a.ws = (unsigned char*)d_ws;
#if MK_FUSED
    a.ph_lo = 0; a.ph_hi = NPHASE;
    hipLaunchKernelGGL(fwd_kernel, dim3(grid), dim3(NTHR), LDS_BYTES, stream, a);
#else
    for (int p = 0; p < NPHASE; ++p) { a.ph_lo = p; a.ph_hi = p + 1; hipLaunchKernelGGL(fwd_kernel, dim3(grid), dim3(NTHR), LDS_BYTES, stream, a); }
#endif
}
```
